# Optimizing an MI355X kernel written in HIP

```python
import math
import jax, jax.numpy as jnp
from jax import lax
import numpy as np

D_MODEL = 1024
BATCH = 4
SEQ = 4096
DEPTH = 4

N_MIXERS = 3
D_INNER = D_MODEL
PLE_DIM = 256
CONV_WIDTH = 3
SSM_GROUP = 16
SSM_STATE = 64
SSM_GROUPS = D_INNER // SSM_GROUP
DT_MIN = 1e-3
DT_MAX = 1e-1
RWKV_HEAD = 64
RWKV_HEADS = D_INNER // RWKV_HEAD
DECAY_LORA = 64
ICLR_LORA = 64
RWKV_GN_EPS = 64e-5
LN_EPS = 1e-5
DN_ALPHA = (2 * DEPTH) ** 0.25
DN_BETA = (8 * DEPTH) ** -0.25
N_CONV = (DEPTH + 2) // 3
N_SSM = (DEPTH + 1) // 3
N_RWKV = DEPTH // 3

kernel_name = "hybrid_conv_s5_rwkv7_deepnorm_trunk"


def layer_norm(h, g, b, eps=LN_EPS):
    h32 = h.astype(jnp.float32)
    mu = h32.mean(-1, keepdims=True)
    var = jnp.square(h32 - mu).mean(-1, keepdims=True)
    return ((h32 - mu) * lax.rsqrt(var + eps) * g.astype(jnp.float32) + b.astype(jnp.float32)).astype(h.dtype)


def token_shift(x):
    return jnp.pad(x, ((0, 0), (1, 0), (0, 0)))[:, :-1]


def short_conv_mixer(x, w_in, conv_k, w_out):
    bg, cg, h, z = jnp.split(x @ w_in, 4, axis=-1)
    u = cg * h
    conv = lax.conv_general_dilated(
        u, conv_k[:, None, :].astype(u.dtype), window_strides=(1,),
        padding=[(CONV_WIDTH - 1, 0)], dimension_numbers=("NWC", "WIO", "NWC"),
        feature_group_count=D_INNER)
    return (bg * conv * jax.nn.silu(z)) @ w_out


def _ssm_combine(left, right):
    a_l, b_l = left
    a_r, b_r = right
    return a_r * a_l, a_r * b_l + b_r


def s5_mixer(x, w_in, lam_re, lam_im, log_dt, b_re, b_im, c_re, c_im, d_skip, w_glu, b_glu, w_out):
    f32 = jnp.float32
    u, z = jnp.split(x @ w_in, 2, axis=-1)
    bsz, seqlen, _ = u.shape
    ug = u.astype(f32).reshape(bsz, seqlen, SSM_GROUPS, SSM_GROUP)
    lam = lax.complex(lam_re.astype(f32), lam_im.astype(f32))
    dt = jnp.exp(log_dt.astype(f32))[:, None]
    a_bar = jnp.exp(lam * dt)
    b_mat = lax.complex(b_re.astype(f32), b_im.astype(f32))
    b_bar = ((a_bar - 1.0) / lam)[..., None] * b_mat
    c_mat = lax.complex(c_re.astype(f32), c_im.astype(f32))
    bu = jnp.einsum("blgh,gph->blgp", ug, b_bar)
    a_seq = jnp.broadcast_to(a_bar, bu.shape)
    states = lax.associative_scan(_ssm_combine, (a_seq, bu), axis=1)[1]
    y = jnp.einsum("blgp,ghp->blgh", states, c_mat).real + d_skip.astype(f32).reshape(SSM_GROUPS, SSM_GROUP) * ug
    y = jax.nn.gelu(y.reshape(bsz, seqlen, D_INNER).astype(x.dtype))
    y = y * jax.nn.sigmoid(y @ w_glu + b_glu)
    return (y * jax.nn.silu(z)) @ w_out


def _rwkv_step(state, inp):
    r_t, w_t, k_t, v_t, kk_t, a_t = inp
    sa = jnp.einsum("bhvk,bhk->bhv", state, -kk_t)
    state = (state * w_t[:, :, None, :] + sa[..., None] * (kk_t * a_t)[:, :, None, :]
             + v_t[..., None] * k_t[:, :, None, :])
    out = jnp.einsum("bhvk,bhk->bhv", state, r_t)
    return state, out


def rwkv7_mixer(x, mu, w_rkvz, w0, w1, w2, a0, a1, a2, k_k, k_a, r_k, lnx_g, lnx_b, w_out):
    f32 = jnp.float32
    bsz, seqlen, _ = x.shape
    dx = token_shift(x) - x
    xs = x[None] + dx[None] * mu[:, None, None, :]
    r, k, v, z = jnp.einsum("nbld,nde->nble", xs[:4], w_rkvz)
    xw, xa = xs[4], xs[5]
    w_log = -jax.nn.softplus(-(w0 + jnp.tanh(xw @ w1) @ w2)) - 0.5
    decay = jnp.exp(-jnp.exp(w_log.astype(f32)))
    a = jax.nn.sigmoid(a0 + (xa @ a1) @ a2).astype(f32)
    heads = lambda t: t.astype(f32).reshape(bsz, seqlen, RWKV_HEADS, RWKV_HEAD)
    kk = heads(k * k_k)
    kk = kk / jnp.maximum(jnp.linalg.norm(kk, axis=-1, keepdims=True), 1e-12)
    k = heads(k * (1.0 + (a.astype(k.dtype) - 1.0) * k_a))
    r, v, decay, a = heads(r), heads(v), heads(decay), heads(a)
    seq_first = lambda t: jnp.moveaxis(t, 1, 0)
    s0 = jnp.zeros((bsz, RWKV_HEADS, RWKV_HEAD, RWKV_HEAD), f32)
    _, out = lax.scan(_rwkv_step, s0, tuple(seq_first(t) for t in (r, decay, k, v, kk, a)))
    out = jnp.moveaxis(out, 0, 1)
    mu_o = out.mean(-1, keepdims=True)
    var_o = jnp.square(out - mu_o).mean(-1, keepdims=True)
    out = ((out - mu_o) * lax.rsqrt(var_o + RWKV_GN_EPS)).reshape(bsz, seqlen, D_INNER)
    out = out * lnx_g.astype(f32) + lnx_b.astype(f32)
    bonus = jnp.sum(r * k * r_k.astype(f32), axis=-1, keepdims=True) * v
    out = (out + bonus.reshape(bsz, seqlen, D_INNER)).astype(x.dtype)
    return (out * jax.nn.silu(z)) @ w_out


def setup_inputs(seed: int = 0) -> dict:
    key = jax.random.key(seed)
    ks = iter(jax.random.split(key, 48))
    nrm = lambda shape, s: jax.random.normal(next(ks), shape, jnp.float32) * s
    D, E, G, P, H, N = D_MODEL, D_INNER, SSM_GROUPS, SSM_STATE, RWKV_HEADS, RWKV_HEAD
    ramp = jnp.linspace(0.0, 1.0, E, dtype=jnp.float32) ** 0.85
    inp = {}
    inp["x"] = nrm((BATCH, SEQ, D), 1.0)
    inp["p"] = nrm((DEPTH, BATCH, SEQ, PLE_DIM), 1.0)
    inp["conv_w_in"] = nrm((N_CONV, D, 4 * E), D ** -0.5)
    inp["conv_k"] = nrm((N_CONV, CONV_WIDTH, E), CONV_WIDTH ** -0.5)
    inp["conv_w_out"] = nrm((N_CONV, E, D), E ** -0.5 * DN_BETA)
    inp["ssm_w_in"] = nrm((N_SSM, D, 2 * E), D ** -0.5)
    inp["ssm_lam_re"] = -0.5 + nrm((N_SSM, G, P), 0.01)
    inp["ssm_lam_im"] = math.pi * jnp.arange(P, dtype=jnp.float32) + nrm((N_SSM, G, P), 0.01)
    inp["ssm_log_dt"] = jax.random.uniform(next(ks), (N_SSM, G), jnp.float32, math.log(DT_MIN), math.log(DT_MAX))
    inp["ssm_b_re"] = nrm((N_SSM, G, P, SSM_GROUP), (2 * SSM_GROUP) ** -0.5)
    inp["ssm_b_im"] = nrm((N_SSM, G, P, SSM_GROUP), (2 * SSM_GROUP) ** -0.5)
    inp["ssm_c_re"] = nrm((N_SSM, G, SSM_GROUP, P), (2 * P) ** -0.5)
    inp["ssm_c_im"] = nrm((N_SSM, G, SSM_GROUP, P), (2 * P) ** -0.5)
    inp["ssm_d"] = nrm((N_SSM, E), 1.0)
    inp["ssm_w_glu"] = nrm((N_SSM, E, E), E ** -0.5)
    inp["ssm_b_glu"] = nrm((N_SSM, E), 0.01)
    inp["ssm_w_out"] = nrm((N_SSM, E, D), E ** -0.5 * DN_BETA)
    inp["rwkv_mu"] = jax.random.uniform(next(ks), (N_RWKV, 6, D), jnp.float32)
    inp["rwkv_w_rkvz"] = nrm((N_RWKV, 4, D, E), D ** -0.5)
    inp["rwkv_w0"] = -6.0 + 5.0 * ramp + nrm((N_RWKV, E), 0.1)
    inp["rwkv_w1"] = nrm((N_RWKV, D, DECAY_LORA), D ** -0.5)
    inp["rwkv_w2"] = nrm((N_RWKV, DECAY_LORA, E), 0.1 * DECAY_LORA ** -0.5)
    inp["rwkv_a0"] = nrm((N_RWKV, E), 0.1)
    inp["rwkv_a1"] = nrm((N_RWKV, D, ICLR_LORA), D ** -0.5)
    inp["rwkv_a2"] = nrm((N_RWKV, ICLR_LORA, E), 0.1 * ICLR_LORA ** -0.5)
    inp["rwkv_k_k"] = 0.85 + nrm((N_RWKV, E), 0.05)
    inp["rwkv_k_a"] = 1.0 + nrm((N_RWKV, E), 0.05)
    inp["rwkv_r_k"] = nrm((N_RWKV, H, N), 0.1)
    inp["rwkv_lnx_g"] = 1.0 + nrm((N_RWKV, E), 0.05)
    inp["rwkv_lnx_b"] = nrm((N_RWKV, E), 0.01)
    inp["rwkv_w_out"] = nrm((N_RWKV, E, D), E ** -0.5 * DN_BETA)
    inp["ple_proj"] = nrm((DEPTH, PLE_DIM, D), PLE_DIM ** -0.5)
    inp["ple_gate"] = nrm((DEPTH, D, D), D ** -0.5)
    inp["ln_g"] = 1.0 + nrm((DEPTH, D), 0.05)
    inp["ln_b"] = nrm((DEPTH, D), 0.01)
    return inp


def reference(x, p, conv_w_in, conv_k, conv_w_out,
              ssm_w_in, ssm_lam_re, ssm_lam_im, ssm_log_dt, ssm_b_re, ssm_b_im, ssm_c_re, ssm_c_im,
              ssm_d, ssm_w_glu, ssm_b_glu, ssm_w_out,
              rwkv_mu, rwkv_w_rkvz, rwkv_w0, rwkv_w1, rwkv_w2, rwkv_a0, rwkv_a1, rwkv_a2,
              rwkv_k_k, rwkv_k_a, rwkv_r_k, rwkv_lnx_g, rwkv_lnx_b, rwkv_w_out,
              ple_proj, ple_gate, ln_g, ln_b):
    for i in range(DEPTH):
        kind, j = i % N_MIXERS, i // N_MIXERS
        if kind == 0:
            y = short_conv_mixer(x, conv_w_in[j], conv_k[j], conv_w_out[j])
        elif kind == 1:
            y = s5_mixer(x, ssm_w_in[j], ssm_lam_re[j], ssm_lam_im[j], ssm_log_dt[j],
                         ssm_b_re[j], ssm_b_im[j], ssm_c_re[j], ssm_c_im[j], ssm_d[j],
                         ssm_w_glu[j], ssm_b_glu[j], ssm_w_out[j])
        else:
            y = rwkv7_mixer(x, rwkv_mu[j], rwkv_w_rkvz[j], rwkv_w0[j], rwkv_w1[j], rwkv_w2[j],
                            rwkv_a0[j], rwkv_a1[j], rwkv_a2[j], rwkv_k_k[j], rwkv_k_a[j],
                            rwkv_r_k[j], rwkv_lnx_g[j], rwkv_lnx_b[j], rwkv_w_out[j])
        r = DN_ALPHA * x + y
        r = r + (p[i] @ ple_proj[i]) * jax.nn.sigmoid(r @ ple_gate[i])
        x = layer_norm(r, ln_g[i], ln_b[i])
    return x
```

```cpp
#include <hip/hip_runtime.h>
#include <hip/hip_cooperative_groups.h>
#include <cstdio>
namespace cg = cooperative_groups;
namespace pg8 {
#define PG8_LAS __attribute__((address_space(3)))
typedef unsigned short bf16_t;
typedef short bf16x8 __attribute__((ext_vector_type(8)));
typedef float f32x4 __attribute__((ext_vector_type(4)));
typedef unsigned u32x4 __attribute__((ext_vector_type(4)));
constexpr int BM = 256, BK = 64, HALF = 128, HTB = HALF * BK * 2  , STAGE_BYTES = 8 * HTB, NXCD = 8, WGM = 8;

__host__ __device__ __forceinline__ int lds_byte(int r, int c) { const int st = (r >> 4) * 2 + (c >> 5), rr = r & 15, cc = c & 31, ob = rr * 64 + cc * 2; return st * 1024 + (ob ^ (((ob >> 9) & 1) << 5)); }
__host__ __device__ __forceinline__ void stage_rc(int b, int& R, int& C) { const int st = b / 1024, sb = b % 1024, swz = sb ^ (((sb >> 9) & 1) << 5); R = (st >> 1) * 16 + swz / 64; C = (st & 1) * 32 + (swz % 64) / 2; }
__host__ __device__ __forceinline__ int perm32(int rho) { const int n = rho >> 4, i = rho & 15; return 8 * (i >> 2) + 4 * n + (i & 3); }

struct Unit { int pm, pn; };
struct Gemm { const bf16_t* A; const bf16_t* Bt; int M, N, K; };
struct StaticOrder {
    int nM, nN, nwg, G, c;
    __host__ __device__ void init(int M, int N, int G_, int c_) { nM = M / BM; nN = N / BM; nwg = nM * nN; G = G_; c = c_; }
    __host__ __device__ bool next(int i, Unit& u) const {
        const long L = (long)i * G + c; if (L >= nwg) return false;
        int wgid = (int)L; { const int q = nwg / NXCD, r = nwg % NXCD, xcd = wgid % NXCD, off = wgid / NXCD; wgid = (xcd < r ? xcd * (q + 1) : r * (q + 1) + (xcd - r) * q) + off; }
        const int nig = WGM * nN, gid = wgid / nig, fm = gid * WGM, gsz = (nM - fm) < WGM ? (nM - fm) : WGM;
        u.pm = fm + ((wgid % nig) % gsz); u.pn = (wgid % nig) / gsz; return true;
    }
    __device__ __forceinline__ void a_ready(const Unit&) const {}
    __device__ __forceinline__ void done(const Unit&) const {}
};
__device__ __forceinline__ unsigned cvt_pk_bf16(float lo, float hi) { unsigned r; asm volatile("v_cvt_pk_bf16_f32 %0, %1, %2" : "=v"(r) : "v"(lo), "v"(hi)); return r; }
template <class Epi, class Sched, bool STAMP = false>
__device__ __forceinline__ void gemm_phase(PG8_LAS unsigned char* lds, const Gemm g, const Sched& S, const Epi& E, unsigned long long* stamps) {
    int tid_o = threadIdx.x; asm volatile("" : "+v"(tid_o)); const int tid = tid_o, wid = __builtin_amdgcn_readfirstlane(tid >> 6), lane = tid & 63, wr = wid >> 2, wc = wid & 3, fr = lane & 15, fq = lane >> 4;
    const int K = g.K, nt = K / BK;
    int ts_lo = 0, ts_hi = 0, nts = 0; const unsigned long long rt_entry = STAMP ? (unsigned long long)wall_clock64() : 0ull;
#define PG8_STAMP() do { if (STAMP && wid == 0 && nts < 64) { const unsigned long long _c = (unsigned long long)clock64(); \
        ts_lo = (lane == nts) ? (int)(unsigned)_c : ts_lo; ts_hi = (lane == nts) ? (int)(unsigned)(_c >> 32) : ts_hi; ++nts; } } while (0)
    PG8_STAMP();
    unsigned voffA[2], voffB[2];
#pragma unroll
    for (int i = 0; i < 2; ++i) { int R, C; stage_rc(tid * 16 + i * 8192, R, C); const int Rb = Epi::PERM ? ((R & ~31) + perm32(R & 31)) : R;
        voffA[i] = (unsigned)(R * K + C) * 2u; voffB[i] = (unsigned)(Rb * K + C) * 2u; }
    const size_t kstep = (size_t)(BK * 2);
    const size_t hstep = (size_t)HALF * K * 2;
    const size_t tstep = 2 * hstep;
    const unsigned ldsw = (unsigned)wid * 1024u;
    const int aoff = lds_byte(wr * 64 + fr, fq * 8), boff = lds_byte(wc * 32 + fr, fq * 8);
#define PG8_SA(b, h) (((b) * 2 + (h)) * HTB)
#define PG8_SB(b, h) ((4 + (b) * 2 + (h)) * HTB)
#define PG8_STAGE(bufoff, gbase, voff) do { _Pragma("unroll") for (int _i = 0; _i < 2; ++_i) \
        __builtin_amdgcn_global_load_lds((const unsigned*)((const char*)(gbase) + (voff)[_i]), (PG8_LAS unsigned*)(lds + (bufoff) + ldsw + _i * 8192), 16, 0, 0); } while (0)
#define PG8_LDA(dst, b, h) do { _Pragma("unroll") for (int m = 0; m < 4; ++m) _Pragma("unroll") for (int k = 0; k < 2; ++k) dst[m][k] = *(const PG8_LAS bf16x8*)(lds + PG8_SA(b, h) + aoff + m * 2048 + k * 1024); } while (0)
#define PG8_LDB(dst, b, h) do { _Pragma("unroll") for (int n = 0; n < 2; ++n) _Pragma("unroll") for (int k = 0; k < 2; ++k) dst[n][k] = *(const PG8_LAS bf16x8*)(lds + PG8_SB(b, h) + boff + n * 2048 + k * 1024); } while (0)
#define PG8_MMA(ai, bj, At, Bt) do { __builtin_amdgcn_s_setprio(1); _Pragma("unroll") for (int m = 0; m < 4; ++m) _Pragma("unroll") for (int n = 0; n < 2; ++n) _Pragma("unroll") for (int k = 0; k < 2; ++k) \
        acc[ai][bj][m][n] = __builtin_amdgcn_mfma_f32_16x16x32_bf16(Bt[n][k], At[m][k], acc[ai][bj][m][n], 0, 0, 0); __builtin_amdgcn_s_setprio(0); } while (0)
#define PG8_WAIT_V(n) asm volatile("s_waitcnt vmcnt(" #n ")" ::: "memory")
#define PG8_WAIT_L(n) asm volatile("s_waitcnt lgkmcnt(" #n ")" ::: "memory")
#define PG8_BAR __builtin_amdgcn_s_barrier()
#define PG8_SCHED __builtin_amdgcn_sched_barrier(0)
    Unit cur, nxt; int ui = 0;
    if (!S.next(0, cur)) return;
    f32x4 acc[2][2][4][2];
#pragma unroll
    for (int a = 0; a < 2; ++a)
#pragma unroll
        for (int b = 0; b < 2; ++b)
#pragma unroll
            for (int m = 0; m < 4; ++m)
#pragma unroll
                for (int n = 0; n < 2; ++n) acc[a][b][m][n] = (f32x4){0.f, 0.f, 0.f, 0.f};
    bf16x8 At[4][2], B0[2][2], B1[2][2];
    const char* cA = (const char*)g.A + (size_t)cur.pm * tstep; const char* cB = (const char*)g.Bt + (size_t)cur.pn * tstep;
    S.a_ready(cur);
    PG8_STAGE(PG8_SB(0, 0), cB, voffB); PG8_STAGE(PG8_SA(0, 0), cA, voffA); PG8_STAGE(PG8_SB(0, 1), cB + hstep, voffB); PG8_STAGE(PG8_SA(0, 1), cA + hstep, voffA);
    if (wr == 1) PG8_BAR;
    PG8_WAIT_V(4); PG8_BAR;
    PG8_STAGE(PG8_SB(1, 0), cB + kstep, voffB); PG8_STAGE(PG8_SA(1, 0), cA + kstep, voffA); PG8_STAGE(PG8_SB(1, 1), cB + hstep + kstep, voffB);
    PG8_WAIT_V(6); PG8_BAR;
    PG8_STAMP();
    for (;;) {
        const bool has_next = S.next(ui + 1, nxt);
        const char* nA = has_next ? (const char*)g.A + (size_t)nxt.pm * tstep : cA; const char* nB = has_next ? (const char*)g.Bt + (size_t)nxt.pn * tstep : cB;
        for (int t = 0; t < nt; t += 2) {
            const bool last = (t == nt - 2);
            const char* a1 = cA + (size_t)(t + 1) * kstep;
            const char* a2 = last ? nA : cA + (size_t)(t + 2) * kstep; const char* b2 = last ? nB : cB + (size_t)(t + 2) * kstep;
            const char* a3 = a2 + kstep; const char* b3 = b2 + kstep;
            if (last && has_next) S.a_ready(nxt);
            PG8_LDB(B0, 0, 0); PG8_SCHED; PG8_LDA(At, 0, 0); PG8_STAGE(PG8_SA(1, 1), a1 + hstep, voffA);
            PG8_WAIT_L(8); PG8_BAR; PG8_WAIT_L(0); PG8_MMA(0, 0, At, B0); PG8_BAR; PG8_SCHED;
            PG8_LDB(B1, 0, 1); PG8_STAGE(PG8_SB(0, 0), b2, voffB);
            PG8_BAR; PG8_WAIT_L(0); PG8_MMA(0, 1, At, B1); PG8_BAR;
            PG8_LDA(At, 0, 1); PG8_STAGE(PG8_SA(0, 0), a2, voffA);
            PG8_BAR; PG8_WAIT_L(0); PG8_MMA(1, 0, At, B0); PG8_BAR; PG8_SCHED;
            PG8_STAGE(PG8_SB(0, 1), b2 + hstep, voffB);
            PG8_WAIT_V(6); PG8_BAR; PG8_MMA(1, 1, At, B1); PG8_BAR;
            PG8_LDB(B0, 1, 0); PG8_SCHED; PG8_LDA(At, 1, 0); PG8_STAGE(PG8_SA(0, 1), a2 + hstep, voffA);
            PG8_WAIT_L(8); PG8_BAR; PG8_WAIT_L(0); PG8_MMA(0, 0, At, B0); PG8_BAR; PG8_SCHED;
            PG8_LDB(B1, 1, 1); PG8_STAGE(PG8_SB(1, 0), b3, voffB);
            PG8_BAR; PG8_WAIT_L(0); PG8_MMA(0, 1, At, B1); PG8_BAR;
            PG8_LDA(At, 1, 1); PG8_STAGE(PG8_SA(1, 0), a3, voffA);
            PG8_BAR; PG8_WAIT_L(0); PG8_MMA(1, 0, At, B0); PG8_BAR; PG8_SCHED;
            PG8_STAGE(PG8_SB(1, 1), b3 + hstep, voffB);
            PG8_WAIT_V(6); PG8_BAR; PG8_MMA(1, 1, At, B1); PG8_BAR;
        }
        PG8_STAMP();
        if constexpr (!Epi::AFTER_DRAIN) { E(acc, cur, wr, wc, fr, fq); S.done(cur); }
        PG8_STAMP();
        if (!has_next) break;
#pragma unroll
        for (int a = 0; a < 2; ++a)
#pragma unroll
            for (int b = 0; b < 2; ++b)
#pragma unroll
                for (int m = 0; m < 4; ++m)
#pragma unroll
                    for (int n = 0; n < 2; ++n) acc[a][b][m][n] = (f32x4){0.f, 0.f, 0.f, 0.f};
        cur = nxt; cA = nA; cB = nB; ++ui;
    }
    PG8_WAIT_V(0);
    if (wr == 0) PG8_BAR;
    PG8_BAR;
    if constexpr (Epi::AFTER_DRAIN) { E.fused(acc, cur, wr, wc, fr, fq, lds, wid, lane); S.done(cur); }
    PG8_STAMP();
    if (STAMP && wid == 0) { stamps[lane] = lane < nts ? (((unsigned long long)(unsigned)ts_hi << 32) | (unsigned)ts_lo) : 0ull;
        if (lane == 62) stamps[62] = rt_entry; if (lane == 63) stamps[63] = (unsigned long long)wall_clock64(); }
#undef PG8_STAMP
#undef PG8_SA
#undef PG8_SB
#undef PG8_STAGE
#undef PG8_LDA
#undef PG8_LDB
#undef PG8_MMA
#undef PG8_WAIT_V
#undef PG8_WAIT_L
#undef PG8_BAR
#undef PG8_SCHED
}
}
using pg8::bf16_t; using pg8::bf16x8; using pg8::f32x4; using pg8::Unit; using pg8::Gemm; using pg8::StaticOrder;
#define LAS __attribute__((address_space(3)))
constexpr int MTOK = 16384, DM = 1024, SEQL = 4096;
constexpr size_t MiB = 1u << 20, KiB = 1u << 10;
constexpr float DN_ALPHA = 1.6817928305074290f;
constexpr size_t W_CIN = 0, W_COUT = 8 * MiB, W_PEC = 10 * MiB, W_PGC = 10 * MiB + 512 * KiB;
constexpr size_t W_SIN = 12 * MiB + 512 * KiB, W_SGLU = 16 * MiB + 512 * KiB, W_SOUT = 18 * MiB + 512 * KiB, W_PE1 = 20 * MiB + 512 * KiB, W_PG1 = 21 * MiB;
constexpr size_t W_RK = 23 * MiB, W_L2 = 40 * MiB, W_ROUT = 41 * MiB, W_PE2 = 43 * MiB, W_PG2 = 43 * MiB + 512 * KiB;
constexpr size_t OUT_RW = 0, PB = 46 * MiB, ACT = 54 * MiB, T0 = 86 * MiB;
constexpr int LDS_BYTES = 131072;

struct P { const float* in[35]; float* out; unsigned char* ws; };

__device__ __forceinline__ unsigned pk2(float lo, float hi) { return pg8::cvt_pk_bf16(lo, hi); }
__device__ __forceinline__ float bflo(unsigned u) { return __uint_as_float(u << 16); }
__device__ __forceinline__ float bfhi(unsigned u) { return __uint_as_float(u & 0xffff0000u); }
__device__ __forceinline__ float sigmoidf_(float x) { return 1.0f / (1.0f + __expf(-x)); }
__device__ __forceinline__ float siluf_(float x) { return x / (1.0f + __expf(-x)); }
__device__ __forceinline__ float tanhf_(float x) { const float e = __expf(-2.0f * fabsf(x)); const float t = (1.0f - e) / (1.0f + e); return x < 0.f ? -t : t; }
__device__ __forceinline__ float gelu_tanh(float x) { return 0.5f * x * (1.0f + tanhf_(0.7978845608028654f * (x + 0.044715f * x * x * x))); }
template <int CTRL> __device__ __forceinline__ float dppf(float x) { return __int_as_float(__builtin_amdgcn_update_dpp(0, __float_as_int(x), CTRL, 0xF, 0xF, true)); }
__device__ __forceinline__ float red8(float x) { x += dppf<0xB1>(x); x += dppf<0x4E>(x); x += dppf<0x141>(x); return x; }
__device__ __forceinline__ float red16(float x) { x = red8(x); x += dppf<0x140>(x); return x; }
__device__ __forceinline__ float wave_sum(float v) { for (int o = 32; o >= 1; o >>= 1) v += __shfl_xor(v, o); return v; }
__device__ __forceinline__ int otid() { int t = threadIdx.x; asm volatile("" : "+v"(t)); return t; }
#define LDS_FENCE() asm volatile("s_waitcnt lgkmcnt(0)" ::: "memory")

struct EpiConvIn {
    static constexpr bool PERM = false, AFTER_DRAIN = false;
    bf16_t* U; bf16_t* G;
    __device__ __forceinline__ void operator()(const f32x4 (&acc)[2][2][4][2], const Unit& u, int wr, int wc, int fr, int fq) const {
        const int row0 = u.pm * 256 + wr * 64 + fr, e0 = u.pn * 64 + wc * 16 + 4 * fq;
#pragma unroll
        for (int ai = 0; ai < 2; ++ai)
#pragma unroll
            for (int m = 0; m < 4; ++m) {
                const size_t o = (size_t)(row0 + ai * 128 + m * 16) * DM + e0;
                float uu[4], gg[4];
#pragma unroll
                for (int j = 0; j < 4; ++j) { uu[j] = acc[ai][0][m][1][j] * acc[ai][1][m][0][j]; gg[j] = acc[ai][0][m][0][j] * siluf_(acc[ai][1][m][1][j]); }
                *(uint2*)(U + o) = make_uint2(pk2(uu[0], uu[1]), pk2(uu[2], uu[3]));
                *(uint2*)(G + o) = make_uint2(pk2(gg[0], gg[1]), pk2(gg[2], gg[3]));
            }
    }
};
struct EpiWout {
    static constexpr bool PERM = false, AFTER_DRAIN = false;
    float* X; bf16_t* RB;
    __device__ __forceinline__ void operator()(const f32x4 (&acc)[2][2][4][2], const Unit& u, int wr, int wc, int fr, int fq) const {
        const int row0 = u.pm * 256 + wr * 64 + fr, col0 = u.pn * 256 + wc * 32 + 4 * fq;
#pragma unroll
        for (int ai = 0; ai < 2; ++ai)
#pragma unroll
            for (int m = 0; m < 4; ++m)
#pragma unroll
                for (int bj = 0; bj < 2; ++bj)
#pragma unroll
                    for (int n = 0; n < 2; ++n) {
                        const size_t o = (size_t)(row0 + ai * 128 + m * 16) * DM + col0 + bj * 128 + n * 16;
                        f32x4 x = *(const f32x4*)(X + o);
                        f32x4 r = x * DN_ALPHA + acc[ai][bj][m][n];
                        *(f32x4*)(X + o) = r;
                        *(uint2*)(RB + o) = make_uint2(pk2(r[0], r[1]), pk2(r[2], r[3]));
                    }
    }
};
struct EpiBf16 {
    static constexpr bool PERM = false, AFTER_DRAIN = false;
    bf16_t* O; int ldo; int split; size_t stride;
    __device__ __forceinline__ void operator()(const f32x4 (&acc)[2][2][4][2], const Unit& u, int wr, int wc, int fr, int fq) const {
        const int row0 = u.pm * 256 + wr * 64 + fr; const int grp = u.pn / split; const int col0 = (u.pn - grp * split) * 256 + wc * 32 + 4 * fq;
        bf16_t* base = O + (size_t)grp * stride;
#pragma unroll
        for (int ai = 0; ai < 2; ++ai)
#pragma unroll
            for (int m = 0; m < 4; ++m)
#pragma unroll
                for (int bj = 0; bj < 2; ++bj)
#pragma unroll
                    for (int n = 0; n < 2; ++n) {
                        const size_t o = (size_t)(row0 + ai * 128 + m * 16) * ldo + col0 + bj * 128 + n * 16;
                        const f32x4 a = acc[ai][bj][m][n];
                        *(uint2*)(base + o) = make_uint2(pk2(a[0], a[1]), pk2(a[2], a[3]));
                    }
    }
};
struct EpiPle {
    static constexpr bool PERM = false, AFTER_DRAIN = false;
    float* X; const bf16_t* PE;
    __device__ __forceinline__ void operator()(const f32x4 (&acc)[2][2][4][2], const Unit& u, int wr, int wc, int fr, int fq) const {
        const int row0 = u.pm * 256 + wr * 64 + fr, col0 = u.pn * 256 + wc * 32 + 4 * fq;
#pragma unroll
        for (int ai = 0; ai < 2; ++ai)
#pragma unroll
            for (int m = 0; m < 4; ++m)
#pragma unroll
                for (int bj = 0; bj < 2; ++bj)
#pragma unroll
                    for (int n = 0; n < 2; ++n) {
                        const size_t o = (size_t)(row0 + ai * 128 + m * 16) * DM + col0 + bj * 128 + n * 16;
                        f32x4 x = *(const f32x4*)(X + o); const uint2 pe = *(const uint2*)(PE + o); const f32x4 a = acc[ai][bj][m][n];
                        x[0] += bflo(pe.x) * sigmoidf_(a[0]); x[1] += bfhi(pe.x) * sigmoidf_(a[1]); x[2] += bflo(pe.y) * sigmoidf_(a[2]); x[3] += bfhi(pe.y) * sigmoidf_(a[3]);
                        *(f32x4*)(X + o) = x;
                    }
    }
};
struct EpiSsmIn {
    static constexpr bool PERM = false, AFTER_DRAIN = false;
    float* U; bf16_t* SZ;
    __device__ __forceinline__ void operator()(const f32x4 (&acc)[2][2][4][2], const Unit& u, int wr, int wc, int fr, int fq) const {
        const int row0 = u.pm * 256 + wr * 64 + fr; const bool isz = u.pn >= 4; const int col0 = (u.pn & 3) * 256 + wc * 32 + 4 * fq;
#pragma unroll
        for (int ai = 0; ai < 2; ++ai)
#pragma unroll
            for (int m = 0; m < 4; ++m)
#pragma unroll
                for (int bj = 0; bj < 2; ++bj)
#pragma unroll
                    for (int n = 0; n < 2; ++n) {
                        const size_t o = (size_t)(row0 + ai * 128 + m * 16) * DM + col0 + bj * 128 + n * 16;
                        const f32x4 a = acc[ai][bj][m][n];
                        if (isz) *(uint2*)(SZ + o) = make_uint2(pk2(siluf_(a[0]), siluf_(a[1])), pk2(siluf_(a[2]), siluf_(a[3])));
                        else *(f32x4*)(U + o) = a;
                    }
    }
};
struct EpiGlu {
    static constexpr bool PERM = false, AFTER_DRAIN = false;
    const bf16_t* YG; const bf16_t* SZ; const float* bias; bf16_t* V;
    __device__ __forceinline__ void operator()(const f32x4 (&acc)[2][2][4][2], const Unit& u, int wr, int wc, int fr, int fq) const {
        const int row0 = u.pm * 256 + wr * 64 + fr, col0 = u.pn * 256 + wc * 32 + 4 * fq;
#pragma unroll
        for (int ai = 0; ai < 2; ++ai)
#pragma unroll
            for (int m = 0; m < 4; ++m)
#pragma unroll
                for (int bj = 0; bj < 2; ++bj)
#pragma unroll
                    for (int n = 0; n < 2; ++n) {
                        const int col = col0 + bj * 128 + n * 16;
                        const size_t o = (size_t)(row0 + ai * 128 + m * 16) * DM + col;
                        const f32x4 a = acc[ai][bj][m][n]; const f32x4 bb = *(const f32x4*)(bias + col);
                        const uint2 y = *(const uint2*)(YG + o), z = *(const uint2*)(SZ + o);
                        const float v0 = bflo(y.x) * sigmoidf_(a[0] + bb[0]) * bflo(z.x), v1 = bfhi(y.x) * sigmoidf_(a[1] + bb[1]) * bfhi(z.x);
                        const float v2 = bflo(y.y) * sigmoidf_(a[2] + bb[2]) * bflo(z.y), v3 = bfhi(y.y) * sigmoidf_(a[3] + bb[3]) * bfhi(z.y);
                        *(uint2*)(V + o) = make_uint2(pk2(v0, v1), pk2(v2, v3));
                    }
    }
};
struct EpiRk {
    static constexpr bool PERM = false, AFTER_DRAIN = false;
    bf16_t* RKV; bf16_t* SZ; bf16_t* L1;
    __device__ __forceinline__ void operator()(const f32x4 (&acc)[2][2][4][2], const Unit& u, int wr, int wc, int fr, int fq) const {
        const int row0 = u.pm * 256 + wr * 64 + fr; const int grp = u.pn >> 2; const int colt = (u.pn & 3) * 256 + wc * 32 + 4 * fq;
#pragma unroll
        for (int ai = 0; ai < 2; ++ai)
#pragma unroll
            for (int m = 0; m < 4; ++m)
#pragma unroll
                for (int bj = 0; bj < 2; ++bj)
#pragma unroll
                    for (int n = 0; n < 2; ++n) {
                        const int row = row0 + ai * 128 + m * 16, col = colt + bj * 128 + n * 16;
                        const f32x4 a = acc[ai][bj][m][n];
                        if (grp < 3) *(uint2*)(RKV + (size_t)grp * MTOK * DM + (size_t)row * DM + col) = make_uint2(pk2(a[0], a[1]), pk2(a[2], a[3]));
                        else if (grp == 3) *(uint2*)(SZ + (size_t)row * DM + col) = make_uint2(pk2(siluf_(a[0]), siluf_(a[1])), pk2(siluf_(a[2]), siluf_(a[3])));
                        else { const bool th = col < 64;
                            const float v0 = th ? tanhf_(a[0]) : a[0], v1 = th ? tanhf_(a[1]) : a[1], v2 = th ? tanhf_(a[2]) : a[2], v3 = th ? tanhf_(a[3]) : a[3];
                            *(uint2*)(L1 + (size_t)row * 256 + col) = make_uint2(pk2(v0, v1), pk2(v2, v3)); }
                    }
    }
};

template <class Epi> __device__ __forceinline__ void run_gemm(LAS unsigned char* lds, const bf16_t* A, const bf16_t* Bt, int N, int K, const Epi& E) {
    Gemm g; g.A = A; g.Bt = Bt; g.M = MTOK; g.N = N; g.K = K;
    StaticOrder S; S.init(MTOK, N, (int)gridDim.x, (int)blockIdx.x);
    pg8::gemm_phase<Epi, StaticOrder, false>(lds, g, S, E, nullptr);
}

__device__ __forceinline__ int conv_rowmap(int n) { const int s = n >> 10, e = n & 1023, q = e & 63; return 256 * (e >> 6) + 128 * (s >> 1) + 32 * (q >> 4) + 16 * (s & 1) + (q & 15); }
__device__ __forceinline__ void tr_job(LAS float* tile, const float* src, int ld_src, int K, int N, bf16_t* dst, int ldd, int koff, const float* kscale, int mode, int rot) {
    const int nblk = (int)gridDim.x, blk = ((int)blockIdx.x + rot) % nblk, tid = otid();
    const int tn_ = N >> 6, ntiles = (K >> 6) * tn_;
    for (int t = blk; t < ntiles; t += nblk) {
        const int k0 = (t / tn_) << 6, n0 = (t % tn_) << 6;
        __syncthreads();
#pragma unroll
        for (int i = 0; i < 8; ++i) { const int tk = (tid >> 6) + i * 8, tn = tid & 63; tile[tk * 65 + tn] = src[(size_t)(k0 + tk) * ld_src + n0 + tn]; }
        __syncthreads();
        const int nl = tid >> 3, kp = (tid & 7) * 8;
        float v[8];
#pragma unroll
        for (int i = 0; i < 8; ++i) { v[i] = tile[(kp + i) * 65 + nl]; if (kscale) v[i] *= kscale[k0 + kp + i]; }
        const int n = n0 + nl; const int row = mode ? conv_rowmap(n) : n;
        *(uint4*)(dst + (size_t)row * ldd + koff + k0 + kp) = make_uint4(pk2(v[0], v[1]), pk2(v[2], v[3]), pk2(v[4], v[5]), pk2(v[6], v[7]));
    }
}
__device__ __forceinline__ void cvt_pb(const float* src, bf16_t* dst) {
    const size_t n4 = (size_t)MTOK * 256 / 4, nth = (size_t)gridDim.x * 512;
    for (size_t i = (size_t)blockIdx.x * 512 + otid(); i < n4; i += nth) { const float4 v = ((const float4*)src)[i]; ((uint2*)dst)[i] = make_uint2(pk2(v.x, v.y), pk2(v.z, v.w)); }
}
__device__ __forceinline__ void conv_layer_weights(const P& p, LAS float* tile, int j, int L) {
    unsigned char* ws = p.ws;
    tr_job(tile, p.in[2] + (size_t)j * 1024 * 4096, 4096, 1024, 4096, (bf16_t*)(ws + W_CIN), 1024, 0, nullptr, 1, 0);
    tr_job(tile, p.in[4] + (size_t)j * 1024 * 1024, 1024, 1024, 1024, (bf16_t*)(ws + W_COUT), 1024, 0, nullptr, 0, 0);
    tr_job(tile, p.in[31] + (size_t)L * 256 * 1024, 1024, 256, 1024, (bf16_t*)(ws + W_PEC), 256, 0, nullptr, 0, 0);
    tr_job(tile, p.in[32] + (size_t)L * 1024 * 1024, 1024, 1024, 1024, (bf16_t*)(ws + W_PGC), 1024, 0, nullptr, 0, 64);
}

__device__ __forceinline__ void phase_prep(const P& p, LAS float* tile) {
    unsigned char* ws = p.ws; const size_t nth = (size_t)gridDim.x * 512, gt = (size_t)blockIdx.x * 512 + otid();
    {
        const float4* x = (const float4*)p.in[0]; float4* o = (float4*)p.out; uint2* a = (uint2*)(ws + ACT);
        for (size_t i = gt; i < (size_t)MTOK * DM / 4; i += nth) { const float4 v = x[i]; o[i] = v; a[i] = make_uint2(pk2(v.x, v.y), pk2(v.z, v.w)); }
    }
    cvt_pb(p.in[1], (bf16_t*)(ws + PB));
    conv_layer_weights(p, tile, 0, 0);
    tr_job(tile, p.in[5], 2048, 1024, 2048, (bf16_t*)(ws + W_SIN), 1024, 0, nullptr, 0, 128);
    tr_job(tile, p.in[14], 1024, 1024, 1024, (bf16_t*)(ws + W_SGLU), 1024, 0, nullptr, 0, 0);
    tr_job(tile, p.in[16], 1024, 1024, 1024, (bf16_t*)(ws + W_SOUT), 1024, 0, nullptr, 0, 0);
    tr_job(tile, p.in[31] + (size_t)1 * 256 * 1024, 1024, 256, 1024, (bf16_t*)(ws + W_PE1), 256, 0, nullptr, 0, 192);
    tr_job(tile, p.in[32] + (size_t)1 * 1024 * 1024, 1024, 1024, 1024, (bf16_t*)(ws + W_PG1), 1024, 0, nullptr, 0, 0);
    bf16_t* rk = (bf16_t*)(ws + W_RK);
    for (int g = 0; g < 4; ++g) {
        tr_job(tile, p.in[18] + (size_t)g * 1024 * 1024, 1024, 1024, 1024, rk + (size_t)g * 1024 * 2048, 2048, 0, nullptr, 0, 0);
        tr_job(tile, p.in[18] + (size_t)g * 1024 * 1024, 1024, 1024, 1024, rk + (size_t)g * 1024 * 2048, 2048, 1024, p.in[17] + g * 1024, 0, 0);
    }
    tr_job(tile, p.in[20], 64, 1024, 64, rk + (size_t)4096 * 2048, 2048, 0, nullptr, 0, 0);
    tr_job(tile, p.in[20], 64, 1024, 64, rk + (size_t)4096 * 2048, 2048, 1024, p.in[17] + 4 * 1024, 0, 16);
    tr_job(tile, p.in[23], 64, 1024, 64, rk + (size_t)4160 * 2048, 2048, 0, nullptr, 0, 32);
    tr_job(tile, p.in[23], 64, 1024, 64, rk + (size_t)4160 * 2048, 2048, 1024, p.in[17] + 5 * 1024, 0, 48);
    {
        uint4* z = (uint4*)(rk + (size_t)4224 * 2048);
        for (size_t i = gt; i < (size_t)128 * 2048 / 8; i += nth) z[i] = make_uint4(0, 0, 0, 0);
    }
    bf16_t* l2 = (bf16_t*)(ws + W_L2);
    tr_job(tile, p.in[21], 1024, 64, 1024, l2, 256, 0, nullptr, 0, 64);
    tr_job(tile, p.in[24], 1024, 64, 1024, l2 + (size_t)1024 * 256, 256, 64, nullptr, 0, 80);
    for (size_t i = gt; i < (size_t)2048 * 32; i += nth) { const int row = (int)(i >> 5), c8 = (int)(i & 31); const bool data = row < 1024 ? (c8 < 8) : (c8 >= 8 && c8 < 16);
        if (!data) *(uint4*)(l2 + (size_t)row * 256 + c8 * 8) = make_uint4(0, 0, 0, 0); }
    tr_job(tile, p.in[30], 1024, 1024, 1024, (bf16_t*)(ws + W_ROUT), 1024, 0, nullptr, 0, 96);
    tr_job(tile, p.in[31] + (size_t)2 * 256 * 1024, 1024, 256, 1024, (bf16_t*)(ws + W_PE2), 256, 0, nullptr, 0, 160);
    tr_job(tile, p.in[32] + (size_t)2 * 1024 * 1024, 1024, 1024, 1024, (bf16_t*)(ws + W_PG2), 1024, 0, nullptr, 0, 0);
}

__device__ __forceinline__ void phase_conv_ew(const bf16_t* U, bf16_t* G, const float* ck) {
    const size_t nth = (size_t)gridDim.x * 512;
    for (size_t i = (size_t)blockIdx.x * 512 + otid(); i < (size_t)MTOK * 128; i += nth) {
        const int row = (int)(i >> 7), c8 = (int)(i & 127) * 8, t = row & (SEQL - 1);
        const uint4 z4 = make_uint4(0, 0, 0, 0);
        const uint4 u0 = *(const uint4*)(U + (size_t)row * DM + c8);
        const uint4 u1 = t >= 1 ? *(const uint4*)(U + (size_t)(row - 1) * DM + c8) : z4;
        const uint4 u2 = t >= 2 ? *(const uint4*)(U + (size_t)(row - 2) * DM + c8) : z4;
        const uint4 g = *(const uint4*)(G + (size_t)row * DM + c8);
        const unsigned a0[4] = {u0.x, u0.y, u0.z, u0.w}, a1[4] = {u1.x, u1.y, u1.z, u1.w}, a2[4] = {u2.x, u2.y, u2.z, u2.w}, gg[4] = {g.x, g.y, g.z, g.w};
        unsigned o[4];
#pragma unroll
        for (int q = 0; q < 4; ++q) {
            const int c = c8 + 2 * q;
            const float lo = bflo(gg[q]) * (ck[c] * bflo(a2[q]) + ck[1024 + c] * bflo(a1[q]) + ck[2048 + c] * bflo(a0[q]));
            const float hi = bfhi(gg[q]) * (ck[c + 1] * bfhi(a2[q]) + ck[1024 + c + 1] * bfhi(a1[q]) + ck[2048 + c + 1] * bfhi(a0[q]));
            o[q] = pk2(lo, hi);
        }
        *(uint4*)(G + (size_t)row * DM + c8) = make_uint4(o[0], o[1], o[2], o[3]);
    }
}

__device__ __forceinline__ void phase_ln(float* X, bf16_t* XB, const float* g, const float* b) {
    const int lane = otid() & 63, gw = blockIdx.x * 8 + (otid() >> 6), nw = gridDim.x * 8;
    for (int row = gw; row < MTOK; row += nw) {
        float4 v[4]; float s = 0.f;
#pragma unroll
        for (int i = 0; i < 4; ++i) { v[i] = *(const float4*)(X + (size_t)row * DM + i * 256 + lane * 4); s += v[i].x + v[i].y + v[i].z + v[i].w; }
        const float mean = wave_sum(s) * (1.0f / 1024.0f);
        float q = 0.f;
#pragma unroll
        for (int i = 0; i < 4; ++i) { v[i].x -= mean; v[i].y -= mean; v[i].z -= mean; v[i].w -= mean; q += v[i].x * v[i].x + v[i].y * v[i].y + v[i].z * v[i].z + v[i].w * v[i].w; }
        const float rs = rsqrtf(wave_sum(q) * (1.0f / 1024.0f) + 1e-5f);
#pragma unroll
        for (int i = 0; i < 4; ++i) { const int c = i * 256 + lane * 4; const float4 gg = *(const float4*)(g + c), bb = *(const float4*)(b + c);
            float4 y; y.x = v[i].x * rs * gg.x + bb.x; y.y = v[i].y * rs * gg.y + bb.y; y.z = v[i].z * rs * gg.z + bb.z; y.w = v[i].w * rs * gg.w + bb.w;
            *(float4*)(X + (size_t)row * DM + c) = y; *(uint2*)(XB + (size_t)row * DM + c) = make_uint2(pk2(y.x, y.y), pk2(y.z, y.w)); }
    }
}

template <int FINAL> __device__ __forceinline__ void phase_s5(const P& p, LAS unsigned char* lds_, const float* U, float* HLOC, bf16_t* YG) {
    const int lane = otid() & 63, wid = otid() >> 6, nw = gridDim.x * 8;
    LAS float* ul = (LAS float*)(lds_ + wid * 8192);
    LAS unsigned* S = (LAS unsigned*)(lds_ + wid * 8192 + 2048);
    const int fr = lane & 15, fq = lane >> 4;
    for (int un = blockIdx.x * 8 + wid; un < 2048; un += nw) {
        const int g = un & 63, sc = (un >> 6) & 7, b = un >> 9;
        if (!FINAL && sc == 7) continue;
        const float dt = __expf(p.in[8][g]);
        const float lre = p.in[6][g * 64 + lane], lim = p.in[7][g * 64 + lane];
        const float mag = expf(lre * dt); float sn, cs; sincosf(lim * dt, &sn, &cs);
        const float are = mag * cs, aim = mag * sn;
        const float d2 = lre * lre + lim * lim, cfre = ((are - 1.0f) * lre + aim * lim) / d2, cfim = (aim * lre - (are - 1.0f) * lim) / d2;
        float Bre[16], Bim[16];
#pragma unroll
        for (int q = 0; q < 4; ++q) { const float4 br = *(const float4*)(p.in[9] + (size_t)(g * 64 + lane) * 16 + q * 4), bi = *(const float4*)(p.in[10] + (size_t)(g * 64 + lane) * 16 + q * 4);
            const float brr[4] = {br.x, br.y, br.z, br.w}, bii[4] = {bi.x, bi.y, bi.z, bi.w};
#pragma unroll
            for (int j = 0; j < 4; ++j) { Bre[q * 4 + j] = cfre * brr[j] - cfim * bii[j]; Bim[q * 4 + j] = cfre * bii[j] + cfim * brr[j]; } }
        float hre = 0.f, him = 0.f;
        bf16x8 Cf[4]; float dsk = 0.f;
        if (FINAL) {
            float lr = are, li = aim;
#pragma unroll
            for (int i = 0; i < 9; ++i) { const float t = lr * lr - li * li; li = 2.0f * lr * li; lr = t; }
            for (int s2 = 0; s2 < sc; ++s2) { const float2 hv = *(const float2*)(HLOC + ((size_t)((b * 8 + s2) * 64 + g) * 64 + lane) * 2);
                const float t = lr * hre - li * him + hv.x; him = lr * him + li * hre + hv.y; hre = t; }
#pragma unroll
            for (int kk = 0; kk < 4; ++kk) {
                unsigned w[4];
#pragma unroll
                for (int i = 0; i < 4; ++i) { const int pi = 16 * kk + 4 * fq + i; const size_t o = (size_t)(g * 16 + fr) * 64 + pi; w[i] = pk2(p.in[11][o], -p.in[12][o]); }
                union { unsigned u[4]; bf16x8 v; } cv; cv.u[0] = w[0]; cv.u[1] = w[1]; cv.u[2] = w[2]; cv.u[3] = w[3]; Cf[kk] = cv.v;
            }
            dsk = p.in[13][g * 16 + fr];
        }
        const size_t tok0 = (size_t)b * SEQL + (size_t)sc * 512;
        const float* ug = U + tok0 * DM + g * 16 + (lane & 3) * 4 + (size_t)(lane >> 2) * DM;
        f32x4 nxt = *(const f32x4*)ug;
        LDS_FENCE();
        *(LAS f32x4*)(ul + lane * 4) = nxt;
        for (int blk = 0; blk < 32; ++blk) {
            const int cur = blk & 1;
            if (blk + 1 < 32) nxt = *(const f32x4*)(ug + (size_t)(blk + 1) * 16 * DM);
            LDS_FENCE();
#pragma unroll
            for (int tt = 0; tt < 16; ++tt) {
                float uu[16];
#pragma unroll
                for (int q = 0; q < 4; ++q) { const f32x4 t4 = *(const LAS f32x4*)(ul + cur * 256 + tt * 16 + q * 4); uu[q * 4] = t4[0]; uu[q * 4 + 1] = t4[1]; uu[q * 4 + 2] = t4[2]; uu[q * 4 + 3] = t4[3]; }
                float bre = 0.f, bim = 0.f;
#pragma unroll
                for (int h = 0; h < 16; ++h) { bre = fmaf(Bre[h], uu[h], bre); bim = fmaf(Bim[h], uu[h], bim); }
                const float t = are * hre - aim * him + bre; him = are * him + aim * hre + bim; hre = t;
                if (FINAL) S[tt * 68 + lane] = pk2(hre, him);
            }
            if (FINAL) {
                LDS_FENCE();
                f32x4 acc = {0.f, 0.f, 0.f, 0.f};
#pragma unroll
                for (int kk = 0; kk < 4; ++kk) { const bf16x8 af = *(const LAS bf16x8*)(S + fr * 68 + 16 * kk + 4 * fq); acc = __builtin_amdgcn_mfma_f32_16x16x32_bf16(af, Cf[kk], acc, 0, 0, 0); }
#pragma unroll
                for (int i = 0; i < 4; ++i) { const int tl = 4 * fq + i; const float y = acc[i] + dsk * ul[cur * 256 + tl * 16 + fr];
                    const unsigned short hb = (unsigned short)(pk2(gelu_tanh(y), 0.f) & 0xffffu);
                    YG[(tok0 + blk * 16 + tl) * DM + g * 16 + fr] = hb; }
            }
            LDS_FENCE();
            if (blk + 1 < 32) *(LAS f32x4*)(ul + (cur ^ 1) * 256 + lane * 4) = nxt;
        }
        if (!FINAL) *(float2*)(HLOC + ((size_t)un * 64 + lane) * 2) = make_float2(hre, him);
    }
}

__device__ __forceinline__ void phase_rw_prep(const float* X, bf16_t* XDX) {
    const size_t nth = (size_t)gridDim.x * 512;
    for (size_t i = (size_t)blockIdx.x * 512 + otid(); i < (size_t)MTOK * 256; i += nth) {
        const int row = (int)(i >> 8), c4 = (int)(i & 255) * 4, t = row & (SEQL - 1);
        const float4 x = *(const float4*)(X + (size_t)row * DM + c4);
        float4 xp = make_float4(0.f, 0.f, 0.f, 0.f); if (t >= 1) xp = *(const float4*)(X + (size_t)(row - 1) * DM + c4);
        *(uint2*)(XDX + (size_t)row * 2048 + c4) = make_uint2(pk2(x.x, x.y), pk2(x.z, x.w));
        *(uint2*)(XDX + (size_t)row * 2048 + 1024 + c4) = make_uint2(pk2(xp.x - x.x, xp.y - x.y), pk2(xp.z - x.z, xp.w - x.w));
    }
}
__device__ __forceinline__ void unpack8(const uint4 v, float* f) { f[0] = bflo(v.x); f[1] = bfhi(v.x); f[2] = bflo(v.y); f[3] = bfhi(v.y); f[4] = bflo(v.z); f[5] = bfhi(v.z); f[6] = bflo(v.w); f[7] = bfhi(v.w); }

constexpr int RW_T = 32, RW_STEP = 336;
__device__ __forceinline__ void phase_rw_scan(const P& p, LAS unsigned char* lds_, const bf16_t* R, const bf16_t* K, const bf16_t* V, const bf16_t* DW, const bf16_t* DA, bf16_t* OUT) {
    LAS float* buf = (LAS float*)lds_;
    LAS float* obuf = (LAS float*)(lds_ + 2 * RW_T * RW_STEP * 4);
    const int tid = otid(), lane = tid & 63, wid = __builtin_amdgcn_readfirstlane(tid >> 6);
    for (int un = blockIdx.x; un < 256; un += gridDim.x) {
        const int bh = un >> 2, rg = un & 3, b = bh >> 4, h = bh & 15;
        __syncthreads();
        if (wid < 4) {
            const int rr = wid * 4 + (lane >> 4), j0 = (lane & 15) * 4;
            float s0 = 0.f, s1 = 0.f, s2 = 0.f, s3 = 0.f;
            __syncthreads();
            for (int c = 0; c < SEQL / RW_T; ++c) {
                const LAS float* cb = buf + (c & 1) * RW_T * RW_STEP; LAS float* ob = obuf + (c & 1) * RW_T * 16;
#pragma unroll 8
                for (int s = 0; s < RW_T; ++s) {
                    const LAS float* sb = cb + s * RW_STEP;
                    const f32x4 r4 = *(const LAS f32x4*)(sb + j0), w4 = *(const LAS f32x4*)(sb + 64 + j0), kp = *(const LAS f32x4*)(sb + 128 + j0);
                    const f32x4 kk = *(const LAS f32x4*)(sb + 192 + j0), ka = *(const LAS f32x4*)(sb + 256 + j0); const float vv = sb[320 + rr];
                    const float sa = -red16(s0 * kk.x + s1 * kk.y + s2 * kk.z + s3 * kk.w);
                    s0 = fmaf(s0, w4.x, fmaf(sa, ka.x, vv * kp.x)); s1 = fmaf(s1, w4.y, fmaf(sa, ka.y, vv * kp.y));
                    s2 = fmaf(s2, w4.z, fmaf(sa, ka.z, vv * kp.z)); s3 = fmaf(s3, w4.w, fmaf(sa, ka.w, vv * kp.w));
                    const float o = red16(s0 * r4.x + s1 * r4.y + s2 * r4.z + s3 * r4.w);
                    if ((lane & 15) == 0) ob[s * 16 + rr] = o;
                }
                __syncthreads();
            }
        } else {
            const int pt = tid - 256, s = pt >> 3, part = pt & 7, c0 = part * 8, ch = h * 64 + c0;
            float w0[8], a0[8], kk_[8], ka_[8];
#pragma unroll
            for (int i = 0; i < 8; ++i) { w0[i] = p.in[19][ch + i]; a0[i] = p.in[22][ch + i]; kk_[i] = p.in[25][ch + i]; ka_[i] = p.in[26][ch + i]; }
            for (int c = 0; c <= SEQL / RW_T; ++c) {
                if (c < SEQL / RW_T) {
                    const size_t row = (size_t)b * SEQL + (size_t)c * RW_T + s; const size_t o = row * DM + ch;
                    float r[8], k[8], dw[8], da[8];
                    unpack8(*(const uint4*)(R + o), r); unpack8(*(const uint4*)(K + o), k); unpack8(*(const uint4*)(DW + o), dw); unpack8(*(const uint4*)(DA + o), da);
                    float wv[8], kp[8], kk[8], ka[8]; float ss = 0.f;
#pragma unroll
                    for (int i = 0; i < 8; ++i) {
                        const float a = sigmoidf_(a0[i] + da[i]);
                        const float x = -(w0[i] + dw[i]);
                        const float sp = fmaxf(x, 0.f) + log1pf(__expf(-fabsf(x)));
                        wv[i] = __expf(-__expf(-sp - 0.5f));
                        kk[i] = k[i] * kk_[i]; ss += kk[i] * kk[i];
                        kp[i] = k[i] * (1.0f + (a - 1.0f) * ka_[i]); ka[i] = a;
                    }
                    ss = red8(ss); const float inv = 1.0f / fmaxf(sqrtf(ss), 1e-12f);
#pragma unroll
                    for (int i = 0; i < 8; ++i) { kk[i] *= inv; ka[i] *= kk[i]; }
                    LAS float* sb = buf + (c & 1) * RW_T * RW_STEP + s * RW_STEP + c0;
                    *(LAS f32x4*)(sb) = (f32x4){r[0], r[1], r[2], r[3]}; *(LAS f32x4*)(sb + 4) = (f32x4){r[4], r[5], r[6], r[7]};
                    *(LAS f32x4*)(sb + 64) = (f32x4){wv[0], wv[1], wv[2], wv[3]}; *(LAS f32x4*)(sb + 68) = (f32x4){wv[4], wv[5], wv[6], wv[7]};
                    *(LAS f32x4*)(sb + 128) = (f32x4){kp[0], kp[1], kp[2], kp[3]}; *(LAS f32x4*)(sb + 132) = (f32x4){kp[4], kp[5], kp[6], kp[7]};
                    *(LAS f32x4*)(sb + 192) = (f32x4){kk[0], kk[1], kk[2], kk[3]}; *(LAS f32x4*)(sb + 196) = (f32x4){kk[4], kk[5], kk[6], kk[7]};
                    *(LAS f32x4*)(sb + 256) = (f32x4){ka[0], ka[1], ka[2], ka[3]}; *(LAS f32x4*)(sb + 260) = (f32x4){ka[4], ka[5], ka[6], ka[7]};
                    if (part < 2) { float v[8]; unpack8(*(const uint4*)(V + row * DM + h * 64 + rg * 16 + part * 8), v);
                        LAS float* vb = buf + (c & 1) * RW_T * RW_STEP + s * RW_STEP + 320 + part * 8;
                        *(LAS f32x4*)(vb) = (f32x4){v[0], v[1], v[2], v[3]}; *(LAS f32x4*)(vb + 4) = (f32x4){v[4], v[5], v[6], v[7]}; }
                }
                if (c >= 2) {
                    const int cc = c - 2; const LAS float* ob = obuf + (cc & 1) * RW_T * 16 + s * 16 + part * 2;
                    const size_t row = (size_t)b * SEQL + (size_t)cc * RW_T + s;
                    *(unsigned*)(OUT + row * DM + h * 64 + rg * 16 + part * 2) = pk2(ob[0], ob[1]);
                }
                __syncthreads();
            }
            {
                const int cc = SEQL / RW_T - 1; const LAS float* ob = obuf + (cc & 1) * RW_T * 16 + s * 16 + part * 2;
                const size_t row = (size_t)b * SEQL + (size_t)cc * RW_T + s;
                *(unsigned*)(OUT + row * DM + h * 64 + rg * 16 + part * 2) = pk2(ob[0], ob[1]);
            }
        }
    }
}

__device__ __forceinline__ void phase_rw_post(const P& p, const bf16_t* OUT, const bf16_t* R, const bf16_t* K, const bf16_t* V, const bf16_t* DA, const bf16_t* SZ, bf16_t* OF) {
    const size_t nth = (size_t)gridDim.x * 512;
    for (size_t it = (size_t)blockIdx.x * 512 + otid(); it < (size_t)MTOK * 128; it += nth) {
        const int c0 = (int)(it & 127) * 8; const size_t o = (it >> 7) * DM + c0;
        float ov[8], r[8], k[8], v[8], da[8], sz[8];
        unpack8(*(const uint4*)(OUT + o), ov); unpack8(*(const uint4*)(R + o), r); unpack8(*(const uint4*)(K + o), k); unpack8(*(const uint4*)(V + o), v);
        unpack8(*(const uint4*)(DA + o), da); unpack8(*(const uint4*)(SZ + o), sz);
        float sm = 0.f, dot = 0.f;
#pragma unroll
        for (int i = 0; i < 8; ++i) { const float a = sigmoidf_(p.in[22][c0 + i] + da[i]); const float kp = k[i] * (1.0f + (a - 1.0f) * p.in[26][c0 + i]);
            dot += r[i] * kp * p.in[27][c0 + i]; sm += ov[i]; }
        dot = red8(dot); const float mean = red8(sm) * (1.0f / 64.0f);
        float q = 0.f;
#pragma unroll
        for (int i = 0; i < 8; ++i) { ov[i] -= mean; q += ov[i] * ov[i]; }
        const float rs = rsqrtf(red8(q) * (1.0f / 64.0f) + 64e-5f);
        float y[8];
#pragma unroll
        for (int i = 0; i < 8; ++i) y[i] = (ov[i] * rs * p.in[28][c0 + i] + p.in[29][c0 + i] + dot * v[i]) * sz[i];
        *(uint4*)(OF + o) = make_uint4(pk2(y[0], y[1]), pk2(y[2], y[3]), pk2(y[4], y[5]), pk2(y[6], y[7]));
    }
}

__global__ void __launch_bounds__(512, 2) fwd_mega(P p) {
    extern __shared__ __attribute__((aligned(16))) unsigned char shm[];
    LAS unsigned char* lds = (LAS unsigned char*)shm;
    LAS float* tile = (LAS float*)shm;
    cg::grid_group grid = cg::this_grid();
    unsigned char* ws = p.ws; float* X = p.out;
    bf16_t* act = (bf16_t*)(ws + ACT); bf16_t* pb = (bf16_t*)(ws + PB);
    phase_prep(p, tile);
    grid.sync();
#define LAYER_TAIL(L, Aout, Wout, Wpe, Wpg, PEB) \
    { EpiWout E; E.X = X; E.RB = act; run_gemm(lds, Aout, Wout, 1024, 1024, E); } \
    { EpiBf16 E; E.O = PEB; E.ldo = 1024; E.split = 1 << 20; E.stride = 0; run_gemm(lds, pb, Wpe, 1024, 256, E); } \
    grid.sync(); \
    { EpiPle E; E.X = X; E.PE = PEB; run_gemm(lds, act, Wpg, 1024, 1024, E); } \
    grid.sync(); \
    phase_ln(X, act, p.in[33] + (L) * 1024, p.in[34] + (L) * 1024);
#define CONV_LAYER(L, j) { \
        bf16_t* U = (bf16_t*)(ws + T0); bf16_t* G = (bf16_t*)(ws + T0 + 32 * MiB); \
        { EpiConvIn E; E.U = U; E.G = G; run_gemm(lds, act, (const bf16_t*)(ws + W_CIN), 4096, 1024, E); } \
        grid.sync(); \
        phase_conv_ew(U, G, p.in[3] + (size_t)(j) * 3 * 1024); \
        if ((L) > 0) cvt_pb(p.in[1] + (size_t)(L) * MTOK * 256, pb); \
        grid.sync(); \
        LAYER_TAIL(L, G, (const bf16_t*)(ws + W_COUT), (const bf16_t*)(ws + W_PEC), (const bf16_t*)(ws + W_PGC), (bf16_t*)(ws + T0 + 64 * MiB)) }
    CONV_LAYER(0, 0)
    grid.sync();
    {
        float* U = (float*)(ws + T0); bf16_t* SZ = (bf16_t*)(ws + T0 + 64 * MiB); bf16_t* YG = (bf16_t*)(ws + T0 + 96 * MiB); bf16_t* V = (bf16_t*)(ws + T0 + 128 * MiB);
        float* HL = (float*)(ws + T0 + 160 * MiB);
        { EpiSsmIn E; E.U = U; E.SZ = SZ; run_gemm(lds, act, (const bf16_t*)(ws + W_SIN), 2048, 1024, E); }
        grid.sync();
        phase_s5<0>(p, lds, U, HL, YG);
        cvt_pb(p.in[1] + (size_t)1 * MTOK * 256, pb);
        grid.sync();
        phase_s5<1>(p, lds, U, HL, YG);
        grid.sync();
        { EpiGlu E; E.YG = YG; E.SZ = SZ; E.bias = p.in[15]; E.V = V; run_gemm(lds, YG, (const bf16_t*)(ws + W_SGLU), 1024, 1024, E); }
        grid.sync();
        LAYER_TAIL(1, V, (const bf16_t*)(ws + W_SOUT), (const bf16_t*)(ws + W_PE1), (const bf16_t*)(ws + W_PG1), (bf16_t*)(ws + T0))
    }
    grid.sync();
    {
        bf16_t* XDX = (bf16_t*)(ws + T0); bf16_t* RKV = (bf16_t*)(ws + T0 + 64 * MiB);
        bf16_t* Rb = RKV; bf16_t* Kb = RKV + (size_t)MTOK * DM; bf16_t* Vb = RKV + (size_t)2 * MTOK * DM;
        bf16_t* SZ = act; bf16_t* L1 = pb; bf16_t* DW = (bf16_t*)(ws + T0); bf16_t* DA = (bf16_t*)(ws + T0 + 32 * MiB);
        bf16_t* OUT = (bf16_t*)(ws + OUT_RW); bf16_t* OF = (bf16_t*)(ws + T0);
        phase_rw_prep(X, XDX);
        grid.sync();
        { EpiRk E; E.RKV = RKV; E.SZ = SZ; E.L1 = L1; run_gemm(lds, XDX, (const bf16_t*)(ws + W_RK), 4352, 2048, E); }
        grid.sync();
        { EpiBf16 E; E.O = DW; E.ldo = 1024; E.split = 4; E.stride = (size_t)MTOK * DM; run_gemm(lds, L1, (const bf16_t*)(ws + W_L2), 2048, 256, E); }
        grid.sync();
        phase_rw_scan(p, lds, Rb, Kb, Vb, DW, DA, OUT);
        grid.sync();
        phase_rw_post(p, OUT, Rb, Kb, Vb, DA, SZ, OF);
        cvt_pb(p.in[1] + (size_t)2 * MTOK * 256, pb);
        grid.sync();
        LAYER_TAIL(2, OF, (const bf16_t*)(ws + W_ROUT), (const bf16_t*)(ws + W_PE2), (const bf16_t*)(ws + W_PG2), (bf16_t*)(ws + T0 + 32 * MiB))
        __syncthreads();
        conv_layer_weights(p, tile, 1, 3);
    }
    grid.sync();
    CONV_LAYER(3, 1)
}

extern "C" void kernel_launch(void* const* d_in, const int* in_sizes, int n_in, void* d_out, int out_size, void* d_ws, size_t ws_size, hipStream_t stream) {
    static int grid_blocks = 0;
    if (!grid_blocks) {
        int dev = 0, cus = 0, per_cu = 0;
        hipGetDevice(&dev);
        hipDeviceGetAttribute(&cus, hipDeviceAttributeMultiprocessorCount, dev);
        hipFuncSetAttribute((const void*)fwd_mega, hipFuncAttributeMaxDynamicSharedMemorySize, LDS_BYTES);
        hipOccupancyMaxActiveBlocksPerMultiprocessor(&per_cu, (const void*)fwd_mega, 512, LDS_BYTES);
        if (per_cu < 1) { fprintf(stderr, "occupancy query returned %d\n", per_cu); per_cu = 1; }
        grid_blocks = cus;
        if (ws_size < 256 * MiB) fprintf(stderr, "workspace too small: %zu\n", ws_size);
    }
    P p{};
    for (int i = 0; i < 35; ++i) p.in[i] = (const float*)d_in[i];
    p.out = (float*)d_out; p.ws = (unsigned char*)d_ws;
    void* args[] = {&p};
    hipError_t e = hipLaunchCooperativeKernel((const void*)fwd_mega, dim3(grid_blocks), dim3(512), args, LDS_BYTES, stream);
    if (e != hipSuccess) fprintf(stderr, "cooperative launch failed: %s (grid %d)\n", hipGetErrorString(e), grid_blocks);
}
```

```cpp
#include <hip/hip_runtime.h>
#include <hip/hip_cooperative_groups.h>
#include <cstdio>
namespace cg = cooperative_groups;
namespace pg8 {
#define PG8_LAS __attribute__((address_space(3)))
typedef unsigned short bf16_t;
typedef short bf16x8 __attribute__((ext_vector_type(8)));
typedef float f32x4 __attribute__((ext_vector_type(4)));
typedef unsigned u32x4 __attribute__((ext_vector_type(4)));
constexpr int BM = 256, BK = 64, HALF = 128, HTB = HALF * BK * 2  , STAGE_BYTES = 8 * HTB, NXCD = 8, WGM = 8;

__host__ __device__ __forceinline__ int lds_byte(int r, int c) { const int st = (r >> 4) * 2 + (c >> 5), rr = r & 15, cc = c & 31, ob = rr * 64 + cc * 2; return st * 1024 + (ob ^ (((ob >> 9) & 1) << 5)); }
__host__ __device__ __forceinline__ void stage_rc(int b, int& R, int& C) { const int st = b / 1024, sb = b % 1024, swz = sb ^ (((sb >> 9) & 1) << 5); R = (st >> 1) * 16 + swz / 64; C = (st & 1) * 32 + (swz % 64) / 2; }
__host__ __device__ __forceinline__ int perm32(int rho) { const int n = rho >> 4, i = rho & 15; return 8 * (i >> 2) + 4 * n + (i & 3); }

struct Unit { int pm, pn; };
struct Gemm { const bf16_t* A; const bf16_t* Bt; int M, N, K; };
struct StaticOrder {
    int nM, nN, nwg, G, c;
    __host__ __device__ void init(int M, int N, int G_, int c_) { nM = M / BM; nN = N / BM; nwg = nM * nN; G = G_; c = c_; }
    __host__ __device__ bool next(int i, Unit& u) const {
        const long L = (long)i * G + c; if (L >= nwg) return false;
        int wgid = (int)L; { const int q = nwg / NXCD, r = nwg % NXCD, xcd = wgid % NXCD, off = wgid / NXCD; wgid = (xcd < r ? xcd * (q + 1) : r * (q + 1) + (xcd - r) * q) + off; }
        const int nig = WGM * nN, gid = wgid / nig, fm = gid * WGM, gsz = (nM - fm) < WGM ? (nM - fm) : WGM;
        u.pm = fm + ((wgid % nig) % gsz); u.pn = (wgid % nig) / gsz; return true;
    }
    __device__ __forceinline__ void a_ready(const Unit&) const {}
    __device__ __forceinline__ void done(const Unit&) const {}
};
__device__ __forceinline__ unsigned cvt_pk_bf16(float lo, float hi) { unsigned r; asm volatile("v_cvt_pk_bf16_f32 %0, %1, %2" : "=v"(r) : "v"(lo), "v"(hi)); return r; }
template <class Epi, class Sched, bool STAMP = false>
__device__ __forceinline__ void gemm_phase(PG8_LAS unsigned char* lds, const Gemm g, const Sched& S, const Epi& E, unsigned long long* stamps) {
    int tid_o = threadIdx.x; asm volatile("" : "+v"(tid_o)); const int tid = tid_o, wid = __builtin_amdgcn_readfirstlane(tid >> 6), lane = tid & 63, wr = wid >> 2, wc = wid & 3, fr = lane & 15, fq = lane >> 4;
    const int K = g.K, nt = K / BK;
    int ts_lo = 0, ts_hi = 0, nts = 0; const unsigned long long rt_entry = STAMP ? (unsigned long long)wall_clock64() : 0ull;
#define PG8_STAMP() do { if (STAMP && wid == 0 && nts < 64) { const unsigned long long _c = (unsigned long long)clock64(); \
        ts_lo = (lane == nts) ? (int)(unsigned)_c : ts_lo; ts_hi = (lane == nts) ? (int)(unsigned)(_c >> 32) : ts_hi; ++nts; } } while (0)
    PG8_STAMP();
    unsigned voffA[2], voffB[2];
#pragma unroll
    for (int i = 0; i < 2; ++i) { int R, C; stage_rc(tid * 16 + i * 8192, R, C); const int Rb = Epi::PERM ? ((R & ~31) + perm32(R & 31)) : R;
        voffA[i] = (unsigned)(R * K + C) * 2u; voffB[i] = (unsigned)(Rb * K + C) * 2u; }
    const size_t kstep = (size_t)(BK * 2);
    const size_t hstep = (size_t)HALF * K * 2;
    const size_t tstep = 2 * hstep;
    const unsigned ldsw = (unsigned)wid * 1024u;
    const int aoff = lds_byte(wr * 64 + fr, fq * 8), boff = lds_byte(wc * 32 + fr, fq * 8);
#define PG8_SA(b, h) (((b) * 2 + (h)) * HTB)
#define PG8_SB(b, h) ((4 + (b) * 2 + (h)) * HTB)
#define PG8_STAGE(bufoff, gbase, voff) do { _Pragma("unroll") for (int _i = 0; _i < 2; ++_i) \
        __builtin_amdgcn_global_load_lds((const unsigned*)((const char*)(gbase) + (voff)[_i]), (PG8_LAS unsigned*)(lds + (bufoff) + ldsw + _i * 8192), 16, 0, 0); } while (0)
#define PG8_LDA(dst, b, h) do { _Pragma("unroll") for (int m = 0; m < 4; ++m) _Pragma("unroll") for (int k = 0; k < 2; ++k) dst[m][k] = *(const PG8_LAS bf16x8*)(lds + PG8_SA(b, h) + aoff + m * 2048 + k * 1024); } while (0)
#define PG8_LDB(dst, b, h) do { _Pragma("unroll") for (int n = 0; n < 2; ++n) _Pragma("unroll") for (int k = 0; k < 2; ++k) dst[n][k] = *(const PG8_LAS bf16x8*)(lds + PG8_SB(b, h) + boff + n * 2048 + k * 1024); } while (0)
#define PG8_MMA(ai, bj, At, Bt) do { __builtin_amdgcn_s_setprio(1); _Pragma("unroll") for (int m = 0; m < 4; ++m) _Pragma("unroll") for (int n = 0; n < 2; ++n) _Pragma("unroll") for (int k = 0; k < 2; ++k) \
        acc[ai][bj][m][n] = __builtin_amdgcn_mfma_f32_16x16x32_bf16(Bt[n][k], At[m][k], acc[ai][bj][m][n], 0, 0, 0); __builtin_amdgcn_s_setprio(0); } while (0)
#define PG8_WAIT_V(n) asm volatile("s_waitcnt vmcnt(" #n ")" ::: "memory")
#define PG8_WAIT_L(n) asm volatile("s_waitcnt lgkmcnt(" #n ")" ::: "memory")
#define PG8_BAR __builtin_amdgcn_s_barrier()
#define PG8_SCHED __builtin_amdgcn_sched_barrier(0)
    Unit cur, nxt; int ui = 0;
    if (!S.next(0, cur)) return;
    f32x4 acc[2][2][4][2];
#pragma unroll
    for (int a = 0; a < 2; ++a)
#pragma unroll
        for (int b = 0; b < 2; ++b)
#pragma unroll
            for (int m = 0; m < 4; ++m)
#pragma unroll
                for (int n = 0; n < 2; ++n) acc[a][b][m][n] = (f32x4){0.f, 0.f, 0.f, 0.f};
    bf16x8 At[4][2], B0[2][2], B1[2][2];
    const char* cA = (const char*)g.A + (size_t)cur.pm * tstep; const char* cB = (const char*)g.Bt + (size_t)cur.pn * tstep;
    S.a_ready(cur);
    PG8_STAGE(PG8_SB(0, 0), cB, voffB); PG8_STAGE(PG8_SA(0, 0), cA, voffA); PG8_STAGE(PG8_SB(0, 1), cB + hstep, voffB); PG8_STAGE(PG8_SA(0, 1), cA + hstep, voffA);
    if (wr == 1) PG8_BAR;
    PG8_WAIT_V(4); PG8_BAR;
    PG8_STAGE(PG8_SB(1, 0), cB + kstep, voffB); PG8_STAGE(PG8_SA(1, 0), cA + kstep, voffA); PG8_STAGE(PG8_SB(1, 1), cB + hstep + kstep, voffB);
    PG8_WAIT_V(6); PG8_BAR;
    PG8_STAMP();
    for (;;) {
        const bool has_next = S.next(ui + 1, nxt);
        const char* nA = has_next ? (const char*)g.A + (size_t)nxt.pm * tstep : cA; const char* nB = has_next ? (const char*)g.Bt + (size_t)nxt.pn * tstep : cB;
        for (int t = 0; t < nt; t += 2) {
            const bool last = (t == nt - 2);
            const char* a1 = cA + (size_t)(t + 1) * kstep;
            const char* a2 = last ? nA : cA + (size_t)(t + 2) * kstep; const char* b2 = last ? nB : cB + (size_t)(t + 2) * kstep;
            const char* a3 = a2 + kstep; const char* b3 = b2 + kstep;
            if (last && has_next) S.a_ready(nxt);
            PG8_LDB(B0, 0, 0); PG8_SCHED; PG8_LDA(At, 0, 0); PG8_STAGE(PG8_SA(1, 1), a1 + hstep, voffA);
            PG8_WAIT_L(8); PG8_BAR; PG8_WAIT_L(0); PG8_MMA(0, 0, At, B0); PG8_BAR; PG8_SCHED;
            PG8_LDB(B1, 0, 1); PG8_STAGE(PG8_SB(0, 0), b2, voffB);
            PG8_BAR; PG8_WAIT_L(0); PG8_MMA(0, 1, At, B1); PG8_BAR;
            PG8_LDA(At, 0, 1); PG8_STAGE(PG8_SA(0, 0), a2, voffA);
            PG8_BAR; PG8_WAIT_L(0); PG8_MMA(1, 0, At, B0); PG8_BAR; PG8_SCHED;
            PG8_STAGE(PG8_SB(0, 1), b2 + hstep, voffB);
            PG8_WAIT_V(6); PG8_BAR; PG8_MMA(1, 1, At, B1); PG8_BAR;
            PG8_LDB(B0, 1, 0); PG8_SCHED; PG8_LDA(At, 1, 0); PG8_STAGE(PG8_SA(0, 1), a2 + hstep, voffA);
            PG8_WAIT_L(8); PG8_BAR; PG8_WAIT_L(0); PG8_MMA(0, 0, At, B0); PG8_BAR; PG8_SCHED;
            PG8_LDB(B1, 1, 1); PG8_STAGE(PG8_SB(1, 0), b3, voffB);
            PG8_BAR; PG8_WAIT_L(0); PG8_MMA(0, 1, At, B1); PG8_BAR;
            PG8_LDA(At, 1, 1); PG8_STAGE(PG8_SA(1, 0), a3, voffA);
            PG8_BAR; PG8_WAIT_L(0); PG8_MMA(1, 0, At, B0); PG8_BAR; PG8_SCHED;
            PG8_STAGE(PG8_SB(1, 1), b3 + hstep, voffB);
            PG8_WAIT_V(6); PG8_BAR; PG8_MMA(1, 1, At, B1); PG8_BAR;
        }
        PG8_STAMP();
        if constexpr (!Epi::AFTER_DRAIN) { E(acc, cur, wr, wc, fr, fq); S.done(cur); }
        PG8_STAMP();
        if (!has_next) break;
#pragma unroll
        for (int a = 0; a < 2; ++a)
#pragma unroll
            for (int b = 0; b < 2; ++b)
#pragma unroll
                for (int m = 0; m < 4; ++m)
#pragma unroll
                    for (int n = 0; n < 2; ++n) acc[a][b][m][n] = (f32x4){0.f, 0.f, 0.f, 0.f};
        cur = nxt; cA = nA; cB = nB; ++ui;
    }
    PG8_WAIT_V(0);
    if (wr == 0) PG8_BAR;
    PG8_BAR;
    if constexpr (Epi::AFTER_DRAIN) { E.fused(acc, cur, wr, wc, fr, fq, lds, wid, lane); S.done(cur); }
    PG8_STAMP();
    if (STAMP && wid == 0) { stamps[lane] = lane < nts ? (((unsigned long long)(unsigned)ts_hi << 32) | (unsigned)ts_lo) : 0ull;
        if (lane == 62) stamps[62] = rt_entry; if (lane == 63) stamps[63] = (unsigned long long)wall_clock64(); }
#undef PG8_STAMP
#undef PG8_SA
#undef PG8_SB
#undef PG8_STAGE
#undef PG8_LDA
#undef PG8_LDB
#undef PG8_MMA
#undef PG8_WAIT_V
#undef PG8_WAIT_L
#undef PG8_BAR
#undef PG8_SCHED
}
}
using pg8::bf16_t; using pg8::bf16x8; using pg8::f32x4; using pg8::Unit; using pg8::Gemm; using pg8::StaticOrder;
#define LAS __attribute__((address_space(3)))
constexpr int MTOK = 16384, DM = 1024, SEQL = 4096;
constexpr size_t MiB = 1u << 20, KiB = 1u << 10;
constexpr float DN_ALPHA = 1.6817928305074290f;
constexpr size_t W_CIN = 0, W_COUT = 8 * MiB, W_PEC = 10 * MiB, W_PGC = 10 * MiB + 512 * KiB;
constexpr size_t W_SIN = 12 * MiB + 512 * KiB, W_SGLU = 16 * MiB + 512 * KiB, W_SOUT = 18 * MiB + 512 * KiB, W_PE1 = 20 * MiB + 512 * KiB, W_PG1 = 21 * MiB;
constexpr size_t W_RK = 23 * MiB, W_L2 = 40 * MiB, W_ROUT = 41 * MiB, W_PE2 = 43 * MiB, W_PG2 = 43 * MiB + 512 * KiB;
constexpr size_t OUT_RW = 0, PB = 46 * MiB, ACT = 54 * MiB, T0 = 86 * MiB;
constexpr int LDS_BYTES = 131072 + 16;
#ifndef DUP_PREP
#define DUP_PREP 0
#define DUP_RWSCAN 0
#define DUP_S5 0
#define DUP_RK 0
#define DUP_SYNC 0
#define DUP_EW 0
#endif

struct P { const float* in[35]; float* out; unsigned char* ws; };
#define XB_TMO      128
#define XB_XCNT(j)  (256  + 64 * (j))
#define XB_XSUB(j)  (1280 + 64 * (j))
#define XB_XGEN(j)  (2304 + 64 * (j))
#define XB_TOP      3328
#define XB_TOPGEN   3392
#define XCD_BAR_WORDS 3456
#define XB_SPIN_CAP (1u << 18)

__device__ __forceinline__ unsigned xb_ld(unsigned* p)              { return __hip_atomic_load(p, __ATOMIC_RELAXED, __HIP_MEMORY_SCOPE_AGENT); }
__device__ __forceinline__ unsigned xb_add(unsigned* p, unsigned v) { return __hip_atomic_fetch_add(p, v, __ATOMIC_RELAXED, __HIP_MEMORY_SCOPE_AGENT); }
__device__ __forceinline__ unsigned xb_xcc_id() { return (unsigned)__builtin_amdgcn_s_getreg((3 << 11) | 20) & 0xFu; }
#define XB_SPIN(cond, bar) do { unsigned _sp = 0; while (cond) { __builtin_amdgcn_s_sleep(1); \
    if ((++_sp & 255u) == 0u) { if (xb_ld(&(bar)[XB_TMO])) break; if (_sp > XB_SPIN_CAP) { atomicAdd(&(bar)[XB_TMO], 1u); break; } } } } while (0)

struct XcdBarrier {
    unsigned* bar; unsigned x;
    volatile LAS unsigned* st;
};

__device__ __forceinline__ XcdBarrier xcd_barrier_post(unsigned* bar, volatile LAS unsigned* st) {
    XcdBarrier b; b.bar = bar; b.x = xb_xcc_id(); b.st = st;
    if (threadIdx.x == 0) (void)xb_add(&bar[XB_XCNT(b.x)], 1u);
    return b;
}
__device__ __forceinline__ void xcd_barrier_complete(unsigned* bar, unsigned x, unsigned& nloc, unsigned& nx) {
    const unsigned G = gridDim.x * gridDim.y * gridDim.z;
    unsigned sum, cnt, mine, sp = 0u;
    for (;;) {
        sum = 0u; cnt = 0u; mine = 0u;
#pragma unroll
        for (unsigned j = 0; j < 16; ++j) { const unsigned c = xb_ld(&bar[XB_XCNT(j)]); sum += c; cnt += (c > 0u) ? 1u : 0u; mine = (j == x) ? c : mine; }
        if (sum == G) break;
        __builtin_amdgcn_s_sleep(1);
        if ((++sp & 255u) == 0u) { if (xb_ld(&bar[XB_TMO])) break; if (sp > XB_SPIN_CAP) { atomicAdd(&bar[XB_TMO], 1u); break; } }
    }
    nloc = mine > 0u ? mine : 1u; nx = cnt > 0u ? cnt : 1u;
}

__device__ __forceinline__ void xcd_barrier(const XcdBarrier& b) {
    asm volatile("s_waitcnt vmcnt(0)" ::: "memory");
    __syncthreads();
    if (threadIdx.x == 0) {
        unsigned* bar = b.bar;
        __builtin_amdgcn_s_waitcnt(0);
        unsigned nloc = b.st[0], nx = b.st[1];
        if (nloc == 0u) { xcd_barrier_complete(bar, b.x, nloc, nx); b.st[0] = nloc; b.st[1] = nx; }
        const unsigned old = xb_add(&bar[XB_XSUB(b.x)], 1u);
        const unsigned gen = old / nloc;
        if (old + 1u == (gen + 1u) * nloc) {
            __builtin_amdgcn_fence(__ATOMIC_RELEASE, "agent");
            asm volatile("s_waitcnt vmcnt(0)" ::: "memory");
            const unsigned og = xb_add(&bar[XB_TOP], 1u);
            const unsigned tg = og / nx;
            if (og + 1u == (tg + 1u) * nx) xb_add(&bar[XB_TOPGEN], 1u);
            else XB_SPIN(xb_ld(&bar[XB_TOPGEN]) == tg, bar);
            __builtin_amdgcn_fence(__ATOMIC_ACQUIRE, "agent");
            xb_add(&bar[XB_XGEN(b.x)], 1u);
            asm volatile("s_waitcnt vmcnt(0)" ::: "memory");
        } else {
            XB_SPIN(xb_ld(&bar[XB_XGEN(b.x)]) == gen, bar);
            __builtin_amdgcn_fence(__ATOMIC_ACQUIRE, "agent");
            asm volatile("s_waitcnt vmcnt(0)" ::: "memory");
        }
    }
    __syncthreads();
}

constexpr size_t BAR_OFF = 254 * MiB;


__device__ __forceinline__ unsigned pk2(float lo, float hi) { return pg8::cvt_pk_bf16(lo, hi); }
__device__ __forceinline__ float bflo(unsigned u) { return __uint_as_float(u << 16); }
__device__ __forceinline__ float bfhi(unsigned u) { return __uint_as_float(u & 0xffff0000u); }
__device__ __forceinline__ float sigmoidf_(float x) { return 1.0f / (1.0f + __expf(-x)); }
__device__ __forceinline__ float siluf_(float x) { return x / (1.0f + __expf(-x)); }
__device__ __forceinline__ float tanhf_(float x) { const float e = __expf(-2.0f * fabsf(x)); const float t = (1.0f - e) / (1.0f + e); return x < 0.f ? -t : t; }
__device__ __forceinline__ float gelu_tanh(float x) { return 0.5f * x * (1.0f + tanhf_(0.7978845608028654f * (x + 0.044715f * x * x * x))); }
template <int CTRL> __device__ __forceinline__ float dppf(float x) { return __int_as_float(__builtin_amdgcn_update_dpp(0, __float_as_int(x), CTRL, 0xF, 0xF, true)); }
__device__ __forceinline__ float red8(float x) { x += dppf<0xB1>(x); x += dppf<0x4E>(x); x += dppf<0x141>(x); return x; }
__device__ __forceinline__ float red16(float x) { x = red8(x); x += dppf<0x140>(x); return x; }
__device__ __forceinline__ float wave_sum(float v) { for (int o = 32; o >= 1; o >>= 1) v += __shfl_xor(v, o); return v; }
__device__ __forceinline__ int otid() { int t = threadIdx.x; asm volatile("" : "+v"(t)); return t; }
#define LDS_FENCE() asm volatile("s_waitcnt lgkmcnt(0)" ::: "memory")

struct EpiConvIn {
    static constexpr bool PERM = false, AFTER_DRAIN = false;
    bf16_t* U; bf16_t* G;
    __device__ __forceinline__ void operator()(const f32x4 (&acc)[2][2][4][2], const Unit& u, int wr, int wc, int fr, int fq) const {
        const int row0 = u.pm * 256 + wr * 64 + fr, e0 = u.pn * 64 + wc * 16 + 4 * fq;
#pragma unroll
        for (int ai = 0; ai < 2; ++ai)
#pragma unroll
            for (int m = 0; m < 4; ++m) {
                const size_t o = (size_t)(row0 + ai * 128 + m * 16) * DM + e0;
                float uu[4], gg[4];
#pragma unroll
                for (int j = 0; j < 4; ++j) { uu[j] = acc[ai][0][m][1][j] * acc[ai][1][m][0][j]; gg[j] = acc[ai][0][m][0][j] * siluf_(acc[ai][1][m][1][j]); }
                *(uint2*)(U + o) = make_uint2(pk2(uu[0], uu[1]), pk2(uu[2], uu[3]));
                *(uint2*)(G + o) = make_uint2(pk2(gg[0], gg[1]), pk2(gg[2], gg[3]));
            }
    }
};
struct EpiWout {
    static constexpr bool PERM = false, AFTER_DRAIN = false;
    float* X; bf16_t* RB;
    __device__ __forceinline__ void operator()(const f32x4 (&acc)[2][2][4][2], const Unit& u, int wr, int wc, int fr, int fq) const {
        const int row0 = u.pm * 256 + wr * 64 + fr, col0 = u.pn * 256 + wc * 32 + 4 * fq;
#pragma unroll
        for (int ai = 0; ai < 2; ++ai)
#pragma unroll
            for (int m = 0; m < 4; ++m)
#pragma unroll
                for (int bj = 0; bj < 2; ++bj)
#pragma unroll
                    for (int n = 0; n < 2; ++n) {
                        const size_t o = (size_t)(row0 + ai * 128 + m * 16) * DM + col0 + bj * 128 + n * 16;
                        f32x4 x = *(const f32x4*)(X + o);
                        f32x4 r = x * DN_ALPHA + acc[ai][bj][m][n];
                        *(f32x4*)(X + o) = r;
                        *(uint2*)(RB + o) = make_uint2(pk2(r[0], r[1]), pk2(r[2], r[3]));
                    }
    }
};
struct EpiBf16 {
    static constexpr bool PERM = false, AFTER_DRAIN = false;
    bf16_t* O; int ldo; int split; size_t stride;
    __device__ __forceinline__ void operator()(const f32x4 (&acc)[2][2][4][2], const Unit& u, int wr, int wc, int fr, int fq) const {
        const int row0 = u.pm * 256 + wr * 64 + fr; const int grp = u.pn / split; const int col0 = (u.pn - grp * split) * 256 + wc * 32 + 4 * fq;
        bf16_t* base = O + (size_t)grp * stride;
#pragma unroll
        for (int ai = 0; ai < 2; ++ai)
#pragma unroll
            for (int m = 0; m < 4; ++m)
#pragma unroll
                for (int bj = 0; bj < 2; ++bj)
#pragma unroll
                    for (int n = 0; n < 2; ++n) {
                        const size_t o = (size_t)(row0 + ai * 128 + m * 16) * ldo + col0 + bj * 128 + n * 16;
                        const f32x4 a = acc[ai][bj][m][n];
                        *(uint2*)(base + o) = make_uint2(pk2(a[0], a[1]), pk2(a[2], a[3]));
                    }
    }
};
struct EpiPle {
    static constexpr bool PERM = false, AFTER_DRAIN = false;
    float* X; const bf16_t* PE;
    __device__ __forceinline__ void operator()(const f32x4 (&acc)[2][2][4][2], const Unit& u, int wr, int wc, int fr, int fq) const {
        const int row0 = u.pm * 256 + wr * 64 + fr, col0 = u.pn * 256 + wc * 32 + 4 * fq;
#pragma unroll
        for (int ai = 0; ai < 2; ++ai)
#pragma unroll
            for (int m = 0; m < 4; ++m)
#pragma unroll
                for (int bj = 0; bj < 2; ++bj)
#pragma unroll
                    for (int n = 0; n < 2; ++n) {
                        const size_t o = (size_t)(row0 + ai * 128 + m * 16) * DM + col0 + bj * 128 + n * 16;
                        f32x4 x = *(const f32x4*)(X + o); const uint2 pe = *(const uint2*)(PE + o); const f32x4 a = acc[ai][bj][m][n];
                        x[0] += bflo(pe.x) * sigmoidf_(a[0]); x[1] += bfhi(pe.x) * sigmoidf_(a[1]); x[2] += bflo(pe.y) * sigmoidf_(a[2]); x[3] += bfhi(pe.y) * sigmoidf_(a[3]);
                        *(f32x4*)(X + o) = x;
                    }
    }
};
struct EpiSsmIn {
    static constexpr bool PERM = false, AFTER_DRAIN = false;
    float* U; bf16_t* SZ;
    __device__ __forceinline__ void operator()(const f32x4 (&acc)[2][2][4][2], const Unit& u, int wr, int wc, int fr, int fq) const {
        const int row0 = u.pm * 256 + wr * 64 + fr; const bool isz = u.pn >= 4; const int col0 = (u.pn & 3) * 256 + wc * 32 + 4 * fq;
#pragma unroll
        for (int ai = 0; ai < 2; ++ai)
#pragma unroll
            for (int m = 0; m < 4; ++m)
#pragma unroll
                for (int bj = 0; bj < 2; ++bj)
#pragma unroll
                    for (int n = 0; n < 2; ++n) {
                        const size_t o = (size_t)(row0 + ai * 128 + m * 16) * DM + col0 + bj * 128 + n * 16;
                        const f32x4 a = acc[ai][bj][m][n];
                        if (isz) *(uint2*)(SZ + o) = make_uint2(pk2(siluf_(a[0]), siluf_(a[1])), pk2(siluf_(a[2]), siluf_(a[3])));
                        else *(f32x4*)(U + o) = a;
                    }
    }
};
struct EpiGlu {
    static constexpr bool PERM = false, AFTER_DRAIN = false;
    const bf16_t* YG; const bf16_t* SZ; const float* bias; bf16_t* V;
    __device__ __forceinline__ void operator()(const f32x4 (&acc)[2][2][4][2], const Unit& u, int wr, int wc, int fr, int fq) const {
        const int row0 = u.pm * 256 + wr * 64 + fr, col0 = u.pn * 256 + wc * 32 + 4 * fq;
#pragma unroll
        for (int ai = 0; ai < 2; ++ai)
#pragma unroll
            for (int m = 0; m < 4; ++m)
#pragma unroll
                for (int bj = 0; bj < 2; ++bj)
#pragma unroll
                    for (int n = 0; n < 2; ++n) {
                        const int col = col0 + bj * 128 + n * 16;
                        const size_t o = (size_t)(row0 + ai * 128 + m * 16) * DM + col;
                        const f32x4 a = acc[ai][bj][m][n]; const f32x4 bb = *(const f32x4*)(bias + col);
                        const uint2 y = *(const uint2*)(YG + o), z = *(const uint2*)(SZ + o);
                        const float v0 = bflo(y.x) * sigmoidf_(a[0] + bb[0]) * bflo(z.x), v1 = bfhi(y.x) * sigmoidf_(a[1] + bb[1]) * bfhi(z.x);
                        const float v2 = bflo(y.y) * sigmoidf_(a[2] + bb[2]) * bflo(z.y), v3 = bfhi(y.y) * sigmoidf_(a[3] + bb[3]) * bfhi(z.y);
                        *(uint2*)(V + o) = make_uint2(pk2(v0, v1), pk2(v2, v3));
                    }
    }
};
struct EpiRk {
    static constexpr bool PERM = false, AFTER_DRAIN = false;
    bf16_t* RKV; bf16_t* SZ; bf16_t* L1;
    __device__ __forceinline__ void operator()(const f32x4 (&acc)[2][2][4][2], const Unit& u, int wr, int wc, int fr, int fq) const {
        const int row0 = u.pm * 256 + wr * 64 + fr; const int grp = u.pn >> 2; const int colt = (u.pn & 3) * 256 + wc * 32 + 4 * fq;
#pragma unroll
        for (int ai = 0; ai < 2; ++ai)
#pragma unroll
            for (int m = 0; m < 4; ++m)
#pragma unroll
                for (int bj = 0; bj < 2; ++bj)
#pragma unroll
                    for (int n = 0; n < 2; ++n) {
                        const int row = row0 + ai * 128 + m * 16, col = colt + bj * 128 + n * 16;
                        const f32x4 a = acc[ai][bj][m][n];
                        if (grp < 3) *(uint2*)(RKV + (size_t)grp * MTOK * DM + (size_t)row * DM + col) = make_uint2(pk2(a[0], a[1]), pk2(a[2], a[3]));
                        else if (grp == 3) *(uint2*)(SZ + (size_t)row * DM + col) = make_uint2(pk2(siluf_(a[0]), siluf_(a[1])), pk2(siluf_(a[2]), siluf_(a[3])));
                        else { const bool th = col < 64;
                            const float v0 = th ? tanhf_(a[0]) : a[0], v1 = th ? tanhf_(a[1]) : a[1], v2 = th ? tanhf_(a[2]) : a[2], v3 = th ? tanhf_(a[3]) : a[3];
                            *(uint2*)(L1 + (size_t)row * 256 + col) = make_uint2(pk2(v0, v1), pk2(v2, v3)); }
                    }
    }
};

template <class Epi> __device__ __forceinline__ void run_gemm(LAS unsigned char* lds, const bf16_t* A, const bf16_t* Bt, int N, int K, const Epi& E) {
    Gemm g; g.A = A; g.Bt = Bt; g.M = MTOK; g.N = N; g.K = K;
    StaticOrder S; S.init(MTOK, N, (int)gridDim.x, (int)blockIdx.x);
    pg8::gemm_phase<Epi, StaticOrder, false>(lds, g, S, E, nullptr);
}

__device__ __forceinline__ int conv_rowmap(int n) { const int s = n >> 10, e = n & 1023, q = e & 63; return 256 * (e >> 6) + 128 * (s >> 1) + 32 * (q >> 4) + 16 * (s & 1) + (q & 15); }
__device__ __forceinline__ void tr_job(LAS float* tile, const float* src, int ld_src, int K, int N, bf16_t* dst, int ldd, int koff, const float* kscale, int mode, int rot) {
    const int nblk = (int)gridDim.x, blk = ((int)blockIdx.x + rot) % nblk, tid = otid();
    const int tn_ = N >> 6, ntiles = (K >> 6) * tn_;
    for (int t = blk; t < ntiles; t += nblk) {
        const int k0 = (t / tn_) << 6, n0 = (t % tn_) << 6;
        __syncthreads();
#pragma unroll
        for (int i = 0; i < 8; ++i) { const int tk = (tid >> 6) + i * 8, tn = tid & 63; tile[tk * 65 + tn] = src[(size_t)(k0 + tk) * ld_src + n0 + tn]; }
        __syncthreads();
        const int nl = tid >> 3, kp = (tid & 7) * 8;
        float v[8];
#pragma unroll
        for (int i = 0; i < 8; ++i) { v[i] = tile[(kp + i) * 65 + nl]; if (kscale) v[i] *= kscale[k0 + kp + i]; }
        const int n = n0 + nl; const int row = mode ? conv_rowmap(n) : n;
        *(uint4*)(dst + (size_t)row * ldd + koff + k0 + kp) = make_uint4(pk2(v[0], v[1]), pk2(v[2], v[3]), pk2(v[4], v[5]), pk2(v[6], v[7]));
    }
}
__device__ __forceinline__ void cvt_pb(const float* src, bf16_t* dst) {
    const size_t n4 = (size_t)MTOK * 256 / 4, nth = (size_t)gridDim.x * 512;
    for (size_t i = (size_t)blockIdx.x * 512 + otid(); i < n4; i += nth) { const float4 v = ((const float4*)src)[i]; ((uint2*)dst)[i] = make_uint2(pk2(v.x, v.y), pk2(v.z, v.w)); }
}
__device__ __forceinline__ void conv_layer_weights(const P& p, LAS float* tile, int j, int L) {
    unsigned char* ws = p.ws;
    tr_job(tile, p.in[2] + (size_t)j * 1024 * 4096, 4096, 1024, 4096, (bf16_t*)(ws + W_CIN), 1024, 0, nullptr, 1, 0);
    tr_job(tile, p.in[4] + (size_t)j * 1024 * 1024, 1024, 1024, 1024, (bf16_t*)(ws + W_COUT), 1024, 0, nullptr, 0, 0);
    tr_job(tile, p.in[31] + (size_t)L * 256 * 1024, 1024, 256, 1024, (bf16_t*)(ws + W_PEC), 256, 0, nullptr, 0, 0);
    tr_job(tile, p.in[32] + (size_t)L * 1024 * 1024, 1024, 1024, 1024, (bf16_t*)(ws + W_PGC), 1024, 0, nullptr, 0, 64);
}

__device__ __forceinline__ void phase_prep(const P& p, LAS float* tile) {
    unsigned char* ws = p.ws; const size_t nth = (size_t)gridDim.x * 512, gt = (size_t)blockIdx.x * 512 + otid();
    {
        const float4* x = (const float4*)p.in[0]; float4* o = (float4*)p.out; uint2* a = (uint2*)(ws + ACT);
        for (size_t i = gt; i < (size_t)MTOK * DM / 4; i += nth) { const float4 v = x[i]; o[i] = v; a[i] = make_uint2(pk2(v.x, v.y), pk2(v.z, v.w)); }
    }
    cvt_pb(p.in[1], (bf16_t*)(ws + PB));
    conv_layer_weights(p, tile, 0, 0);
    tr_job(tile, p.in[5], 2048, 1024, 2048, (bf16_t*)(ws + W_SIN), 1024, 0, nullptr, 0, 128);
    tr_job(tile, p.in[14], 1024, 1024, 1024, (bf16_t*)(ws + W_SGLU), 1024, 0, nullptr, 0, 0);
    tr_job(tile, p.in[16], 1024, 1024, 1024, (bf16_t*)(ws + W_SOUT), 1024, 0, nullptr, 0, 0);
    tr_job(tile, p.in[31] + (size_t)1 * 256 * 1024, 1024, 256, 1024, (bf16_t*)(ws + W_PE1), 256, 0, nullptr, 0, 192);
    tr_job(tile, p.in[32] + (size_t)1 * 1024 * 1024, 1024, 1024, 1024, (bf16_t*)(ws + W_PG1), 1024, 0, nullptr, 0, 0);
    bf16_t* rk = (bf16_t*)(ws + W_RK);
    for (int g = 0; g < 4; ++g) {
        tr_job(tile, p.in[18] + (size_t)g * 1024 * 1024, 1024, 1024, 1024, rk + (size_t)g * 1024 * 2048, 2048, 0, nullptr, 0, 0);
        tr_job(tile, p.in[18] + (size_t)g * 1024 * 1024, 1024, 1024, 1024, rk + (size_t)g * 1024 * 2048, 2048, 1024, p.in[17] + g * 1024, 0, 0);
    }
    tr_job(tile, p.in[20], 64, 1024, 64, rk + (size_t)4096 * 2048, 2048, 0, nullptr, 0, 0);
    tr_job(tile, p.in[20], 64, 1024, 64, rk + (size_t)4096 * 2048, 2048, 1024, p.in[17] + 4 * 1024, 0, 16);
    tr_job(tile, p.in[23], 64, 1024, 64, rk + (size_t)4160 * 2048, 2048, 0, nullptr, 0, 32);
    tr_job(tile, p.in[23], 64, 1024, 64, rk + (size_t)4160 * 2048, 2048, 1024, p.in[17] + 5 * 1024, 0, 48);
    {
        uint4* z = (uint4*)(rk + (size_t)4224 * 2048);
        for (size_t i = gt; i < (size_t)128 * 2048 / 8; i += nth) z[i] = make_uint4(0, 0, 0, 0);
    }
    bf16_t* l2 = (bf16_t*)(ws + W_L2);
    tr_job(tile, p.in[21], 1024, 64, 1024, l2, 256, 0, nullptr, 0, 64);
    tr_job(tile, p.in[24], 1024, 64, 1024, l2 + (size_t)1024 * 256, 256, 64, nullptr, 0, 80);
    for (size_t i = gt; i < (size_t)2048 * 32; i += nth) { const int row = (int)(i >> 5), c8 = (int)(i & 31); const bool data = row < 1024 ? (c8 < 8) : (c8 >= 8 && c8 < 16);
        if (!data) *(uint4*)(l2 + (size_t)row * 256 + c8 * 8) = make_uint4(0, 0, 0, 0); }
    tr_job(tile, p.in[30], 1024, 1024, 1024, (bf16_t*)(ws + W_ROUT), 1024, 0, nullptr, 0, 96);
    tr_job(tile, p.in[31] + (size_t)2 * 256 * 1024, 1024, 256, 1024, (bf16_t*)(ws + W_PE2), 256, 0, nullptr, 0, 160);
    tr_job(tile, p.in[32] + (size_t)2 * 1024 * 1024, 1024, 1024, 1024, (bf16_t*)(ws + W_PG2), 1024, 0, nullptr, 0, 0);
}

__device__ __forceinline__ void phase_conv_ew(const bf16_t* U, bf16_t* G, const float* ck) {
    const size_t nth = (size_t)gridDim.x * 512;
    for (size_t i = (size_t)blockIdx.x * 512 + otid(); i < (size_t)MTOK * 128; i += nth) {
        const int row = (int)(i >> 7), c8 = (int)(i & 127) * 8, t = row & (SEQL - 1);
        const uint4 z4 = make_uint4(0, 0, 0, 0);
        const uint4 u0 = *(const uint4*)(U + (size_t)row * DM + c8);
        const uint4 u1 = t >= 1 ? *(const uint4*)(U + (size_t)(row - 1) * DM + c8) : z4;
        const uint4 u2 = t >= 2 ? *(const uint4*)(U + (size_t)(row - 2) * DM + c8) : z4;
        const uint4 g = *(const uint4*)(G + (size_t)row * DM + c8);
        const unsigned a0[4] = {u0.x, u0.y, u0.z, u0.w}, a1[4] = {u1.x, u1.y, u1.z, u1.w}, a2[4] = {u2.x, u2.y, u2.z, u2.w}, gg[4] = {g.x, g.y, g.z, g.w};
        unsigned o[4];
#pragma unroll
        for (int q = 0; q < 4; ++q) {
            const int c = c8 + 2 * q;
            const float lo = bflo(gg[q]) * (ck[c] * bflo(a2[q]) + ck[1024 + c] * bflo(a1[q]) + ck[2048 + c] * bflo(a0[q]));
            const float hi = bfhi(gg[q]) * (ck[c + 1] * bfhi(a2[q]) + ck[1024 + c + 1] * bfhi(a1[q]) + ck[2048 + c + 1] * bfhi(a0[q]));
            o[q] = pk2(lo, hi);
        }
        *(uint4*)(G + (size_t)row * DM + c8) = make_uint4(o[0], o[1], o[2], o[3]);
    }
}

__device__ __forceinline__ void phase_ln(float* X, bf16_t* XB, const float* g, const float* b) {
    const int lane = otid() & 63, gw = blockIdx.x * 8 + (otid() >> 6), nw = gridDim.x * 8;
    for (int row = gw; row < MTOK; row += nw) {
        float4 v[4]; float s = 0.f;
#pragma unroll
        for (int i = 0; i < 4; ++i) { v[i] = *(const float4*)(X + (size_t)row * DM + i * 256 + lane * 4); s += v[i].x + v[i].y + v[i].z + v[i].w; }
        const float mean = wave_sum(s) * (1.0f / 1024.0f);
        float q = 0.f;
#pragma unroll
        for (int i = 0; i < 4; ++i) { v[i].x -= mean; v[i].y -= mean; v[i].z -= mean; v[i].w -= mean; q += v[i].x * v[i].x + v[i].y * v[i].y + v[i].z * v[i].z + v[i].w * v[i].w; }
        const float rs = rsqrtf(wave_sum(q) * (1.0f / 1024.0f) + 1e-5f);
#pragma unroll
        for (int i = 0; i < 4; ++i) { const int c = i * 256 + lane * 4; const float4 gg = *(const float4*)(g + c), bb = *(const float4*)(b + c);
            float4 y; y.x = v[i].x * rs * gg.x + bb.x; y.y = v[i].y * rs * gg.y + bb.y; y.z = v[i].z * rs * gg.z + bb.z; y.w = v[i].w * rs * gg.w + bb.w;
            *(float4*)(X + (size_t)row * DM + c) = y; *(uint2*)(XB + (size_t)row * DM + c) = make_uint2(pk2(y.x, y.y), pk2(y.z, y.w)); }
    }
}

template <int FINAL> __device__ __forceinline__ void phase_s5(const P& p, LAS unsigned char* lds_, const float* U, float* HLOC, bf16_t* YG) {
    const int lane = otid() & 63, wid = otid() >> 6, nw = gridDim.x * 8;
    LAS float* ul = (LAS float*)(lds_ + wid * 8192);
    LAS unsigned* S = (LAS unsigned*)(lds_ + wid * 8192 + 2048);
    const int fr = lane & 15, fq = lane >> 4;
    for (int un = blockIdx.x * 8 + wid; un < 2048; un += nw) {
        const int g = un & 63, sc = (un >> 6) & 7, b = un >> 9;
        if (!FINAL && sc == 7) continue;
        const float dt = __expf(p.in[8][g]);
        const float lre = p.in[6][g * 64 + lane], lim = p.in[7][g * 64 + lane];
        const float mag = expf(lre * dt); float sn, cs; sincosf(lim * dt, &sn, &cs);
        const float are = mag * cs, aim = mag * sn;
        const float d2 = lre * lre + lim * lim, cfre = ((are - 1.0f) * lre + aim * lim) / d2, cfim = (aim * lre - (are - 1.0f) * lim) / d2;
        float Bre[16], Bim[16];
#pragma unroll
        for (int q = 0; q < 4; ++q) { const float4 br = *(const float4*)(p.in[9] + (size_t)(g * 64 + lane) * 16 + q * 4), bi = *(const float4*)(p.in[10] + (size_t)(g * 64 + lane) * 16 + q * 4);
            const float brr[4] = {br.x, br.y, br.z, br.w}, bii[4] = {bi.x, bi.y, bi.z, bi.w};
#pragma unroll
            for (int j = 0; j < 4; ++j) { Bre[q * 4 + j] = cfre * brr[j] - cfim * bii[j]; Bim[q * 4 + j] = cfre * bii[j] + cfim * brr[j]; } }
        float hre = 0.f, him = 0.f;
        bf16x8 Cf[4]; float dsk = 0.f;
        if (FINAL) {
            float lr = are, li = aim;
#pragma unroll
            for (int i = 0; i < 9; ++i) { const float t = lr * lr - li * li; li = 2.0f * lr * li; lr = t; }
            for (int s2 = 0; s2 < sc; ++s2) { const float2 hv = *(const float2*)(HLOC + ((size_t)((b * 8 + s2) * 64 + g) * 64 + lane) * 2);
                const float t = lr * hre - li * him + hv.x; him = lr * him + li * hre + hv.y; hre = t; }
#pragma unroll
            for (int kk = 0; kk < 4; ++kk) {
                unsigned w[4];
#pragma unroll
                for (int i = 0; i < 4; ++i) { const int pi = 16 * kk + 4 * fq + i; const size_t o = (size_t)(g * 16 + fr) * 64 + pi; w[i] = pk2(p.in[11][o], -p.in[12][o]); }
                union { unsigned u[4]; bf16x8 v; } cv; cv.u[0] = w[0]; cv.u[1] = w[1]; cv.u[2] = w[2]; cv.u[3] = w[3]; Cf[kk] = cv.v;
            }
            dsk = p.in[13][g * 16 + fr];
        }
        const size_t tok0 = (size_t)b * SEQL + (size_t)sc * 512;
        const float* ug = U + tok0 * DM + g * 16 + (lane & 3) * 4 + (size_t)(lane >> 2) * DM;
        f32x4 nxt = *(const f32x4*)ug;
        LDS_FENCE();
        *(LAS f32x4*)(ul + lane * 4) = nxt;
        for (int blk = 0; blk < 32; ++blk) {
            const int cur = blk & 1;
            if (blk + 1 < 32) nxt = *(const f32x4*)(ug + (size_t)(blk + 1) * 16 * DM);
            LDS_FENCE();
#pragma unroll
            for (int tt = 0; tt < 16; ++tt) {
                float uu[16];
#pragma unroll
                for (int q = 0; q < 4; ++q) { const f32x4 t4 = *(const LAS f32x4*)(ul + cur * 256 + tt * 16 + q * 4); uu[q * 4] = t4[0]; uu[q * 4 + 1] = t4[1]; uu[q * 4 + 2] = t4[2]; uu[q * 4 + 3] = t4[3]; }
                float bre = 0.f, bim = 0.f;
#pragma unroll
                for (int h = 0; h < 16; ++h) { bre = fmaf(Bre[h], uu[h], bre); bim = fmaf(Bim[h], uu[h], bim); }
                const float t = are * hre - aim * him + bre; him = are * him + aim * hre + bim; hre = t;
                if (FINAL) S[tt * 68 + lane] = pk2(hre, him);
            }
            if (FINAL) {
                LDS_FENCE();
                f32x4 acc = {0.f, 0.f, 0.f, 0.f};
#pragma unroll
                for (int kk = 0; kk < 4; ++kk) { const bf16x8 af = *(const LAS bf16x8*)(S + fr * 68 + 16 * kk + 4 * fq); acc = __builtin_amdgcn_mfma_f32_16x16x32_bf16(af, Cf[kk], acc, 0, 0, 0); }
#pragma unroll
                for (int i = 0; i < 4; ++i) { const int tl = 4 * fq + i; const float y = acc[i] + dsk * ul[cur * 256 + tl * 16 + fr];
                    const unsigned short hb = (unsigned short)(pk2(gelu_tanh(y), 0.f) & 0xffffu);
                    YG[(tok0 + blk * 16 + tl) * DM + g * 16 + fr] = hb; }
            }
            LDS_FENCE();
            if (blk + 1 < 32) *(LAS f32x4*)(ul + (cur ^ 1) * 256 + lane * 4) = nxt;
        }
        if (!FINAL) *(float2*)(HLOC + ((size_t)un * 64 + lane) * 2) = make_float2(hre, him);
    }
}

__device__ __forceinline__ void phase_rw_prep(const float* X, bf16_t* XDX) {
    const size_t nth = (size_t)gridDim.x * 512;
    for (size_t i = (size_t)blockIdx.x * 512 + otid(); i < (size_t)MTOK * 256; i += nth) {
        const int row = (int)(i >> 8), c4 = (int)(i & 255) * 4, t = row & (SEQL - 1);
        const float4 x = *(const float4*)(X + (size_t)row * DM + c4);
        float4 xp = make_float4(0.f, 0.f, 0.f, 0.f); if (t >= 1) xp = *(const float4*)(X + (size_t)(row - 1) * DM + c4);
        *(uint2*)(XDX + (size_t)row * 2048 + c4) = make_uint2(pk2(x.x, x.y), pk2(x.z, x.w));
        *(uint2*)(XDX + (size_t)row * 2048 + 1024 + c4) = make_uint2(pk2(xp.x - x.x, xp.y - x.y), pk2(xp.z - x.z, xp.w - x.w));
    }
}
__device__ __forceinline__ void unpack8(const uint4 v, float* f) { f[0] = bflo(v.x); f[1] = bfhi(v.x); f[2] = bflo(v.y); f[3] = bfhi(v.y); f[4] = bflo(v.z); f[5] = bfhi(v.z); f[6] = bflo(v.w); f[7] = bfhi(v.w); }

constexpr int RW_T = 32, RW_STEP = 336;
__device__ __forceinline__ void phase_rw_scan(const P& p, LAS unsigned char* lds_, const bf16_t* R, const bf16_t* K, const bf16_t* V, const bf16_t* DW, const bf16_t* DA, bf16_t* OUT) {
    LAS float* buf = (LAS float*)lds_;
    LAS float* obuf = (LAS float*)(lds_ + 2 * RW_T * RW_STEP * 4);
    const int tid = otid(), lane = tid & 63, wid = __builtin_amdgcn_readfirstlane(tid >> 6);
    for (int un = blockIdx.x; un < 256; un += gridDim.x) {
        const int bh = un >> 2, rg = un & 3, b = bh >> 4, h = bh & 15;
        __syncthreads();
        if (wid < 4) {
            const int rr = wid * 4 + (lane >> 4), j0 = (lane & 15) * 4;
            float s0 = 0.f, s1 = 0.f, s2 = 0.f, s3 = 0.f;
            __syncthreads();
            for (int c = 0; c < SEQL / RW_T; ++c) {
                const LAS float* cb = buf + (c & 1) * RW_T * RW_STEP; LAS float* ob = obuf + (c & 1) * RW_T * 16;
#pragma unroll 8
                for (int s = 0; s < RW_T; ++s) {
                    const LAS float* sb = cb + s * RW_STEP;
                    const f32x4 r4 = *(const LAS f32x4*)(sb + j0), w4 = *(const LAS f32x4*)(sb + 64 + j0), kp = *(const LAS f32x4*)(sb + 128 + j0);
                    const f32x4 kk = *(const LAS f32x4*)(sb + 192 + j0), ka = *(const LAS f32x4*)(sb + 256 + j0); const float vv = sb[320 + rr];
                    const float sa = -red16(s0 * kk.x + s1 * kk.y + s2 * kk.z + s3 * kk.w);
                    s0 = fmaf(s0, w4.x, fmaf(sa, ka.x, vv * kp.x)); s1 = fmaf(s1, w4.y, fmaf(sa, ka.y, vv * kp.y));
                    s2 = fmaf(s2, w4.z, fmaf(sa, ka.z, vv * kp.z)); s3 = fmaf(s3, w4.w, fmaf(sa, ka.w, vv * kp.w));
                    const float o = red16(s0 * r4.x + s1 * r4.y + s2 * r4.z + s3 * r4.w);
                    if ((lane & 15) == 0) ob[s * 16 + rr] = o;
                }
                __syncthreads();
            }
        } else {
            const int pt = tid - 256, s = pt >> 3, part = pt & 7, c0 = part * 8, ch = h * 64 + c0;
            float w0[8], a0[8], kk_[8], ka_[8];
#pragma unroll
            for (int i = 0; i < 8; ++i) { w0[i] = p.in[19][ch + i]; a0[i] = p.in[22][ch + i]; kk_[i] = p.in[25][ch + i]; ka_[i] = p.in[26][ch + i]; }
            for (int c = 0; c <= SEQL / RW_T; ++c) {
                if (c < SEQL / RW_T) {
                    const size_t row = (size_t)b * SEQL + (size_t)c * RW_T + s; const size_t o = row * DM + ch;
                    float r[8], k[8], dw[8], da[8];
                    unpack8(*(const uint4*)(R + o), r); unpack8(*(const uint4*)(K + o), k); unpack8(*(const uint4*)(DW + o), dw); unpack8(*(const uint4*)(DA + o), da);
                    float wv[8], kp[8], kk[8], ka[8]; float ss = 0.f;
#pragma unroll
                    for (int i = 0; i < 8; ++i) {
                        const float a = sigmoidf_(a0[i] + da[i]);
                        const float x = -(w0[i] + dw[i]);
                        const float sp = fmaxf(x, 0.f) + log1pf(__expf(-fabsf(x)));
                        wv[i] = __expf(-__expf(-sp - 0.5f));
                        kk[i] = k[i] * kk_[i]; ss += kk[i] * kk[i];
                        kp[i] = k[i] * (1.0f + (a - 1.0f) * ka_[i]); ka[i] = a;
                    }
                    ss = red8(ss); const float inv = 1.0f / fmaxf(sqrtf(ss), 1e-12f);
#pragma unroll
                    for (int i = 0; i < 8; ++i) { kk[i] *= inv; ka[i] *= kk[i]; }
                    LAS float* sb = buf + (c & 1) * RW_T * RW_STEP + s * RW_STEP + c0;
                    *(LAS f32x4*)(sb) = (f32x4){r[0], r[1], r[2], r[3]}; *(LAS f32x4*)(sb + 4) = (f32x4){r[4], r[5], r[6], r[7]};
                    *(LAS f32x4*)(sb + 64) = (f32x4){wv[0], wv[1], wv[2], wv[3]}; *(LAS f32x4*)(sb + 68) = (f32x4){wv[4], wv[5], wv[6], wv[7]};
                    *(LAS f32x4*)(sb + 128) = (f32x4){kp[0], kp[1], kp[2], kp[3]}; *(LAS f32x4*)(sb + 132) = (f32x4){kp[4], kp[5], kp[6], kp[7]};
                    *(LAS f32x4*)(sb + 192) = (f32x4){kk[0], kk[1], kk[2], kk[3]}; *(LAS f32x4*)(sb + 196) = (f32x4){kk[4], kk[5], kk[6], kk[7]};
                    *(LAS f32x4*)(sb + 256) = (f32x4){ka[0], ka[1], ka[2], ka[3]}; *(LAS f32x4*)(sb + 260) = (f32x4){ka[4], ka[5], ka[6], ka[7]};
                    if (part < 2) { float v[8]; unpack8(*(const uint4*)(V + row * DM + h * 64 + rg * 16 + part * 8), v);
                        LAS float* vb = buf + (c & 1) * RW_T * RW_STEP + s * RW_STEP + 320 + part * 8;
                        *(LAS f32x4*)(vb) = (f32x4){v[0], v[1], v[2], v[3]}; *(LAS f32x4*)(vb + 4) = (f32x4){v[4], v[5], v[6], v[7]}; }
                }
                if (c >= 2) {
                    const int cc = c - 2; const LAS float* ob = obuf + (cc & 1) * RW_T * 16 + s * 16 + part * 2;
                    const size_t row = (size_t)b * SEQL + (size_t)cc * RW_T + s;
                    *(unsigned*)(OUT + row * DM + h * 64 + rg * 16 + part * 2) = pk2(ob[0], ob[1]);
                }
                __syncthreads();
            }
            {
                const int cc = SEQL / RW_T - 1; const LAS float* ob = obuf + (cc & 1) * RW_T * 16 + s * 16 + part * 2;
                const size_t row = (size_t)b * SEQL + (size_t)cc * RW_T + s;
                *(unsigned*)(OUT + row * DM + h * 64 + rg * 16 + part * 2) = pk2(ob[0], ob[1]);
            }
        }
    }
}

__device__ __forceinline__ void phase_rw_post(const P& p, const bf16_t* OUT, const bf16_t* R, const bf16_t* K, const bf16_t* V, const bf16_t* DA, const bf16_t* SZ, bf16_t* OF) {
    const size_t nth = (size_t)gridDim.x * 512;
    for (size_t it = (size_t)blockIdx.x * 512 + otid(); it < (size_t)MTOK * 128; it += nth) {
        const int c0 = (int)(it & 127) * 8; const size_t o = (it >> 7) * DM + c0;
        float ov[8], r[8], k[8], v[8], da[8], sz[8];
        unpack8(*(const uint4*)(OUT + o), ov); unpack8(*(const uint4*)(R + o), r); unpack8(*(const uint4*)(K + o), k); unpack8(*(const uint4*)(V + o), v);
        unpack8(*(const uint4*)(DA + o), da); unpack8(*(const uint4*)(SZ + o), sz);
        float sm = 0.f, dot = 0.f;
#pragma unroll
        for (int i = 0; i < 8; ++i) { const float a = sigmoidf_(p.in[22][c0 + i] + da[i]); const float kp = k[i] * (1.0f + (a - 1.0f) * p.in[26][c0 + i]);
            dot += r[i] * kp * p.in[27][c0 + i]; sm += ov[i]; }
        dot = red8(dot); const float mean = red8(sm) * (1.0f / 64.0f);
        float q = 0.f;
#pragma unroll
        for (int i = 0; i < 8; ++i) { ov[i] -= mean; q += ov[i] * ov[i]; }
        const float rs = rsqrtf(red8(q) * (1.0f / 64.0f) + 64e-5f);
        float y[8];
#pragma unroll
        for (int i = 0; i < 8; ++i) y[i] = (ov[i] * rs * p.in[28][c0 + i] + p.in[29][c0 + i] + dot * v[i]) * sz[i];
        *(uint4*)(OF + o) = make_uint4(pk2(y[0], y[1]), pk2(y[2], y[3]), pk2(y[4], y[5]), pk2(y[6], y[7]));
    }
}

__global__ void __launch_bounds__(512, 2) fwd_mega(P p) {
    extern __shared__ __attribute__((aligned(16))) unsigned char shm[];
    LAS unsigned char* lds = (LAS unsigned char*)shm;
    LAS float* tile = (LAS float*)shm;
    cg::grid_group grid = cg::this_grid();
    volatile LAS unsigned* xst = (volatile LAS unsigned*)(lds + 131072);
    if (threadIdx.x == 0) { xst[0] = 0u; xst[1] = 0u; }
    __syncthreads();
    const XcdBarrier xb = xcd_barrier_post((unsigned*)(p.ws + BAR_OFF), xst);
    unsigned char* ws = p.ws; float* X = p.out;
    bf16_t* act = (bf16_t*)(ws + ACT); bf16_t* pb = (bf16_t*)(ws + PB);
    phase_prep(p, tile);
    grid.sync();
    for (int d = 0; d < DUP_PREP; ++d) { phase_prep(p, tile); xcd_barrier(xb); }
    for (int d = 0; d < DUP_SYNC; ++d) xcd_barrier(xb);
#define LAYER_TAIL(L, Aout, Wout, Wpe, Wpg, PEB) \
    { EpiWout E; E.X = X; E.RB = act; run_gemm(lds, Aout, Wout, 1024, 1024, E); } \
    { EpiBf16 E; E.O = PEB; E.ldo = 1024; E.split = 1 << 20; E.stride = 0; run_gemm(lds, pb, Wpe, 1024, 256, E); } \
    xcd_barrier(xb); \
    { EpiPle E; E.X = X; E.PE = PEB; run_gemm(lds, act, Wpg, 1024, 1024, E); } \
    xcd_barrier(xb); \
    phase_ln(X, act, p.in[33] + (L) * 1024, p.in[34] + (L) * 1024);
#define CONV_LAYER(L, j) { \
        bf16_t* U = (bf16_t*)(ws + T0); bf16_t* G = (bf16_t*)(ws + T0 + 32 * MiB); \
        { EpiConvIn E; E.U = U; E.G = G; run_gemm(lds, act, (const bf16_t*)(ws + W_CIN), 4096, 1024, E); } \
        xcd_barrier(xb); \
        phase_conv_ew(U, G, p.in[3] + (size_t)(j) * 3 * 1024); \
        if ((L) > 0) cvt_pb(p.in[1] + (size_t)(L) * MTOK * 256, pb); \
        xcd_barrier(xb); \
        LAYER_TAIL(L, G, (const bf16_t*)(ws + W_COUT), (const bf16_t*)(ws + W_PEC), (const bf16_t*)(ws + W_PGC), (bf16_t*)(ws + T0 + 64 * MiB)) }
    CONV_LAYER(0, 0)
    xcd_barrier(xb);
    {
        float* U = (float*)(ws + T0); bf16_t* SZ = (bf16_t*)(ws + T0 + 64 * MiB); bf16_t* YG = (bf16_t*)(ws + T0 + 96 * MiB); bf16_t* V = (bf16_t*)(ws + T0 + 128 * MiB);
        float* HL = (float*)(ws + T0 + 160 * MiB);
        { EpiSsmIn E; E.U = U; E.SZ = SZ; run_gemm(lds, act, (const bf16_t*)(ws + W_SIN), 2048, 1024, E); }
        xcd_barrier(xb);
        phase_s5<0>(p, lds, U, HL, YG);
        cvt_pb(p.in[1] + (size_t)1 * MTOK * 256, pb);
        xcd_barrier(xb);
        phase_s5<1>(p, lds, U, HL, YG);
        xcd_barrier(xb);
        for (int d = 0; d < DUP_S5; ++d) { phase_s5<0>(p, lds, U, HL, YG); xcd_barrier(xb); phase_s5<1>(p, lds, U, HL, YG); xcd_barrier(xb); }
        { EpiGlu E; E.YG = YG; E.SZ = SZ; E.bias = p.in[15]; E.V = V; run_gemm(lds, YG, (const bf16_t*)(ws + W_SGLU), 1024, 1024, E); }
        xcd_barrier(xb);
        LAYER_TAIL(1, V, (const bf16_t*)(ws + W_SOUT), (const bf16_t*)(ws + W_PE1), (const bf16_t*)(ws + W_PG1), (bf16_t*)(ws + T0))
    }
    xcd_barrier(xb);
    {
        bf16_t* XDX = (bf16_t*)(ws + T0); bf16_t* RKV = (bf16_t*)(ws + T0 + 64 * MiB);
        bf16_t* Rb = RKV; bf16_t* Kb = RKV + (size_t)MTOK * DM; bf16_t* Vb = RKV + (size_t)2 * MTOK * DM;
        bf16_t* SZ = act; bf16_t* L1 = pb; bf16_t* DW = (bf16_t*)(ws + T0); bf16_t* DA = (bf16_t*)(ws + T0 + 32 * MiB);
        bf16_t* OUT = (bf16_t*)(ws + OUT_RW); bf16_t* OF = (bf16_t*)(ws + T0);
        phase_rw_prep(X, XDX);
        xcd_barrier(xb);
        { EpiRk E; E.RKV = RKV; E.SZ = SZ; E.L1 = L1; run_gemm(lds, XDX, (const bf16_t*)(ws + W_RK), 4352, 2048, E); }
        xcd_barrier(xb);
        for (int d = 0; d < DUP_RK; ++d) { EpiRk E; E.RKV = RKV; E.SZ = SZ; E.L1 = L1; run_gemm(lds, XDX, (const bf16_t*)(ws + W_RK), 4352, 2048, E); xcd_barrier(xb); }
        { EpiBf16 E; E.O = DW; E.ldo = 1024; E.split = 4; E.stride = (size_t)MTOK * DM; run_gemm(lds, L1, (const bf16_t*)(ws + W_L2), 2048, 256, E); }
        xcd_barrier(xb);
        phase_rw_scan(p, lds, Rb, Kb, Vb, DW, DA, OUT);
        xcd_barrier(xb);
        for (int d = 0; d < DUP_RWSCAN; ++d) { phase_rw_scan(p, lds, Rb, Kb, Vb, DW, DA, OUT); xcd_barrier(xb); }
        phase_rw_post(p, OUT, Rb, Kb, Vb, DA, SZ, OF);
        for (int d = 0; d < DUP_EW; ++d) { xcd_barrier(xb); phase_rw_post(p, OUT, Rb, Kb, Vb, DA, SZ, OF); }
        cvt_pb(p.in[1] + (size_t)2 * MTOK * 256, pb);
        xcd_barrier(xb);
        LAYER_TAIL(2, OF, (const bf16_t*)(ws + W_ROUT), (const bf16_t*)(ws + W_PE2), (const bf16_t*)(ws + W_PG2), (bf16_t*)(ws + T0 + 32 * MiB))
        __syncthreads();
        conv_layer_weights(p, tile, 1, 3);
    }
    xcd_barrier(xb);
    CONV_LAYER(3, 1)
}

extern "C" void kernel_launch(void* const* d_in, const int* in_sizes, int n_in, void* d_out, int out_size, void* d_ws, size_t ws_size, hipStream_t stream) {
    static int grid_blocks = 0;
    if (!grid_blocks) {
        int dev = 0, cus = 0, per_cu = 0;
        hipGetDevice(&dev);
        hipDeviceGetAttribute(&cus, hipDeviceAttributeMultiprocessorCount, dev);
        hipFuncSetAttribute((const void*)fwd_mega, hipFuncAttributeMaxDynamicSharedMemorySize, LDS_BYTES);
        hipOccupancyMaxActiveBlocksPerMultiprocessor(&per_cu, (const void*)fwd_mega, 512, LDS_BYTES);
        if (per_cu < 1) { fprintf(stderr, "occupancy query returned %d\n", per_cu); per_cu = 1; }
        grid_blocks = cus;
        if (ws_size < 256 * MiB) fprintf(stderr, "workspace too small: %zu\n", ws_size);
    }
    P p{};
    for (int i = 0; i < 35; ++i) p.in[i] = (const float*)d_in[i];
    p.out = (float*)d_out; p.ws = (unsigned char*)d_ws;
    hipMemsetAsync((unsigned char*)d_ws + BAR_OFF, 0, XCD_BAR_WORDS * sizeof(unsigned), stream);
    void* args[] = {&p};
    hipError_t e = hipLaunchCooperativeKernel((const void*)fwd_mega, dim3(grid_blocks), dim3(512), args, LDS_BYTES, stream);
    if (e != hipSuccess) fprintf(stderr, "cooperative launch failed: %s (grid %d)\n", hipGetErrorString(e), grid_blocks);
}
```

```cpp
#include <hip/hip_runtime.h>
#include <hip/hip_cooperative_groups.h>
#include <cstdio>
namespace cg = cooperative_groups;
namespace pg8 {
#define PG8_LAS __attribute__((address_space(3)))
typedef unsigned short bf16_t;
typedef short bf16x8 __attribute__((ext_vector_type(8)));
typedef float f32x4 __attribute__((ext_vector_type(4)));
typedef unsigned u32x4 __attribute__((ext_vector_type(4)));
constexpr int BM = 256, BK = 64, HALF = 128, HTB = HALF * BK * 2  , STAGE_BYTES = 8 * HTB, NXCD = 8, WGM = 8;

__host__ __device__ __forceinline__ int lds_byte(int r, int c) { const int st = (r >> 4) * 2 + (c >> 5), rr = r & 15, cc = c & 31, ob = rr * 64 + cc * 2; return st * 1024 + (ob ^ (((ob >> 9) & 1) << 5)); }
__host__ __device__ __forceinline__ void stage_rc(int b, int& R, int& C) { const int st = b / 1024, sb = b % 1024, swz = sb ^ (((sb >> 9) & 1) << 5); R = (st >> 1) * 16 + swz / 64; C = (st & 1) * 32 + (swz % 64) / 2; }
__host__ __device__ __forceinline__ int perm32(int rho) { const int n = rho >> 4, i = rho & 15; return 8 * (i >> 2) + 4 * n + (i & 3); }

struct Unit { int pm, pn; };
struct Gemm { const bf16_t* A; const bf16_t* Bt; int M, N, K; };
struct StaticOrder {
    int nM, nN, nwg, G, c;
    __host__ __device__ void init(int M, int N, int G_, int c_) { nM = M / BM; nN = N / BM; nwg = nM * nN; G = G_; c = c_; }
    __host__ __device__ bool next(int i, Unit& u) const {
        const long L = (long)i * G + c; if (L >= nwg) return false;
        int wgid = (int)L; { const int q = nwg / NXCD, r = nwg % NXCD, xcd = wgid % NXCD, off = wgid / NXCD; wgid = (xcd < r ? xcd * (q + 1) : r * (q + 1) + (xcd - r) * q) + off; }
        const int nig = WGM * nN, gid = wgid / nig, fm = gid * WGM, gsz = (nM - fm) < WGM ? (nM - fm) : WGM;
        u.pm = fm + ((wgid % nig) % gsz); u.pn = (wgid % nig) / gsz; return true;
    }
    __device__ __forceinline__ void a_ready(const Unit&) const {}
    __device__ __forceinline__ void done(const Unit&) const {}
};
__device__ __forceinline__ unsigned cvt_pk_bf16(float lo, float hi) { unsigned r; asm volatile("v_cvt_pk_bf16_f32 %0, %1, %2" : "=v"(r) : "v"(lo), "v"(hi)); return r; }
template <class Epi, class Sched, bool STAMP = false>
__device__ __forceinline__ void gemm_phase(PG8_LAS unsigned char* lds, const Gemm g, const Sched& S, const Epi& E, unsigned long long* stamps) {
    int tid_o = threadIdx.x; asm volatile("" : "+v"(tid_o)); const int tid = tid_o, wid = __builtin_amdgcn_readfirstlane(tid >> 6), lane = tid & 63, wr = wid >> 2, wc = wid & 3, fr = lane & 15, fq = lane >> 4;
    const int K = g.K, nt = K / BK;
    int ts_lo = 0, ts_hi = 0, nts = 0; const unsigned long long rt_entry = STAMP ? (unsigned long long)wall_clock64() : 0ull;
#define PG8_STAMP() do { if (STAMP && wid == 0 && nts < 64) { const unsigned long long _c = (unsigned long long)clock64(); \
        ts_lo = (lane == nts) ? (int)(unsigned)_c : ts_lo; ts_hi = (lane == nts) ? (int)(unsigned)(_c >> 32) : ts_hi; ++nts; } } while (0)
    PG8_STAMP();
    unsigned voffA[2], voffB[2];
#pragma unroll
    for (int i = 0; i < 2; ++i) { int R, C; stage_rc(tid * 16 + i * 8192, R, C); const int Rb = Epi::PERM ? ((R & ~31) + perm32(R & 31)) : R;
        voffA[i] = (unsigned)(R * K + C) * 2u; voffB[i] = (unsigned)(Rb * K + C) * 2u; }
    const size_t kstep = (size_t)(BK * 2);
    const size_t hstep = (size_t)HALF * K * 2;
    const size_t tstep = 2 * hstep;
    const unsigned ldsw = (unsigned)wid * 1024u;
    const int aoff = lds_byte(wr * 64 + fr, fq * 8), boff = lds_byte(wc * 32 + fr, fq * 8);
#define PG8_SA(b, h) (((b) * 2 + (h)) * HTB)
#define PG8_SB(b, h) ((4 + (b) * 2 + (h)) * HTB)
#define PG8_STAGE(bufoff, gbase, voff) do { _Pragma("unroll") for (int _i = 0; _i < 2; ++_i) \
        __builtin_amdgcn_global_load_lds((const unsigned*)((const char*)(gbase) + (voff)[_i]), (PG8_LAS unsigned*)(lds + (bufoff) + ldsw + _i * 8192), 16, 0, 0); } while (0)
#define PG8_LDA(dst, b, h) do { _Pragma("unroll") for (int m = 0; m < 4; ++m) _Pragma("unroll") for (int k = 0; k < 2; ++k) dst[m][k] = *(const PG8_LAS bf16x8*)(lds + PG8_SA(b, h) + aoff + m * 2048 + k * 1024); } while (0)
#define PG8_LDB(dst, b, h) do { _Pragma("unroll") for (int n = 0; n < 2; ++n) _Pragma("unroll") for (int k = 0; k < 2; ++k) dst[n][k] = *(const PG8_LAS bf16x8*)(lds + PG8_SB(b, h) + boff + n * 2048 + k * 1024); } while (0)
#define PG8_MMA(ai, bj, At, Bt) do { __builtin_amdgcn_s_setprio(1); _Pragma("unroll") for (int m = 0; m < 4; ++m) _Pragma("unroll") for (int n = 0; n < 2; ++n) _Pragma("unroll") for (int k = 0; k < 2; ++k) \
        acc[ai][bj][m][n] = __builtin_amdgcn_mfma_f32_16x16x32_bf16(Bt[n][k], At[m][k], acc[ai][bj][m][n], 0, 0, 0); __builtin_amdgcn_s_setprio(0); } while (0)
#define PG8_WAIT_V(n) asm volatile("s_waitcnt vmcnt(" #n ")" ::: "memory")
#define PG8_WAIT_L(n) asm volatile("s_waitcnt lgkmcnt(" #n ")" ::: "memory")
#define PG8_BAR __builtin_amdgcn_s_barrier()
#define PG8_SCHED __builtin_amdgcn_sched_barrier(0)
    Unit cur, nxt; int ui = 0;
    if (!S.next(0, cur)) return;
    f32x4 acc[2][2][4][2];
#pragma unroll
    for (int a = 0; a < 2; ++a)
#pragma unroll
        for (int b = 0; b < 2; ++b)
#pragma unroll
            for (int m = 0; m < 4; ++m)
#pragma unroll
                for (int n = 0; n < 2; ++n) acc[a][b][m][n] = (f32x4){0.f, 0.f, 0.f, 0.f};
    bf16x8 At[4][2], B0[2][2], B1[2][2];
    const char* cA = (const char*)g.A + (size_t)cur.pm * tstep; const char* cB = (const char*)g.Bt + (size_t)cur.pn * tstep;
    S.a_ready(cur);
    PG8_STAGE(PG8_SB(0, 0), cB, voffB); PG8_STAGE(PG8_SA(0, 0), cA, voffA); PG8_STAGE(PG8_SB(0, 1), cB + hstep, voffB); PG8_STAGE(PG8_SA(0, 1), cA + hstep, voffA);
    if (wr == 1) PG8_BAR;
    PG8_WAIT_V(4); PG8_BAR;
    PG8_STAGE(PG8_SB(1, 0), cB + kstep, voffB); PG8_STAGE(PG8_SA(1, 0), cA + kstep, voffA); PG8_STAGE(PG8_SB(1, 1), cB + hstep + kstep, voffB);
    PG8_WAIT_V(6); PG8_BAR;
    PG8_STAMP();
    for (;;) {
        const bool has_next = S.next(ui + 1, nxt);
        const char* nA = has_next ? (const char*)g.A + (size_t)nxt.pm * tstep : cA; const char* nB = has_next ? (const char*)g.Bt + (size_t)nxt.pn * tstep : cB;
        for (int t = 0; t < nt; t += 2) {
            const bool last = (t == nt - 2);
            const char* a1 = cA + (size_t)(t + 1) * kstep;
            const char* a2 = last ? nA : cA + (size_t)(t + 2) * kstep; const char* b2 = last ? nB : cB + (size_t)(t + 2) * kstep;
            const char* a3 = a2 + kstep; const char* b3 = b2 + kstep;
            if (last && has_next) S.a_ready(nxt);
            PG8_LDB(B0, 0, 0); PG8_SCHED; PG8_LDA(At, 0, 0); PG8_STAGE(PG8_SA(1, 1), a1 + hstep, voffA);
            PG8_WAIT_L(8); PG8_BAR; PG8_WAIT_L(0); PG8_MMA(0, 0, At, B0); PG8_BAR; PG8_SCHED;
            PG8_LDB(B1, 0, 1); PG8_STAGE(PG8_SB(0, 0), b2, voffB);
            PG8_BAR; PG8_WAIT_L(0); PG8_MMA(0, 1, At, B1); PG8_BAR;
            PG8_LDA(At, 0, 1); PG8_STAGE(PG8_SA(0, 0), a2, voffA);
            PG8_BAR; PG8_WAIT_L(0); PG8_MMA(1, 0, At, B0); PG8_BAR; PG8_SCHED;
            PG8_STAGE(PG8_SB(0, 1), b2 + hstep, voffB);
            PG8_WAIT_V(6); PG8_BAR; PG8_MMA(1, 1, At, B1); PG8_BAR;
            PG8_LDB(B0, 1, 0); PG8_SCHED; PG8_LDA(At, 1, 0); PG8_STAGE(PG8_SA(0, 1), a2 + hstep, voffA);
            PG8_WAIT_L(8); PG8_BAR; PG8_WAIT_L(0); PG8_MMA(0, 0, At, B0); PG8_BAR; PG8_SCHED;
            PG8_LDB(B1, 1, 1); PG8_STAGE(PG8_SB(1, 0), b3, voffB);
            PG8_BAR; PG8_WAIT_L(0); PG8_MMA(0, 1, At, B1); PG8_BAR;
            PG8_LDA(At, 1, 1); PG8_STAGE(PG8_SA(1, 0), a3, voffA);
            PG8_BAR; PG8_WAIT_L(0); PG8_MMA(1, 0, At, B0); PG8_BAR; PG8_SCHED;
            PG8_STAGE(PG8_SB(1, 1), b3 + hstep, voffB);
            PG8_WAIT_V(6); PG8_BAR; PG8_MMA(1, 1, At, B1); PG8_BAR;
        }
        PG8_STAMP();
        if constexpr (!Epi::AFTER_DRAIN) { E(acc, cur, wr, wc, fr, fq); S.done(cur); }
        PG8_STAMP();
        if (!has_next) break;
#pragma unroll
        for (int a = 0; a < 2; ++a)
#pragma unroll
            for (int b = 0; b < 2; ++b)
#pragma unroll
                for (int m = 0; m < 4; ++m)
#pragma unroll
                    for (int n = 0; n < 2; ++n) acc[a][b][m][n] = (f32x4){0.f, 0.f, 0.f, 0.f};
        cur = nxt; cA = nA; cB = nB; ++ui;
    }
    PG8_WAIT_V(0);
    if (wr == 0) PG8_BAR;
    PG8_BAR;
    if constexpr (Epi::AFTER_DRAIN) { E.fused(acc, cur, wr, wc, fr, fq, lds, wid, lane); S.done(cur); }
    PG8_STAMP();
    if (STAMP && wid == 0) { stamps[lane] = lane < nts ? (((unsigned long long)(unsigned)ts_hi << 32) | (unsigned)ts_lo) : 0ull;
        if (lane == 62) stamps[62] = rt_entry; if (lane == 63) stamps[63] = (unsigned long long)wall_clock64(); }
#undef PG8_STAMP
#undef PG8_SA
#undef PG8_SB
#undef PG8_STAGE
#undef PG8_LDA
#undef PG8_LDB
#undef PG8_MMA
#undef PG8_WAIT_V
#undef PG8_WAIT_L
#undef PG8_BAR
#undef PG8_SCHED
}
}
using pg8::bf16_t; using pg8::bf16x8; using pg8::f32x4; using pg8::Unit; using pg8::Gemm; using pg8::StaticOrder;
#define LAS __attribute__((address_space(3)))
constexpr int MTOK = 16384, DM = 1024, SEQL = 4096;
constexpr size_t MiB = 1u << 20, KiB = 1u << 10;
constexpr float DN_ALPHA = 1.6817928305074290f;
constexpr size_t W_CIN = 0, W_COUT = 8 * MiB, W_PEC = 10 * MiB, W_PGC = 10 * MiB + 512 * KiB;
constexpr size_t W_SIN = 12 * MiB + 512 * KiB, W_SGLU = 16 * MiB + 512 * KiB, W_SOUT = 18 * MiB + 512 * KiB, W_PE1 = 20 * MiB + 512 * KiB, W_PG1 = 21 * MiB;
constexpr size_t W_RK = 23 * MiB, W_L2 = 40 * MiB, W_ROUT = 41 * MiB, W_PE2 = 43 * MiB, W_PG2 = 43 * MiB + 512 * KiB;
constexpr size_t OUT_RW = 0, PB = 46 * MiB, ACT = 54 * MiB, T0 = 86 * MiB;
constexpr int LDS_XST = 151552;
constexpr int LDS_BYTES = LDS_XST + 16;
#ifndef DUP_PREP
#define DUP_PREP 0
#define DUP_RWSCAN 0
#define DUP_S5 0
#define DUP_RK 0
#define DUP_SYNC 0
#define DUP_EW 0
#endif
#ifndef DUP_MODE
#define DUP_MODE 0
#endif

struct P { const float* in[35]; float* out; unsigned char* ws; };
#define XB_TMO      128
#define XB_XCNT(j)  (256  + 64 * (j))
#define XB_XSUB(j)  (1280 + 64 * (j))
#define XB_XGEN(j)  (2304 + 64 * (j))
#define XB_TOP      3328
#define XB_TOPGEN   3392
#define XCD_BAR_WORDS 3456
#define XB_SPIN_CAP (1u << 18)

__device__ __forceinline__ unsigned xb_ld(unsigned* p)              { return __hip_atomic_load(p, __ATOMIC_RELAXED, __HIP_MEMORY_SCOPE_AGENT); }
__device__ __forceinline__ unsigned xb_add(unsigned* p, unsigned v) { return __hip_atomic_fetch_add(p, v, __ATOMIC_RELAXED, __HIP_MEMORY_SCOPE_AGENT); }
__device__ __forceinline__ unsigned xb_xcc_id() { return (unsigned)__builtin_amdgcn_s_getreg((3 << 11) | 20) & 0xFu; }
#define XB_SPIN(cond, bar) do { unsigned _sp = 0; while (cond) { __builtin_amdgcn_s_sleep(1); \
    if ((++_sp & 255u) == 0u) { if (xb_ld(&(bar)[XB_TMO])) break; if (_sp > XB_SPIN_CAP) { atomicAdd(&(bar)[XB_TMO], 1u); break; } } } } while (0)

struct XcdBarrier {
    unsigned* bar; unsigned x;
    volatile LAS unsigned* st;
};

__device__ __forceinline__ XcdBarrier xcd_barrier_post(unsigned* bar, volatile LAS unsigned* st) {
    XcdBarrier b; b.bar = bar; b.x = xb_xcc_id(); b.st = st;
    if (threadIdx.x == 0) (void)xb_add(&bar[XB_XCNT(b.x)], 1u);
    return b;
}
__device__ __forceinline__ void xcd_barrier_complete(unsigned* bar, unsigned x, unsigned& nloc, unsigned& nx) {
    const unsigned G = gridDim.x * gridDim.y * gridDim.z;
    unsigned sum, cnt, mine, sp = 0u;
    for (;;) {
        sum = 0u; cnt = 0u; mine = 0u;
#pragma unroll
        for (unsigned j = 0; j < 16; ++j) { const unsigned c = xb_ld(&bar[XB_XCNT(j)]); sum += c; cnt += (c > 0u) ? 1u : 0u; mine = (j == x) ? c : mine; }
        if (sum == G) break;
        __builtin_amdgcn_s_sleep(1);
        if ((++sp & 255u) == 0u) { if (xb_ld(&bar[XB_TMO])) break; if (sp > XB_SPIN_CAP) { atomicAdd(&bar[XB_TMO], 1u); break; } }
    }
    nloc = mine > 0u ? mine : 1u; nx = cnt > 0u ? cnt : 1u;
}

__device__ __forceinline__ void xcd_barrier(const XcdBarrier& b) {
    asm volatile("s_waitcnt vmcnt(0)" ::: "memory");
    __syncthreads();
    if (threadIdx.x == 0) {
        unsigned* bar = b.bar;
        __builtin_amdgcn_s_waitcnt(0);
        unsigned nloc = b.st[0], nx = b.st[1];
        if (nloc == 0u) { xcd_barrier_complete(bar, b.x, nloc, nx); b.st[0] = nloc; b.st[1] = nx; }
        const unsigned old = xb_add(&bar[XB_XSUB(b.x)], 1u);
        const unsigned gen = old / nloc;
        if (old + 1u == (gen + 1u) * nloc) {
            __builtin_amdgcn_fence(__ATOMIC_RELEASE, "agent");
            asm volatile("s_waitcnt vmcnt(0)" ::: "memory");
            const unsigned og = xb_add(&bar[XB_TOP], 1u);
            const unsigned tg = og / nx;
            if (og + 1u == (tg + 1u) * nx) xb_add(&bar[XB_TOPGEN], 1u);
            else XB_SPIN(xb_ld(&bar[XB_TOPGEN]) == tg, bar);
            __builtin_amdgcn_fence(__ATOMIC_ACQUIRE, "agent");
            xb_add(&bar[XB_XGEN(b.x)], 1u);
            asm volatile("s_waitcnt vmcnt(0)" ::: "memory");
        } else {
            XB_SPIN(xb_ld(&bar[XB_XGEN(b.x)]) == gen, bar);
            __builtin_amdgcn_fence(__ATOMIC_ACQUIRE, "agent");
            asm volatile("s_waitcnt vmcnt(0)" ::: "memory");
        }
    }
    __syncthreads();
}

constexpr size_t BAR_OFF = 254 * MiB;


__device__ __forceinline__ unsigned pk2(float lo, float hi) { return pg8::cvt_pk_bf16(lo, hi); }
__device__ __forceinline__ float bflo(unsigned u) { return __uint_as_float(u << 16); }
__device__ __forceinline__ float bfhi(unsigned u) { return __uint_as_float(u & 0xffff0000u); }
__device__ __forceinline__ float rcpf_(float x) { return __builtin_amdgcn_rcpf(x); }
__device__ __forceinline__ float sigmoidf_(float x) { return rcpf_(1.0f + __expf(-x)); }
__device__ __forceinline__ float siluf_(float x) { return x * rcpf_(1.0f + __expf(-x)); }
__device__ __forceinline__ float tanhf_(float x) { const float e = __expf(-2.0f * fabsf(x)); const float t = (1.0f - e) * rcpf_(1.0f + e); return x < 0.f ? -t : t; }
__device__ __forceinline__ float gelu_tanh(float x) { return 0.5f * x * (1.0f + tanhf_(0.7978845608028654f * (x + 0.044715f * x * x * x))); }
template <int CTRL> __device__ __forceinline__ float dppf(float x) { return __int_as_float(__builtin_amdgcn_update_dpp(0, __float_as_int(x), CTRL, 0xF, 0xF, true)); }
__device__ __forceinline__ float red8(float x) { x += dppf<0xB1>(x); x += dppf<0x4E>(x); x += dppf<0x141>(x); return x; }
__device__ __forceinline__ float red16(float x) { x = red8(x); x += dppf<0x140>(x); return x; }
__device__ __forceinline__ float wave_sum(float v) { for (int o = 32; o >= 1; o >>= 1) v += __shfl_xor(v, o); return v; }
__device__ __forceinline__ int otid() { int t = threadIdx.x; asm volatile("" : "+v"(t)); return t; }
typedef float f32x2 __attribute__((ext_vector_type(2)));
__device__ __forceinline__ float fma_s(float a, float b, float c) { float d; asm("v_fma_f32 %0, %1, %2, %3" : "=v"(d) : "v"(a), "v"(b), "v"(c)); return d; }
__device__ __forceinline__ float fnma_s(float a, float b, float c) { float d; asm("v_fma_f32 %0, -%1, %2, %3" : "=v"(d) : "v"(a), "v"(b), "v"(c)); return d; }
__device__ __forceinline__ float mul_s(float a, float b) { float d; asm("v_mul_f32 %0, %1, %2" : "=v"(d) : "v"(a), "v"(b)); return d; }
__device__ __forceinline__ float add_s(float a, float b) { float d; asm("v_add_f32 %0, %1, %2" : "=v"(d) : "v"(a), "v"(b)); return d; }
#define BAR_LDS() asm volatile("s_waitcnt lgkmcnt(0)\n\ts_barrier" ::: "memory")
#define LDS_FENCE() asm volatile("s_waitcnt lgkmcnt(0)" ::: "memory")

struct EpiConvIn {
    static constexpr bool PERM = false, AFTER_DRAIN = false;
    bf16_t* U; bf16_t* G;
    __device__ __forceinline__ void operator()(const f32x4 (&acc)[2][2][4][2], const Unit& u, int wr, int wc, int fr, int fq) const {
        const int row0 = u.pm * 256 + wr * 64 + fr, e0 = u.pn * 64 + wc * 16 + 4 * fq;
#pragma unroll
        for (int ai = 0; ai < 2; ++ai)
#pragma unroll
            for (int m = 0; m < 4; ++m) {
                const size_t o = (size_t)(row0 + ai * 128 + m * 16) * DM + e0;
                float uu[4], gg[4];
#pragma unroll
                for (int j = 0; j < 4; ++j) { uu[j] = acc[ai][0][m][1][j] * acc[ai][1][m][0][j]; gg[j] = acc[ai][0][m][0][j] * siluf_(acc[ai][1][m][1][j]); }
                *(uint2*)(U + o) = make_uint2(pk2(uu[0], uu[1]), pk2(uu[2], uu[3]));
                *(uint2*)(G + o) = make_uint2(pk2(gg[0], gg[1]), pk2(gg[2], gg[3]));
            }
    }
};
struct EpiWout {
    static constexpr bool PERM = false, AFTER_DRAIN = false;
    float* X; bf16_t* RB;
    __device__ __forceinline__ void operator()(const f32x4 (&acc)[2][2][4][2], const Unit& u, int wr, int wc, int fr, int fq) const {
        const int row0 = u.pm * 256 + wr * 64 + fr, col0 = u.pn * 256 + wc * 32 + 4 * fq;
#pragma unroll
        for (int ai = 0; ai < 2; ++ai)
#pragma unroll
            for (int m = 0; m < 4; ++m)
#pragma unroll
                for (int bj = 0; bj < 2; ++bj)
#pragma unroll
                    for (int n = 0; n < 2; ++n) {
                        const size_t o = (size_t)(row0 + ai * 128 + m * 16) * DM + col0 + bj * 128 + n * 16;
                        f32x4 x = *(const f32x4*)(X + o);
                        f32x4 r = x * DN_ALPHA + acc[ai][bj][m][n];
                        *(f32x4*)(X + o) = r;
                        *(uint2*)(RB + o) = make_uint2(pk2(r[0], r[1]), pk2(r[2], r[3]));
                    }
    }
};
struct EpiBf16 {
    static constexpr bool PERM = false, AFTER_DRAIN = false;
    bf16_t* O; int ldo; int split; size_t stride;
    __device__ __forceinline__ void operator()(const f32x4 (&acc)[2][2][4][2], const Unit& u, int wr, int wc, int fr, int fq) const {
        const int row0 = u.pm * 256 + wr * 64 + fr; const int grp = u.pn / split; const int col0 = (u.pn - grp * split) * 256 + wc * 32 + 4 * fq;
        bf16_t* base = O + (size_t)grp * stride;
#pragma unroll
        for (int ai = 0; ai < 2; ++ai)
#pragma unroll
            for (int m = 0; m < 4; ++m)
#pragma unroll
                for (int bj = 0; bj < 2; ++bj)
#pragma unroll
                    for (int n = 0; n < 2; ++n) {
                        const size_t o = (size_t)(row0 + ai * 128 + m * 16) * ldo + col0 + bj * 128 + n * 16;
                        const f32x4 a = acc[ai][bj][m][n];
                        *(uint2*)(base + o) = make_uint2(pk2(a[0], a[1]), pk2(a[2], a[3]));
                    }
    }
};
struct EpiPle {
    static constexpr bool PERM = false, AFTER_DRAIN = false;
    float* X; const bf16_t* PE;
    __device__ __forceinline__ void operator()(const f32x4 (&acc)[2][2][4][2], const Unit& u, int wr, int wc, int fr, int fq) const {
        const int row0 = u.pm * 256 + wr * 64 + fr, col0 = u.pn * 256 + wc * 32 + 4 * fq;
#pragma unroll
        for (int ai = 0; ai < 2; ++ai)
#pragma unroll
            for (int m = 0; m < 4; ++m)
#pragma unroll
                for (int bj = 0; bj < 2; ++bj)
#pragma unroll
                    for (int n = 0; n < 2; ++n) {
                        const size_t o = (size_t)(row0 + ai * 128 + m * 16) * DM + col0 + bj * 128 + n * 16;
                        f32x4 x = *(const f32x4*)(X + o); const uint2 pe = *(const uint2*)(PE + o); const f32x4 a = acc[ai][bj][m][n];
                        x[0] += bflo(pe.x) * sigmoidf_(a[0]); x[1] += bfhi(pe.x) * sigmoidf_(a[1]); x[2] += bflo(pe.y) * sigmoidf_(a[2]); x[3] += bfhi(pe.y) * sigmoidf_(a[3]);
                        *(f32x4*)(X + o) = x;
                    }
    }
};
struct EpiSsmIn {
    static constexpr bool PERM = false, AFTER_DRAIN = false;
    float* U; bf16_t* SZ;
    __device__ __forceinline__ void operator()(const f32x4 (&acc)[2][2][4][2], const Unit& u, int wr, int wc, int fr, int fq) const {
        const int row0 = u.pm * 256 + wr * 64 + fr; const bool isz = u.pn >= 4; const int col0 = (u.pn & 3) * 256 + wc * 32 + 4 * fq;
#pragma unroll
        for (int ai = 0; ai < 2; ++ai)
#pragma unroll
            for (int m = 0; m < 4; ++m)
#pragma unroll
                for (int bj = 0; bj < 2; ++bj)
#pragma unroll
                    for (int n = 0; n < 2; ++n) {
                        const size_t o = (size_t)(row0 + ai * 128 + m * 16) * DM + col0 + bj * 128 + n * 16;
                        const f32x4 a = acc[ai][bj][m][n];
                        if (isz) *(uint2*)(SZ + o) = make_uint2(pk2(siluf_(a[0]), siluf_(a[1])), pk2(siluf_(a[2]), siluf_(a[3])));
                        else *(f32x4*)(U + o) = a;
                    }
    }
};
struct EpiGlu {
    static constexpr bool PERM = false, AFTER_DRAIN = false;
    const bf16_t* YG; const bf16_t* SZ; const float* bias; bf16_t* V;
    __device__ __forceinline__ void operator()(const f32x4 (&acc)[2][2][4][2], const Unit& u, int wr, int wc, int fr, int fq) const {
        const int row0 = u.pm * 256 + wr * 64 + fr, col0 = u.pn * 256 + wc * 32 + 4 * fq;
#pragma unroll
        for (int ai = 0; ai < 2; ++ai)
#pragma unroll
            for (int m = 0; m < 4; ++m)
#pragma unroll
                for (int bj = 0; bj < 2; ++bj)
#pragma unroll
                    for (int n = 0; n < 2; ++n) {
                        const int col = col0 + bj * 128 + n * 16;
                        const size_t o = (size_t)(row0 + ai * 128 + m * 16) * DM + col;
                        const f32x4 a = acc[ai][bj][m][n]; const f32x4 bb = *(const f32x4*)(bias + col);
                        const uint2 y = *(const uint2*)(YG + o), z = *(const uint2*)(SZ + o);
                        const float v0 = bflo(y.x) * sigmoidf_(a[0] + bb[0]) * bflo(z.x), v1 = bfhi(y.x) * sigmoidf_(a[1] + bb[1]) * bfhi(z.x);
                        const float v2 = bflo(y.y) * sigmoidf_(a[2] + bb[2]) * bflo(z.y), v3 = bfhi(y.y) * sigmoidf_(a[3] + bb[3]) * bfhi(z.y);
                        *(uint2*)(V + o) = make_uint2(pk2(v0, v1), pk2(v2, v3));
                    }
    }
};
struct EpiRk {
    static constexpr bool PERM = false, AFTER_DRAIN = false;
    bf16_t* RKV; bf16_t* SZ; bf16_t* L1;
    __device__ __forceinline__ void operator()(const f32x4 (&acc)[2][2][4][2], const Unit& u, int wr, int wc, int fr, int fq) const {
        const int row0 = u.pm * 256 + wr * 64 + fr; const int grp = u.pn >> 2; const int colt = (u.pn & 3) * 256 + wc * 32 + 4 * fq;
#pragma unroll
        for (int ai = 0; ai < 2; ++ai)
#pragma unroll
            for (int m = 0; m < 4; ++m)
#pragma unroll
                for (int bj = 0; bj < 2; ++bj)
#pragma unroll
                    for (int n = 0; n < 2; ++n) {
                        const int row = row0 + ai * 128 + m * 16, col = colt + bj * 128 + n * 16;
                        const f32x4 a = acc[ai][bj][m][n];
                        if (grp < 3) *(uint2*)(RKV + (size_t)grp * MTOK * DM + (size_t)row * DM + col) = make_uint2(pk2(a[0], a[1]), pk2(a[2], a[3]));
                        else if (grp == 3) *(uint2*)(SZ + (size_t)row * DM + col) = make_uint2(pk2(siluf_(a[0]), siluf_(a[1])), pk2(siluf_(a[2]), siluf_(a[3])));
                        else { const bool th = col < 64;
                            const float v0 = th ? tanhf_(a[0]) : a[0], v1 = th ? tanhf_(a[1]) : a[1], v2 = th ? tanhf_(a[2]) : a[2], v3 = th ? tanhf_(a[3]) : a[3];
                            *(uint2*)(L1 + (size_t)row * 256 + col) = make_uint2(pk2(v0, v1), pk2(v2, v3)); }
                    }
    }
};

struct EpiLora2 {
    static constexpr bool PERM = false, AFTER_DRAIN = false;
    bf16_t* EW; bf16_t* AA; const float* w0; const float* a0;
    __device__ __forceinline__ void operator()(const f32x4 (&acc)[2][2][4][2], const Unit& u, int wr, int wc, int fr, int fq) const {
        const int row0 = u.pm * 256 + wr * 64 + fr; const bool isa = u.pn >= 4; const int col0 = (u.pn & 3) * 256 + wc * 32 + 4 * fq;
        bf16_t* O = isa ? AA : EW; const float* bias = isa ? a0 : w0;
#pragma unroll
        for (int bj = 0; bj < 2; ++bj)
#pragma unroll
            for (int n = 0; n < 2; ++n) {
                const int col = col0 + bj * 128 + n * 16; const f32x4 bb = *(const f32x4*)(bias + col);
#pragma unroll
                for (int ai = 0; ai < 2; ++ai)
#pragma unroll
                    for (int m = 0; m < 4; ++m) {
                        const f32x4 a = acc[ai][bj][m][n]; float v[4];
#pragma unroll
                        for (int j = 0; j < 4; ++j) { const float t = bb[j] + a[j];
                            if (isa) v[j] = sigmoidf_(t);
                            else { const float x = -t; const float sp = fmaxf(x, 0.f) + __logf(1.0f + __expf(-fabsf(x))); v[j] = __expf(-sp - 0.5f); } }
                        *(uint2*)(O + (size_t)(row0 + ai * 128 + m * 16) * DM + col) = make_uint2(pk2(v[0], v[1]), pk2(v[2], v[3]));
                    }
            }
    }
};

template <class Epi> __device__ __forceinline__ void run_gemm(LAS unsigned char* lds, const bf16_t* A, const bf16_t* Bt, int N, int K, const Epi& E) {
    Gemm g; g.A = A; g.Bt = Bt; g.M = MTOK; g.N = N; g.K = K;
    StaticOrder S; S.init(MTOK, N, (int)gridDim.x, (int)blockIdx.x);
    pg8::gemm_phase<Epi, StaticOrder, false>(lds, g, S, E, nullptr);
}

__device__ __forceinline__ int conv_rowmap(int n) { const int s = n >> 10, e = n & 1023, q = e & 63; return 256 * (e >> 6) + 128 * (s >> 1) + 32 * (q >> 4) + 16 * (s & 1) + (q & 15); }
__device__ __forceinline__ void tr_job(LAS float* tile, const float* src, int ld_src, int K, int N, bf16_t* dst, int ldd, int koff, const float* kscale, int mode, int rot) {
    const int nblk = (int)gridDim.x, blk = ((int)blockIdx.x + rot) % nblk, tid = otid();
    const int tn_ = N >> 6, ntiles = (K >> 6) * tn_;
    const int tk0 = tid >> 6, tn = tid & 63, nl = tid >> 3, kp = (tid & 7) * 8;
    float cur[8];
    if (blk < ntiles) { const int k0 = (blk / tn_) << 6, n0 = (blk % tn_) << 6;
#pragma unroll
        for (int i = 0; i < 8; ++i) cur[i] = src[(size_t)(k0 + tk0 + i * 8) * ld_src + n0 + tn]; }
    for (int t = blk; t < ntiles; t += nblk) {
        const int k0 = (t / tn_) << 6, n0 = (t % tn_) << 6;
        float nxt[8];
        const int t2 = t + nblk;
        if (t2 < ntiles) { const int k2 = (t2 / tn_) << 6, n2 = (t2 % tn_) << 6;
#pragma unroll
            for (int i = 0; i < 8; ++i) nxt[i] = src[(size_t)(k2 + tk0 + i * 8) * ld_src + n2 + tn]; }
        BAR_LDS();
#pragma unroll
        for (int i = 0; i < 8; ++i) tile[(tk0 + i * 8) * 65 + tn] = cur[i];
        BAR_LDS();
        float v[8];
#pragma unroll
        for (int i = 0; i < 8; ++i) { v[i] = tile[(kp + i) * 65 + nl]; if (kscale) v[i] *= kscale[k0 + kp + i]; }
        const int n = n0 + nl; const int row = mode ? conv_rowmap(n) : n;
        *(uint4*)(dst + (size_t)row * ldd + koff + k0 + kp) = make_uint4(pk2(v[0], v[1]), pk2(v[2], v[3]), pk2(v[4], v[5]), pk2(v[6], v[7]));
        if (t2 < ntiles) {
#pragma unroll
            for (int i = 0; i < 8; ++i) cur[i] = nxt[i]; }
    }
}
__device__ __forceinline__ void cvt_pb(const float* src, bf16_t* dst) {
    const size_t n4 = (size_t)MTOK * 256 / 4, nth = (size_t)gridDim.x * 512;
    for (size_t i = (size_t)blockIdx.x * 512 + otid(); i < n4; i += nth) { const float4 v = ((const float4*)src)[i]; ((uint2*)dst)[i] = make_uint2(pk2(v.x, v.y), pk2(v.z, v.w)); }
}
__device__ __forceinline__ void conv_layer_weights(const P& p, LAS float* tile, int j, int L) {
    unsigned char* ws = p.ws;
    tr_job(tile, p.in[2] + (size_t)j * 1024 * 4096, 4096, 1024, 4096, (bf16_t*)(ws + W_CIN), 1024, 0, nullptr, 1, 0);
    tr_job(tile, p.in[4] + (size_t)j * 1024 * 1024, 1024, 1024, 1024, (bf16_t*)(ws + W_COUT), 1024, 0, nullptr, 0, 0);
    tr_job(tile, p.in[31] + (size_t)L * 256 * 1024, 1024, 256, 1024, (bf16_t*)(ws + W_PEC), 256, 0, nullptr, 0, 0);
    tr_job(tile, p.in[32] + (size_t)L * 1024 * 1024, 1024, 1024, 1024, (bf16_t*)(ws + W_PGC), 1024, 0, nullptr, 0, 64);
}

__device__ __forceinline__ void phase_prep(const P& p, LAS float* tile) {
    unsigned char* ws = p.ws; const size_t nth = (size_t)gridDim.x * 512, gt = (size_t)blockIdx.x * 512 + otid();
    {
        const float4* x = (const float4*)p.in[0]; float4* o = (float4*)p.out; uint2* a = (uint2*)(ws + ACT);
        for (size_t i = gt; i < (size_t)MTOK * DM / 4; i += nth) { const float4 v = x[i]; o[i] = v; a[i] = make_uint2(pk2(v.x, v.y), pk2(v.z, v.w)); }
    }
    cvt_pb(p.in[1], (bf16_t*)(ws + PB));
    conv_layer_weights(p, tile, 0, 0);
    tr_job(tile, p.in[5], 2048, 1024, 2048, (bf16_t*)(ws + W_SIN), 1024, 0, nullptr, 0, 128);
    tr_job(tile, p.in[14], 1024, 1024, 1024, (bf16_t*)(ws + W_SGLU), 1024, 0, nullptr, 0, 0);
    tr_job(tile, p.in[16], 1024, 1024, 1024, (bf16_t*)(ws + W_SOUT), 1024, 0, nullptr, 0, 0);
    tr_job(tile, p.in[31] + (size_t)1 * 256 * 1024, 1024, 256, 1024, (bf16_t*)(ws + W_PE1), 256, 0, nullptr, 0, 192);
    tr_job(tile, p.in[32] + (size_t)1 * 1024 * 1024, 1024, 1024, 1024, (bf16_t*)(ws + W_PG1), 1024, 0, nullptr, 0, 0);
    bf16_t* rk = (bf16_t*)(ws + W_RK);
    for (int g = 0; g < 4; ++g) {
        tr_job(tile, p.in[18] + (size_t)g * 1024 * 1024, 1024, 1024, 1024, rk + (size_t)g * 1024 * 2048, 2048, 0, nullptr, 0, 0);
        tr_job(tile, p.in[18] + (size_t)g * 1024 * 1024, 1024, 1024, 1024, rk + (size_t)g * 1024 * 2048, 2048, 1024, p.in[17] + g * 1024, 0, 0);
    }
    tr_job(tile, p.in[20], 64, 1024, 64, rk + (size_t)4096 * 2048, 2048, 0, nullptr, 0, 0);
    tr_job(tile, p.in[20], 64, 1024, 64, rk + (size_t)4096 * 2048, 2048, 1024, p.in[17] + 4 * 1024, 0, 16);
    tr_job(tile, p.in[23], 64, 1024, 64, rk + (size_t)4160 * 2048, 2048, 0, nullptr, 0, 32);
    tr_job(tile, p.in[23], 64, 1024, 64, rk + (size_t)4160 * 2048, 2048, 1024, p.in[17] + 5 * 1024, 0, 48);
    {
        uint4* z = (uint4*)(rk + (size_t)4224 * 2048);
        for (size_t i = gt; i < (size_t)128 * 2048 / 8; i += nth) z[i] = make_uint4(0, 0, 0, 0);
    }
    bf16_t* l2 = (bf16_t*)(ws + W_L2);
    tr_job(tile, p.in[21], 1024, 64, 1024, l2, 256, 0, nullptr, 0, 64);
    tr_job(tile, p.in[24], 1024, 64, 1024, l2 + (size_t)1024 * 256, 256, 64, nullptr, 0, 80);
    for (size_t i = gt; i < (size_t)2048 * 32; i += nth) { const int row = (int)(i >> 5), c8 = (int)(i & 31); const bool data = row < 1024 ? (c8 < 8) : (c8 >= 8 && c8 < 16);
        if (!data) *(uint4*)(l2 + (size_t)row * 256 + c8 * 8) = make_uint4(0, 0, 0, 0); }
    tr_job(tile, p.in[30], 1024, 1024, 1024, (bf16_t*)(ws + W_ROUT), 1024, 0, nullptr, 0, 96);
    tr_job(tile, p.in[31] + (size_t)2 * 256 * 1024, 1024, 256, 1024, (bf16_t*)(ws + W_PE2), 256, 0, nullptr, 0, 160);
    tr_job(tile, p.in[32] + (size_t)2 * 1024 * 1024, 1024, 1024, 1024, (bf16_t*)(ws + W_PG2), 1024, 0, nullptr, 0, 0);
}

__device__ __forceinline__ void phase_conv_ew(const bf16_t* U, bf16_t* G, const float* ck) {
    const size_t nth = (size_t)gridDim.x * 512;
    for (size_t i = (size_t)blockIdx.x * 512 + otid(); i < (size_t)MTOK * 128; i += nth) {
        const int row = (int)(i >> 7), c8 = (int)(i & 127) * 8, t = row & (SEQL - 1);
        const uint4 z4 = make_uint4(0, 0, 0, 0);
        const uint4 u0 = *(const uint4*)(U + (size_t)row * DM + c8);
        const uint4 u1 = t >= 1 ? *(const uint4*)(U + (size_t)(row - 1) * DM + c8) : z4;
        const uint4 u2 = t >= 2 ? *(const uint4*)(U + (size_t)(row - 2) * DM + c8) : z4;
        const uint4 g = *(const uint4*)(G + (size_t)row * DM + c8);
        const unsigned a0[4] = {u0.x, u0.y, u0.z, u0.w}, a1[4] = {u1.x, u1.y, u1.z, u1.w}, a2[4] = {u2.x, u2.y, u2.z, u2.w}, gg[4] = {g.x, g.y, g.z, g.w};
        unsigned o[4];
#pragma unroll
        for (int q = 0; q < 4; ++q) {
            const int c = c8 + 2 * q;
            const float lo = bflo(gg[q]) * (ck[c] * bflo(a2[q]) + ck[1024 + c] * bflo(a1[q]) + ck[2048 + c] * bflo(a0[q]));
            const float hi = bfhi(gg[q]) * (ck[c + 1] * bfhi(a2[q]) + ck[1024 + c + 1] * bfhi(a1[q]) + ck[2048 + c + 1] * bfhi(a0[q]));
            o[q] = pk2(lo, hi);
        }
        *(uint4*)(G + (size_t)row * DM + c8) = make_uint4(o[0], o[1], o[2], o[3]);
    }
}

__device__ __forceinline__ void phase_ln(float* X, bf16_t* XB, const float* g, const float* b) {
    const int lane = otid() & 63, gw = blockIdx.x * 8 + (otid() >> 6), nw = gridDim.x * 8;
    for (int row = gw; row < MTOK; row += nw) {
        float4 v[4]; float s = 0.f;
#pragma unroll
        for (int i = 0; i < 4; ++i) { v[i] = *(const float4*)(X + (size_t)row * DM + i * 256 + lane * 4); s += v[i].x + v[i].y + v[i].z + v[i].w; }
        const float mean = wave_sum(s) * (1.0f / 1024.0f);
        float q = 0.f;
#pragma unroll
        for (int i = 0; i < 4; ++i) { v[i].x -= mean; v[i].y -= mean; v[i].z -= mean; v[i].w -= mean; q += v[i].x * v[i].x + v[i].y * v[i].y + v[i].z * v[i].z + v[i].w * v[i].w; }
        const float rs = rsqrtf(wave_sum(q) * (1.0f / 1024.0f) + 1e-5f);
#pragma unroll
        for (int i = 0; i < 4; ++i) { const int c = i * 256 + lane * 4; const float4 gg = *(const float4*)(g + c), bb = *(const float4*)(b + c);
            float4 y; y.x = v[i].x * rs * gg.x + bb.x; y.y = v[i].y * rs * gg.y + bb.y; y.z = v[i].z * rs * gg.z + bb.z; y.w = v[i].w * rs * gg.w + bb.w;
            *(float4*)(X + (size_t)row * DM + c) = y; *(uint2*)(XB + (size_t)row * DM + c) = make_uint2(pk2(y.x, y.y), pk2(y.z, y.w)); }
    }
}

template <int FINAL> __device__ __forceinline__ void phase_s5(const P& p, LAS unsigned char* lds_, const float* U, float* HLOC, bf16_t* YG) {
    const int lane = otid() & 63, wid = otid() >> 6, nw = gridDim.x * 8;
    LAS float* ul = (LAS float*)(lds_ + wid * 8192);
    LAS unsigned* S = (LAS unsigned*)(lds_ + wid * 8192 + 2048);
    const int fr = lane & 15, fq = lane >> 4;
    for (int un = blockIdx.x * 8 + wid; un < 2048; un += nw) {
        const int g = un & 63, sc = (un >> 6) & 7, b = un >> 9;
        if (!FINAL && sc == 7) continue;
        const float dt = __expf(p.in[8][g]);
        const float lre = p.in[6][g * 64 + lane], lim = p.in[7][g * 64 + lane];
        const float mag = expf(lre * dt); float sn, cs; sincosf(lim * dt, &sn, &cs);
        const float are = mag * cs, aim = mag * sn;
        const float d2 = lre * lre + lim * lim, cfre = ((are - 1.0f) * lre + aim * lim) / d2, cfim = (aim * lre - (are - 1.0f) * lim) / d2;
        f32x2 Bp[16];
#pragma unroll
        for (int q = 0; q < 4; ++q) { const float4 br = *(const float4*)(p.in[9] + (size_t)(g * 64 + lane) * 16 + q * 4), bi = *(const float4*)(p.in[10] + (size_t)(g * 64 + lane) * 16 + q * 4);
            const float brr[4] = {br.x, br.y, br.z, br.w}, bii[4] = {bi.x, bi.y, bi.z, bi.w};
#pragma unroll
            for (int j = 0; j < 4; ++j) { Bp[q * 4 + j] = (f32x2){cfre * brr[j] - cfim * bii[j], cfre * bii[j] + cfim * brr[j]}; } }
        float hre = 0.f, him = 0.f;
        bf16x8 Cf[4]; float dsk = 0.f;
        if (FINAL) {
            float lr = are, li = aim;
#pragma unroll
            for (int i = 0; i < 9; ++i) { const float t = lr * lr - li * li; li = 2.0f * lr * li; lr = t; }
            for (int s2 = 0; s2 < sc; ++s2) { const float2 hv = *(const float2*)(HLOC + ((size_t)((b * 8 + s2) * 64 + g) * 64 + lane) * 2);
                const float t = lr * hre - li * him + hv.x; him = lr * him + li * hre + hv.y; hre = t; }
#pragma unroll
            for (int kk = 0; kk < 4; ++kk) {
                unsigned w[4];
#pragma unroll
                for (int i = 0; i < 4; ++i) { const int pi = 16 * kk + 4 * fq + i; const size_t o = (size_t)(g * 16 + fr) * 64 + pi; w[i] = pk2(p.in[11][o], -p.in[12][o]); }
                union { unsigned u[4]; bf16x8 v; } cv; cv.u[0] = w[0]; cv.u[1] = w[1]; cv.u[2] = w[2]; cv.u[3] = w[3]; Cf[kk] = cv.v;
            }
            dsk = p.in[13][g * 16 + fr];
        }
        const size_t tok0 = (size_t)b * SEQL + (size_t)sc * 512;
        const float* ug = U + tok0 * DM + g * 16 + (lane & 3) * 4 + (size_t)(lane >> 2) * DM;
        f32x4 nxt = *(const f32x4*)ug;
        LDS_FENCE();
        *(LAS f32x4*)(ul + lane * 4) = nxt;
        for (int blk = 0; blk < 32; ++blk) {
            const int cur = blk & 1;
            if (blk + 1 < 32) nxt = *(const f32x4*)(ug + (size_t)(blk + 1) * 16 * DM);
            LDS_FENCE();
#pragma unroll 4
            for (int tt = 0; tt < 16; ++tt) {
                float uu[16];
#pragma unroll
                for (int q = 0; q < 4; ++q) { const f32x4 t4 = *(const LAS f32x4*)(ul + cur * 256 + tt * 16 + q * 4); uu[q * 4] = t4[0]; uu[q * 4 + 1] = t4[1]; uu[q * 4 + 2] = t4[2]; uu[q * 4 + 3] = t4[3]; }
                f32x2 b0 = {0.f, 0.f}, b1 = {0.f, 0.f};
#pragma unroll
                for (int h = 0; h < 16; h += 2) { b0 = Bp[h] * (f32x2){uu[h], uu[h]} + b0; b1 = Bp[h + 1] * (f32x2){uu[h + 1], uu[h + 1]} + b1; }
                const f32x2 bs = b0 + b1; const float bre = bs[0], bim = bs[1];
                const float t = are * hre - aim * him + bre; him = are * him + aim * hre + bim; hre = t;
                if (FINAL) S[tt * 68 + lane] = pk2(hre, him);
            }
            if (FINAL) {
                LDS_FENCE();
                f32x4 acc = {0.f, 0.f, 0.f, 0.f};
#pragma unroll
                for (int kk = 0; kk < 4; ++kk) { const bf16x8 af = *(const LAS bf16x8*)(S + fr * 68 + 16 * kk + 4 * fq); acc = __builtin_amdgcn_mfma_f32_16x16x32_bf16(af, Cf[kk], acc, 0, 0, 0); }
#pragma unroll
                for (int i = 0; i < 4; ++i) { const int tl = 4 * fq + i; const float y = acc[i] + dsk * ul[cur * 256 + tl * 16 + fr];
                    const unsigned short hb = (unsigned short)(pk2(gelu_tanh(y), 0.f) & 0xffffu);
                    YG[(tok0 + blk * 16 + tl) * DM + g * 16 + fr] = hb; }
            }
            LDS_FENCE();
            if (blk + 1 < 32) *(LAS f32x4*)(ul + (cur ^ 1) * 256 + lane * 4) = nxt;
        }
        if (!FINAL) *(float2*)(HLOC + ((size_t)un * 64 + lane) * 2) = make_float2(hre, him);
    }
}

__device__ __forceinline__ void phase_rw_prep(const float* X, bf16_t* XDX) {
    const size_t nth = (size_t)gridDim.x * 512;
    for (size_t i = (size_t)blockIdx.x * 512 + otid(); i < (size_t)MTOK * 256; i += nth) {
        const int row = (int)(i >> 8), c4 = (int)(i & 255) * 4, t = row & (SEQL - 1);
        const float4 x = *(const float4*)(X + (size_t)row * DM + c4);
        float4 xp = make_float4(0.f, 0.f, 0.f, 0.f); if (t >= 1) xp = *(const float4*)(X + (size_t)(row - 1) * DM + c4);
        *(uint2*)(XDX + (size_t)row * 2048 + c4) = make_uint2(pk2(x.x, x.y), pk2(x.z, x.w));
        *(uint2*)(XDX + (size_t)row * 2048 + 1024 + c4) = make_uint2(pk2(xp.x - x.x, xp.y - x.y), pk2(xp.z - x.z, xp.w - x.w));
    }
}
__device__ __forceinline__ void unpack8(const uint4 v, float* f) { f[0] = bflo(v.x); f[1] = bfhi(v.x); f[2] = bflo(v.y); f[3] = bfhi(v.y); f[4] = bflo(v.z); f[5] = bfhi(v.z); f[6] = bflo(v.w); f[7] = bfhi(v.w); }

constexpr int RW_T = 32, RW_STEP = 336;
constexpr int RW_BUF = RW_T * RW_STEP, RW_OB = RW_T * 16 * 16;
struct RwOp { f32x4 r, w, kp, kk, ka; float v; };
__device__ __forceinline__ void rw_load(RwOp& o, const LAS float* sb, int j0, int rr) {
    o.r = *(const LAS f32x4*)(sb + j0); o.w = *(const LAS f32x4*)(sb + 64 + j0); o.kp = *(const LAS f32x4*)(sb + 128 + j0);
    o.kk = *(const LAS f32x4*)(sb + 192 + j0); o.ka = *(const LAS f32x4*)(sb + 256 + j0); o.v = sb[320 + rr];
}
template <int MODE> __device__ __forceinline__ float rw_step(const RwOp& o, float& s0, float& s1, float& s2, float& s3) {
    const float dsum = fmaf(s0, o.kk[0], s1 * o.kk[1]) + fmaf(s2, o.kk[2], s3 * o.kk[3]);
    const float sa = MODE == 3 ? -dsum : -red16(dsum);
    s0 = fmaf(s0, o.w[0], fmaf(sa, o.ka[0], o.v * o.kp[0])); s1 = fmaf(s1, o.w[1], fmaf(sa, o.ka[1], o.v * o.kp[1]));
    s2 = fmaf(s2, o.w[2], fmaf(sa, o.ka[2], o.v * o.kp[2])); s3 = fmaf(s3, o.w[3], fmaf(sa, o.ka[3], o.v * o.kp[3]));
    return fmaf(s0, o.r[0], s1 * o.r[1]) + fmaf(s2, o.r[2], s3 * o.r[3]);
}
__device__ __forceinline__ void rw_flush(const LAS float* ob, bf16_t* dst) {
    float o2[2];
#pragma unroll
    for (int q = 0; q < 2; ++q) { float a = 0.f;
#pragma unroll
        for (int i = 0; i < 4; ++i) { const f32x4 t = *(const LAS f32x4*)(ob + q * 16 + i * 4); a += (t[0] + t[1]) + (t[2] + t[3]); }
        o2[q] = a; }
    *(unsigned*)dst = pk2(o2[0], o2[1]);
}
template <int MODE> __device__ __forceinline__ void phase_rw_scan(const P& p, LAS unsigned char* lds_, const bf16_t* R, const bf16_t* K, const bf16_t* V, const bf16_t* DW, const bf16_t* DA, bf16_t* OUT) {
    LAS float* buf = (LAS float*)lds_;
    LAS float* obuf = buf + 2 * RW_BUF;
    const int tid = otid(), lane = tid & 63, wid = __builtin_amdgcn_readfirstlane(tid >> 6);
    for (int un = blockIdx.x; un < 256; un += gridDim.x) {
        const int bh = un >> 2, rg = un & 3, b = bh >> 4, h = bh & 15;
        __syncthreads();
        if (wid < 4) {
            const int rr = wid * 4 + (lane >> 4), jl = lane & 15, j0 = jl * 4;
            float s0 = 0.f, s1 = 0.f, s2 = 0.f, s3 = 0.f;
            BAR_LDS();
            for (int c = 0; c < SEQL / RW_T; ++c) {
                const LAS float* cb = buf + (c & 1) * RW_BUF; LAS float* ob = obuf + (c & 1) * RW_OB + rr * 16 + jl;
                if (MODE != 1) {
                RwOp ops[3];
                rw_load(ops[0], cb, j0, rr); rw_load(ops[1], cb + RW_STEP, j0, rr);
#pragma unroll
                for (int s = 0; s < RW_T; ++s) {
                    if (s + 2 < RW_T) rw_load(ops[(s + 2) % 3], cb + (s + 2) * RW_STEP, j0, rr);
                    ob[s * 256] = rw_step<MODE>(ops[s % 3], s0, s1, s2, s3);
                }
                }
                BAR_LDS();
            }
        } else {
            const int pt = tid - 256, s = pt >> 3, part = pt & 7, c0 = part * 8, ch = h * 64 + c0;
            float kk_[8], ka_[8];
#pragma unroll
            for (int i = 0; i < 8; ++i) { kk_[i] = p.in[25][ch + i]; ka_[i] = p.in[26][ch + i]; }
            const size_t rowb = (size_t)b * SEQL + s;
            uint4 qr, qk, qw, qa, qv = make_uint4(0, 0, 0, 0);
            { const size_t o = rowb * DM + ch; qr = *(const uint4*)(R + o); qk = *(const uint4*)(K + o); qw = *(const uint4*)(DW + o); qa = *(const uint4*)(DA + o);
              if (part < 2) qv = *(const uint4*)(V + rowb * DM + h * 64 + rg * 16 + part * 8); }
            for (int c = 0; c <= SEQL / RW_T; ++c) {
                uint4 nr = qr, nk = qk, nw = qw, na = qa, nv = qv;
                if (MODE != 2 && c + 1 < SEQL / RW_T) { const size_t row = rowb + (size_t)(c + 1) * RW_T; const size_t o = row * DM + ch;
                    nr = *(const uint4*)(R + o); nk = *(const uint4*)(K + o); nw = *(const uint4*)(DW + o); na = *(const uint4*)(DA + o);
                    if (part < 2) nv = *(const uint4*)(V + row * DM + h * 64 + rg * 16 + part * 8); }
                if (MODE != 2 && c < SEQL / RW_T) {
                    float r[8], k[8], ew[8], aa[8];
                    unpack8(qr, r); unpack8(qk, k); unpack8(qw, ew); unpack8(qa, aa);
                    float wv[8], kp[8], kk[8], ka[8]; float ss = 0.f;
#pragma unroll
                    for (int i = 0; i < 8; ++i) {
                        wv[i] = __expf(-ew[i]);
                        kk[i] = k[i] * kk_[i]; ss = fmaf(kk[i], kk[i], ss);
                        kp[i] = k[i] * fmaf(aa[i] - 1.0f, ka_[i], 1.0f);
                    }
                    ss = red8(ss); const float inv = rcpf_(fmaxf(__builtin_amdgcn_sqrtf(ss), 1e-12f));
#pragma unroll
                    for (int i = 0; i < 8; ++i) { kk[i] *= inv; ka[i] = kk[i] * aa[i]; }
                    LAS float* sb = buf + (c & 1) * RW_BUF + s * RW_STEP + c0;
                    *(LAS f32x4*)(sb) = (f32x4){r[0], r[1], r[2], r[3]}; *(LAS f32x4*)(sb + 4) = (f32x4){r[4], r[5], r[6], r[7]};
                    *(LAS f32x4*)(sb + 64) = (f32x4){wv[0], wv[1], wv[2], wv[3]}; *(LAS f32x4*)(sb + 68) = (f32x4){wv[4], wv[5], wv[6], wv[7]};
                    *(LAS f32x4*)(sb + 128) = (f32x4){kp[0], kp[1], kp[2], kp[3]}; *(LAS f32x4*)(sb + 132) = (f32x4){kp[4], kp[5], kp[6], kp[7]};
                    *(LAS f32x4*)(sb + 192) = (f32x4){kk[0], kk[1], kk[2], kk[3]}; *(LAS f32x4*)(sb + 196) = (f32x4){kk[4], kk[5], kk[6], kk[7]};
                    *(LAS f32x4*)(sb + 256) = (f32x4){ka[0], ka[1], ka[2], ka[3]}; *(LAS f32x4*)(sb + 260) = (f32x4){ka[4], ka[5], ka[6], ka[7]};
                    if (part < 2) { float v[8]; unpack8(qv, v);
                        LAS float* vb = buf + (c & 1) * RW_BUF + s * RW_STEP + 320 + part * 8;
                        *(LAS f32x4*)(vb) = (f32x4){v[0], v[1], v[2], v[3]}; *(LAS f32x4*)(vb + 4) = (f32x4){v[4], v[5], v[6], v[7]}; }
                }
                if (MODE == 0 && c >= 2) {
                    const int cc = c - 2; const size_t row = (size_t)b * SEQL + (size_t)cc * RW_T + s;
                    rw_flush(obuf + (cc & 1) * RW_OB + s * 256 + part * 32, OUT + row * DM + h * 64 + rg * 16 + part * 2);
                }
                BAR_LDS();
                qr = nr; qk = nk; qw = nw; qa = na; qv = nv;
            }
            if (MODE == 0) {
                const int cc = SEQL / RW_T - 1; const size_t row = (size_t)b * SEQL + (size_t)cc * RW_T + s;
                rw_flush(obuf + (cc & 1) * RW_OB + s * 256 + part * 32, OUT + row * DM + h * 64 + rg * 16 + part * 2);
            }
        }
    }
}

__device__ __forceinline__ void phase_rw_post(const P& p, const bf16_t* OUT, const bf16_t* R, const bf16_t* K, const bf16_t* V, const bf16_t* DA, const bf16_t* SZ, bf16_t* OF) {
    const size_t nth = (size_t)gridDim.x * 512;
    for (size_t it = (size_t)blockIdx.x * 512 + otid(); it < (size_t)MTOK * 128; it += nth) {
        const int c0 = (int)(it & 127) * 8; const size_t o = (it >> 7) * DM + c0;
        float ov[8], r[8], k[8], v[8], da[8], sz[8];
        unpack8(*(const uint4*)(OUT + o), ov); unpack8(*(const uint4*)(R + o), r); unpack8(*(const uint4*)(K + o), k); unpack8(*(const uint4*)(V + o), v);
        unpack8(*(const uint4*)(DA + o), da); unpack8(*(const uint4*)(SZ + o), sz);
        float sm = 0.f, dot = 0.f;
#pragma unroll
        for (int i = 0; i < 8; ++i) { const float a = da[i]; const float kp = k[i] * (1.0f + (a - 1.0f) * p.in[26][c0 + i]);
            dot += r[i] * kp * p.in[27][c0 + i]; sm += ov[i]; }
        dot = red8(dot); const float mean = red8(sm) * (1.0f / 64.0f);
        float q = 0.f;
#pragma unroll
        for (int i = 0; i < 8; ++i) { ov[i] -= mean; q += ov[i] * ov[i]; }
        const float rs = rsqrtf(red8(q) * (1.0f / 64.0f) + 64e-5f);
        float y[8];
#pragma unroll
        for (int i = 0; i < 8; ++i) y[i] = (ov[i] * rs * p.in[28][c0 + i] + p.in[29][c0 + i] + dot * v[i]) * sz[i];
        *(uint4*)(OF + o) = make_uint4(pk2(y[0], y[1]), pk2(y[2], y[3]), pk2(y[4], y[5]), pk2(y[6], y[7]));
    }
}

__global__ void __launch_bounds__(512, 2) fwd_mega(P p) {
    extern __shared__ __attribute__((aligned(16))) unsigned char shm[];
    LAS unsigned char* lds = (LAS unsigned char*)shm;
    LAS float* tile = (LAS float*)shm;
    cg::grid_group grid = cg::this_grid();
    volatile LAS unsigned* xst = (volatile LAS unsigned*)(lds + LDS_XST);
    if (threadIdx.x == 0) { xst[0] = 0u; xst[1] = 0u; }
    __syncthreads();
    const XcdBarrier xb = xcd_barrier_post((unsigned*)(p.ws + BAR_OFF), xst);
    unsigned char* ws = p.ws; float* X = p.out;
    bf16_t* act = (bf16_t*)(ws + ACT); bf16_t* pb = (bf16_t*)(ws + PB);
    phase_prep(p, tile);
    grid.sync();
    for (int d = 0; d < DUP_PREP; ++d) { phase_prep(p, tile); xcd_barrier(xb); }
    for (int d = 0; d < DUP_SYNC; ++d) xcd_barrier(xb);
#define LAYER_TAIL(L, Aout, Wout, Wpe, Wpg, PEB) \
    { EpiWout E; E.X = X; E.RB = act; run_gemm(lds, Aout, Wout, 1024, 1024, E); } \
    { EpiBf16 E; E.O = PEB; E.ldo = 1024; E.split = 1 << 20; E.stride = 0; run_gemm(lds, pb, Wpe, 1024, 256, E); } \
    xcd_barrier(xb); \
    { EpiPle E; E.X = X; E.PE = PEB; run_gemm(lds, act, Wpg, 1024, 1024, E); } \
    xcd_barrier(xb); \
    phase_ln(X, act, p.in[33] + (L) * 1024, p.in[34] + (L) * 1024);
#define CONV_LAYER(L, j) { \
        bf16_t* U = (bf16_t*)(ws + T0); bf16_t* G = (bf16_t*)(ws + T0 + 32 * MiB); \
        { EpiConvIn E; E.U = U; E.G = G; run_gemm(lds, act, (const bf16_t*)(ws + W_CIN), 4096, 1024, E); } \
        xcd_barrier(xb); \
        phase_conv_ew(U, G, p.in[3] + (size_t)(j) * 3 * 1024); \
        if ((L) > 0) cvt_pb(p.in[1] + (size_t)(L) * MTOK * 256, pb); \
        xcd_barrier(xb); \
        LAYER_TAIL(L, G, (const bf16_t*)(ws + W_COUT), (const bf16_t*)(ws + W_PEC), (const bf16_t*)(ws + W_PGC), (bf16_t*)(ws + T0 + 64 * MiB)) }
    CONV_LAYER(0, 0)
    xcd_barrier(xb);
    {
        float* U = (float*)(ws + T0); bf16_t* SZ = (bf16_t*)(ws + T0 + 64 * MiB); bf16_t* YG = (bf16_t*)(ws + T0 + 96 * MiB); bf16_t* V = (bf16_t*)(ws + T0 + 128 * MiB);
        float* HL = (float*)(ws + T0 + 160 * MiB);
        { EpiSsmIn E; E.U = U; E.SZ = SZ; run_gemm(lds, act, (const bf16_t*)(ws + W_SIN), 2048, 1024, E); }
        xcd_barrier(xb);
        phase_s5<0>(p, lds, U, HL, YG);
        cvt_pb(p.in[1] + (size_t)1 * MTOK * 256, pb);
        xcd_barrier(xb);
        phase_s5<1>(p, lds, U, HL, YG);
        xcd_barrier(xb);
        for (int d = 0; d < DUP_S5; ++d) { phase_s5<0>(p, lds, U, HL, YG); xcd_barrier(xb); phase_s5<1>(p, lds, U, HL, YG); xcd_barrier(xb); }
        { EpiGlu E; E.YG = YG; E.SZ = SZ; E.bias = p.in[15]; E.V = V; run_gemm(lds, YG, (const bf16_t*)(ws + W_SGLU), 1024, 1024, E); }
        xcd_barrier(xb);
        LAYER_TAIL(1, V, (const bf16_t*)(ws + W_SOUT), (const bf16_t*)(ws + W_PE1), (const bf16_t*)(ws + W_PG1), (bf16_t*)(ws + T0))
    }
    xcd_barrier(xb);
    {
        bf16_t* XDX = (bf16_t*)(ws + T0); bf16_t* RKV = (bf16_t*)(ws + T0 + 64 * MiB);
        bf16_t* Rb = RKV; bf16_t* Kb = RKV + (size_t)MTOK * DM; bf16_t* Vb = RKV + (size_t)2 * MTOK * DM;
        bf16_t* SZ = act; bf16_t* L1 = pb; bf16_t* DW = (bf16_t*)(ws + T0); bf16_t* DA = (bf16_t*)(ws + T0 + 32 * MiB);
        bf16_t* OUT = (bf16_t*)(ws + OUT_RW); bf16_t* OF = (bf16_t*)(ws + T0);
        phase_rw_prep(X, XDX);
        xcd_barrier(xb);
        { EpiRk E; E.RKV = RKV; E.SZ = SZ; E.L1 = L1; run_gemm(lds, XDX, (const bf16_t*)(ws + W_RK), 4352, 2048, E); }
        xcd_barrier(xb);
        for (int d = 0; d < DUP_RK; ++d) { EpiRk E; E.RKV = RKV; E.SZ = SZ; E.L1 = L1; run_gemm(lds, XDX, (const bf16_t*)(ws + W_RK), 4352, 2048, E); xcd_barrier(xb); }
        { EpiLora2 E; E.EW = DW; E.AA = DA; E.w0 = p.in[19]; E.a0 = p.in[22]; run_gemm(lds, L1, (const bf16_t*)(ws + W_L2), 2048, 256, E); }
        xcd_barrier(xb);
        phase_rw_scan<0>(p, lds, Rb, Kb, Vb, DW, DA, OUT);
        xcd_barrier(xb);
        for (int d = 0; d < DUP_RWSCAN; ++d) { phase_rw_scan<DUP_MODE>(p, lds, Rb, Kb, Vb, DW, DA, OUT); xcd_barrier(xb); }
        phase_rw_post(p, OUT, Rb, Kb, Vb, DA, SZ, OF);
        for (int d = 0; d < DUP_EW; ++d) { xcd_barrier(xb); phase_rw_post(p, OUT, Rb, Kb, Vb, DA, SZ, OF); }
        cvt_pb(p.in[1] + (size_t)2 * MTOK * 256, pb);
        xcd_barrier(xb);
        LAYER_TAIL(2, OF, (const bf16_t*)(ws + W_ROUT), (const bf16_t*)(ws + W_PE2), (const bf16_t*)(ws + W_PG2), (bf16_t*)(ws + T0 + 32 * MiB))
        __syncthreads();
        conv_layer_weights(p, tile, 1, 3);
    }
    xcd_barrier(xb);
    CONV_LAYER(3, 1)
}

extern "C" void kernel_launch(void* const* d_in, const int* in_sizes, int n_in, void* d_out, int out_size, void* d_ws, size_t ws_size, hipStream_t stream) {
    static int grid_blocks = 0;
    if (!grid_blocks) {
        int dev = 0, cus = 0, per_cu = 0;
        hipGetDevice(&dev);
        hipDeviceGetAttribute(&cus, hipDeviceAttributeMultiprocessorCount, dev);
        hipFuncSetAttribute((const void*)fwd_mega, hipFuncAttributeMaxDynamicSharedMemorySize, LDS_BYTES);
        hipOccupancyMaxActiveBlocksPerMultiprocessor(&per_cu, (const void*)fwd_mega, 512, LDS_BYTES);
        if (per_cu < 1) { fprintf(stderr, "occupancy query returned %d\n", per_cu); per_cu = 1; }
        grid_blocks = cus;
        if (ws_size < 256 * MiB) fprintf(stderr, "workspace too small: %zu\n", ws_size);
    }
    P p{};
    for (int i = 0; i < 35; ++i) p.in[i] = (const float*)d_in[i];
    p.out = (float*)d_out; p.ws = (unsigned char*)d_ws;
    hipMemsetAsync((unsigned char*)d_ws + BAR_OFF, 0, XCD_BAR_WORDS * sizeof(unsigned), stream);
    void* args[] = {&p};
    hipError_t e = hipLaunchCooperativeKernel((const void*)fwd_mega, dim3(grid_blocks), dim3(512), args, LDS_BYTES, stream);
    if (e != hipSuccess) fprintf(stderr, "cooperative launch failed: %s (grid %d)\n", hipGetErrorString(e), grid_blocks);
}
```

```cpp
#include <hip/hip_runtime.h>
#include <hip/hip_cooperative_groups.h>
#include <cstdio>
namespace cg = cooperative_groups;
namespace pg8 {
#define PG8_LAS __attribute__((address_space(3)))
typedef unsigned short bf16_t;
typedef short bf16x8 __attribute__((ext_vector_type(8)));
typedef float f32x4 __attribute__((ext_vector_type(4)));
typedef unsigned u32x4 __attribute__((ext_vector_type(4)));
constexpr int BM = 256, BK = 64, HALF = 128, HTB = HALF * BK * 2  , STAGE_BYTES = 8 * HTB, NXCD = 8, WGM = 8;

__host__ __device__ __forceinline__ int lds_byte(int r, int c) { const int st = (r >> 4) * 2 + (c >> 5), rr = r & 15, cc = c & 31, ob = rr * 64 + cc * 2; return st * 1024 + (ob ^ (((ob >> 9) & 1) << 5)); }
__host__ __device__ __forceinline__ void stage_rc(int b, int& R, int& C) { const int st = b / 1024, sb = b % 1024, swz = sb ^ (((sb >> 9) & 1) << 5); R = (st >> 1) * 16 + swz / 64; C = (st & 1) * 32 + (swz % 64) / 2; }
__host__ __device__ __forceinline__ int perm32(int rho) { const int n = rho >> 4, i = rho & 15; return 8 * (i >> 2) + 4 * n + (i & 3); }

struct Unit { int pm, pn; };
struct Gemm { const bf16_t* A; const bf16_t* Bt; int M, N, K; };
struct StaticOrder {
    int nM, nN, nwg, G, c;
    __host__ __device__ void init(int M, int N, int G_, int c_) { nM = M / BM; nN = N / BM; nwg = nM * nN; G = G_; c = c_; }
    __host__ __device__ bool next(int i, Unit& u) const {
        const long L = (long)i * G + c; if (L >= nwg) return false;
        int wgid = (int)L; { const int q = nwg / NXCD, r = nwg % NXCD, xcd = wgid % NXCD, off = wgid / NXCD; wgid = (xcd < r ? xcd * (q + 1) : r * (q + 1) + (xcd - r) * q) + off; }
        const int nig = WGM * nN, gid = wgid / nig, fm = gid * WGM, gsz = (nM - fm) < WGM ? (nM - fm) : WGM;
        u.pm = fm + ((wgid % nig) % gsz); u.pn = (wgid % nig) / gsz; return true;
    }
    __device__ __forceinline__ void a_ready(const Unit&) const {}
    __device__ __forceinline__ void done(const Unit&) const {}
};
__device__ __forceinline__ unsigned cvt_pk_bf16(float lo, float hi) { unsigned r; asm volatile("v_cvt_pk_bf16_f32 %0, %1, %2" : "=v"(r) : "v"(lo), "v"(hi)); return r; }
template <class Epi, class Sched, bool STAMP = false>
__device__ __forceinline__ void gemm_phase(PG8_LAS unsigned char* lds, const Gemm g, const Sched& S, const Epi& E, unsigned long long* stamps) {
    int tid_o = threadIdx.x; asm volatile("" : "+v"(tid_o)); const int tid = tid_o, wid = __builtin_amdgcn_readfirstlane(tid >> 6), lane = tid & 63, wr = wid >> 2, wc = wid & 3, fr = lane & 15, fq = lane >> 4;
    const int K = g.K, nt = K / BK;
    int ts_lo = 0, ts_hi = 0, nts = 0; const unsigned long long rt_entry = STAMP ? (unsigned long long)wall_clock64() : 0ull;
#define PG8_STAMP() do { if (STAMP && wid == 0 && nts < 64) { const unsigned long long _c = (unsigned long long)clock64(); \
        ts_lo = (lane == nts) ? (int)(unsigned)_c : ts_lo; ts_hi = (lane == nts) ? (int)(unsigned)(_c >> 32) : ts_hi; ++nts; } } while (0)
    PG8_STAMP();
    unsigned voffA[2], voffB[2];
#pragma unroll
    for (int i = 0; i < 2; ++i) { int R, C; stage_rc(tid * 16 + i * 8192, R, C); const int Rb = Epi::PERM ? ((R & ~31) + perm32(R & 31)) : R;
        voffA[i] = (unsigned)(R * K + C) * 2u; voffB[i] = (unsigned)(Rb * K + C) * 2u; }
    const size_t kstep = (size_t)(BK * 2);
    const size_t hstep = (size_t)HALF * K * 2;
    const size_t tstep = 2 * hstep;
    const unsigned ldsw = (unsigned)wid * 1024u;
    const int aoff = lds_byte(wr * 64 + fr, fq * 8), boff = lds_byte(wc * 32 + fr, fq * 8);
#define PG8_SA(b, h) (((b) * 2 + (h)) * HTB)
#define PG8_SB(b, h) ((4 + (b) * 2 + (h)) * HTB)
#define PG8_STAGE(bufoff, gbase, voff) do { _Pragma("unroll") for (int _i = 0; _i < 2; ++_i) \
        __builtin_amdgcn_global_load_lds((const unsigned*)((const char*)(gbase) + (voff)[_i]), (PG8_LAS unsigned*)(lds + (bufoff) + ldsw + _i * 8192), 16, 0, 0); } while (0)
#define PG8_LDA(dst, b, h) do { _Pragma("unroll") for (int m = 0; m < 4; ++m) _Pragma("unroll") for (int k = 0; k < 2; ++k) dst[m][k] = *(const PG8_LAS bf16x8*)(lds + PG8_SA(b, h) + aoff + m * 2048 + k * 1024); } while (0)
#define PG8_LDB(dst, b, h) do { _Pragma("unroll") for (int n = 0; n < 2; ++n) _Pragma("unroll") for (int k = 0; k < 2; ++k) dst[n][k] = *(const PG8_LAS bf16x8*)(lds + PG8_SB(b, h) + boff + n * 2048 + k * 1024); } while (0)
#define PG8_MMA(ai, bj, At, Bt) do { __builtin_amdgcn_s_setprio(1); _Pragma("unroll") for (int m = 0; m < 4; ++m) _Pragma("unroll") for (int n = 0; n < 2; ++n) _Pragma("unroll") for (int k = 0; k < 2; ++k) \
        acc[ai][bj][m][n] = __builtin_amdgcn_mfma_f32_16x16x32_bf16(Bt[n][k], At[m][k], acc[ai][bj][m][n], 0, 0, 0); __builtin_amdgcn_s_setprio(0); } while (0)
#define PG8_WAIT_V(n) asm volatile("s_waitcnt vmcnt(" #n ")" ::: "memory")
#define PG8_WAIT_L(n) asm volatile("s_waitcnt lgkmcnt(" #n ")" ::: "memory")
#define PG8_BAR __builtin_amdgcn_s_barrier()
#define PG8_SCHED __builtin_amdgcn_sched_barrier(0)
    Unit cur, nxt; int ui = 0;
    if (!S.next(0, cur)) return;
    f32x4 acc[2][2][4][2];
#pragma unroll
    for (int a = 0; a < 2; ++a)
#pragma unroll
        for (int b = 0; b < 2; ++b)
#pragma unroll
            for (int m = 0; m < 4; ++m)
#pragma unroll
                for (int n = 0; n < 2; ++n) acc[a][b][m][n] = (f32x4){0.f, 0.f, 0.f, 0.f};
    bf16x8 At[4][2], B0[2][2], B1[2][2];
    const char* cA = (const char*)g.A + (size_t)cur.pm * tstep; const char* cB = (const char*)g.Bt + (size_t)cur.pn * tstep;
    S.a_ready(cur);
    PG8_STAGE(PG8_SB(0, 0), cB, voffB); PG8_STAGE(PG8_SA(0, 0), cA, voffA); PG8_STAGE(PG8_SB(0, 1), cB + hstep, voffB); PG8_STAGE(PG8_SA(0, 1), cA + hstep, voffA);
    if (wr == 1) PG8_BAR;
    PG8_WAIT_V(4); PG8_BAR;
    PG8_STAGE(PG8_SB(1, 0), cB + kstep, voffB); PG8_STAGE(PG8_SA(1, 0), cA + kstep, voffA); PG8_STAGE(PG8_SB(1, 1), cB + hstep + kstep, voffB);
    PG8_WAIT_V(6); PG8_BAR;
    PG8_STAMP();
    for (;;) {
        const bool has_next = S.next(ui + 1, nxt);
        const char* nA = has_next ? (const char*)g.A + (size_t)nxt.pm * tstep : cA; const char* nB = has_next ? (const char*)g.Bt + (size_t)nxt.pn * tstep : cB;
        for (int t = 0; t < nt; t += 2) {
            const bool last = (t == nt - 2);
            const char* a1 = cA + (size_t)(t + 1) * kstep;
            const char* a2 = last ? nA : cA + (size_t)(t + 2) * kstep; const char* b2 = last ? nB : cB + (size_t)(t + 2) * kstep;
            const char* a3 = a2 + kstep; const char* b3 = b2 + kstep;
            if (last && has_next) S.a_ready(nxt);
            PG8_LDB(B0, 0, 0); PG8_SCHED; PG8_LDA(At, 0, 0); PG8_STAGE(PG8_SA(1, 1), a1 + hstep, voffA);
            PG8_WAIT_L(8); PG8_BAR; PG8_WAIT_L(0); PG8_MMA(0, 0, At, B0); PG8_BAR; PG8_SCHED;
            PG8_LDB(B1, 0, 1); PG8_STAGE(PG8_SB(0, 0), b2, voffB);
            PG8_BAR; PG8_WAIT_L(0); PG8_MMA(0, 1, At, B1); PG8_BAR;
            PG8_LDA(At, 0, 1); PG8_STAGE(PG8_SA(0, 0), a2, voffA);
            PG8_BAR; PG8_WAIT_L(0); PG8_MMA(1, 0, At, B0); PG8_BAR; PG8_SCHED;
            PG8_STAGE(PG8_SB(0, 1), b2 + hstep, voffB);
            PG8_WAIT_V(6); PG8_BAR; PG8_MMA(1, 1, At, B1); PG8_BAR;
            PG8_LDB(B0, 1, 0); PG8_SCHED; PG8_LDA(At, 1, 0); PG8_STAGE(PG8_SA(0, 1), a2 + hstep, voffA);
            PG8_WAIT_L(8); PG8_BAR; PG8_WAIT_L(0); PG8_MMA(0, 0, At, B0); PG8_BAR; PG8_SCHED;
            PG8_LDB(B1, 1, 1); PG8_STAGE(PG8_SB(1, 0), b3, voffB);
            PG8_BAR; PG8_WAIT_L(0); PG8_MMA(0, 1, At, B1); PG8_BAR;
            PG8_LDA(At, 1, 1); PG8_STAGE(PG8_SA(1, 0), a3, voffA);
            PG8_BAR; PG8_WAIT_L(0); PG8_MMA(1, 0, At, B0); PG8_BAR; PG8_SCHED;
            PG8_STAGE(PG8_SB(1, 1), b3 + hstep, voffB);
            PG8_WAIT_V(6); PG8_BAR; PG8_MMA(1, 1, At, B1); PG8_BAR;
        }
        PG8_STAMP();
        if constexpr (!Epi::AFTER_DRAIN) { E(acc, cur, wr, wc, fr, fq); S.done(cur); }
        PG8_STAMP();
        if (!has_next) break;
#pragma unroll
        for (int a = 0; a < 2; ++a)
#pragma unroll
            for (int b = 0; b < 2; ++b)
#pragma unroll
                for (int m = 0; m < 4; ++m)
#pragma unroll
                    for (int n = 0; n < 2; ++n) acc[a][b][m][n] = (f32x4){0.f, 0.f, 0.f, 0.f};
        cur = nxt; cA = nA; cB = nB; ++ui;
    }
    PG8_WAIT_V(0);
    if (wr == 0) PG8_BAR;
    PG8_BAR;
    if constexpr (Epi::AFTER_DRAIN) { E.fused(acc, cur, wr, wc, fr, fq, lds, wid, lane); S.done(cur); }
    PG8_STAMP();
    if (STAMP && wid == 0) { stamps[lane] = lane < nts ? (((unsigned long long)(unsigned)ts_hi << 32) | (unsigned)ts_lo) : 0ull;
        if (lane == 62) stamps[62] = rt_entry; if (lane == 63) stamps[63] = (unsigned long long)wall_clock64(); }
#undef PG8_STAMP
#undef PG8_SA
#undef PG8_SB
#undef PG8_STAGE
#undef PG8_LDA
#undef PG8_LDB
#undef PG8_MMA
#undef PG8_WAIT_V
#undef PG8_WAIT_L
#undef PG8_BAR
#undef PG8_SCHED
}
}
using pg8::bf16_t; using pg8::bf16x8; using pg8::f32x4; using pg8::Unit; using pg8::Gemm; using pg8::StaticOrder;
#define LAS __attribute__((address_space(3)))
constexpr int MTOK = 16384, DM = 1024, SEQL = 4096;
constexpr size_t MiB = 1u << 20, KiB = 1u << 10;
constexpr float DN_ALPHA = 1.6817928305074290f;
constexpr size_t W_CIN = 0, W_COUT = 8 * MiB, W_PEC = 10 * MiB, W_PGC = 10 * MiB + 512 * KiB;
constexpr size_t W_SIN = 12 * MiB + 512 * KiB, W_SGLU = 16 * MiB + 512 * KiB, W_SOUT = 18 * MiB + 512 * KiB, W_PE1 = 20 * MiB + 512 * KiB, W_PG1 = 21 * MiB;
constexpr size_t W_RK = 23 * MiB, W_L2 = 40 * MiB, W_ROUT = 41 * MiB, W_PE2 = 43 * MiB, W_PG2 = 43 * MiB + 512 * KiB;
constexpr size_t OUT_RW = 0, PB = 46 * MiB, ACT = 54 * MiB, T0 = 86 * MiB;
constexpr int LDS_XST = 151552;
constexpr int LDS_BYTES = LDS_XST + 16;
#ifndef DUP_PREP
#define DUP_PREP 0
#define DUP_RWSCAN 0
#define DUP_S5 0
#define DUP_RK 0
#define DUP_SYNC 0
#define DUP_EW 0
#endif
#ifndef DUP_MODE
#define DUP_MODE 0
#endif

struct P { const float* in[35]; float* out; unsigned char* ws; };
#define XB_TMO      128
#define XB_XCNT(j)  (256  + 64 * (j))
#define XB_XSUB(j)  (1280 + 64 * (j))
#define XB_XGEN(j)  (2304 + 64 * (j))
#define XB_TOP      3328
#define XB_TOPGEN   3392
#define XCD_BAR_WORDS 3456
#define XB_SPIN_CAP (1u << 18)

__device__ __forceinline__ unsigned xb_ld(unsigned* p)              { return __hip_atomic_load(p, __ATOMIC_RELAXED, __HIP_MEMORY_SCOPE_AGENT); }
__device__ __forceinline__ unsigned xb_add(unsigned* p, unsigned v) { return __hip_atomic_fetch_add(p, v, __ATOMIC_RELAXED, __HIP_MEMORY_SCOPE_AGENT); }
__device__ __forceinline__ unsigned xb_xcc_id() { return (unsigned)__builtin_amdgcn_s_getreg((3 << 11) | 20) & 0xFu; }
#define XB_SPIN(cond, bar) do { unsigned _sp = 0; while (cond) { __builtin_amdgcn_s_sleep(1); \
    if ((++_sp & 255u) == 0u) { if (xb_ld(&(bar)[XB_TMO])) break; if (_sp > XB_SPIN_CAP) { atomicAdd(&(bar)[XB_TMO], 1u); break; } } } } while (0)

struct XcdBarrier {
    unsigned* bar; unsigned x;
    volatile LAS unsigned* st;
};

__device__ __forceinline__ XcdBarrier xcd_barrier_post(unsigned* bar, volatile LAS unsigned* st) {
    XcdBarrier b; b.bar = bar; b.x = xb_xcc_id(); b.st = st;
    if (threadIdx.x == 0) (void)xb_add(&bar[XB_XCNT(b.x)], 1u);
    return b;
}
__device__ __forceinline__ void xcd_barrier_complete(unsigned* bar, unsigned x, unsigned& nloc, unsigned& nx) {
    const unsigned G = gridDim.x * gridDim.y * gridDim.z;
    unsigned sum, cnt, mine, sp = 0u;
    for (;;) {
        sum = 0u; cnt = 0u; mine = 0u;
#pragma unroll
        for (unsigned j = 0; j < 16; ++j) { const unsigned c = xb_ld(&bar[XB_XCNT(j)]); sum += c; cnt += (c > 0u) ? 1u : 0u; mine = (j == x) ? c : mine; }
        if (sum == G) break;
        __builtin_amdgcn_s_sleep(1);
        if ((++sp & 255u) == 0u) { if (xb_ld(&bar[XB_TMO])) break; if (sp > XB_SPIN_CAP) { atomicAdd(&bar[XB_TMO], 1u); break; } }
    }
    nloc = mine > 0u ? mine : 1u; nx = cnt > 0u ? cnt : 1u;
}

__device__ __forceinline__ void xcd_barrier(const XcdBarrier& b) {
    asm volatile("s_waitcnt vmcnt(0)" ::: "memory");
    __syncthreads();
    if (threadIdx.x == 0) {
        unsigned* bar = b.bar;
        __builtin_amdgcn_s_waitcnt(0);
        unsigned nloc = b.st[0], nx = b.st[1];
        if (nloc == 0u) { xcd_barrier_complete(bar, b.x, nloc, nx); b.st[0] = nloc; b.st[1] = nx; }
        const unsigned old = xb_add(&bar[XB_XSUB(b.x)], 1u);
        const unsigned gen = old / nloc;
        if (old + 1u == (gen + 1u) * nloc) {
            __builtin_amdgcn_fence(__ATOMIC_RELEASE, "agent");
            asm volatile("s_waitcnt vmcnt(0)" ::: "memory");
            const unsigned og = xb_add(&bar[XB_TOP], 1u);
            const unsigned tg = og / nx;
            if (og + 1u == (tg + 1u) * nx) xb_add(&bar[XB_TOPGEN], 1u);
            else XB_SPIN(xb_ld(&bar[XB_TOPGEN]) == tg, bar);
            __builtin_amdgcn_fence(__ATOMIC_ACQUIRE, "agent");
            xb_add(&bar[XB_XGEN(b.x)], 1u);
            asm volatile("s_waitcnt vmcnt(0)" ::: "memory");
        } else {
            XB_SPIN(xb_ld(&bar[XB_XGEN(b.x)]) == gen, bar);
            __builtin_amdgcn_fence(__ATOMIC_ACQUIRE, "agent");
            asm volatile("s_waitcnt vmcnt(0)" ::: "memory");
        }
    }
    __syncthreads();
}

constexpr size_t BAR_OFF = 254 * MiB;


__device__ __forceinline__ unsigned pk2(float lo, float hi) { return pg8::cvt_pk_bf16(lo, hi); }
__device__ __forceinline__ float bflo(unsigned u) { return __uint_as_float(u << 16); }
__device__ __forceinline__ float bfhi(unsigned u) { return __uint_as_float(u & 0xffff0000u); }
__device__ __forceinline__ float rcpf_(float x) { return __builtin_amdgcn_rcpf(x); }
__device__ __forceinline__ float sigmoidf_(float x) { return rcpf_(1.0f + __expf(-x)); }
__device__ __forceinline__ float siluf_(float x) { return x * rcpf_(1.0f + __expf(-x)); }
__device__ __forceinline__ float tanhf_(float x) { const float e = __expf(-2.0f * fabsf(x)); const float t = (1.0f - e) * rcpf_(1.0f + e); return x < 0.f ? -t : t; }
__device__ __forceinline__ float gelu_tanh(float x) { return 0.5f * x * (1.0f + tanhf_(0.7978845608028654f * (x + 0.044715f * x * x * x))); }
template <int CTRL> __device__ __forceinline__ float dppf(float x) { return __int_as_float(__builtin_amdgcn_update_dpp(0, __float_as_int(x), CTRL, 0xF, 0xF, true)); }
__device__ __forceinline__ float red8(float x) { x += dppf<0xB1>(x); x += dppf<0x4E>(x); x += dppf<0x141>(x); return x; }
__device__ __forceinline__ float red16(float x) { x = red8(x); x += dppf<0x140>(x); return x; }
__device__ __forceinline__ float wave_sum(float v) { for (int o = 32; o >= 1; o >>= 1) v += __shfl_xor(v, o); return v; }
__device__ __forceinline__ int otid() { int t = threadIdx.x; asm volatile("" : "+v"(t)); return t; }
typedef float f32x2 __attribute__((ext_vector_type(2)));
__device__ __forceinline__ float fma_s(float a, float b, float c) { float d; asm("v_fma_f32 %0, %1, %2, %3" : "=v"(d) : "v"(a), "v"(b), "v"(c)); return d; }
__device__ __forceinline__ float fnma_s(float a, float b, float c) { float d; asm("v_fma_f32 %0, -%1, %2, %3" : "=v"(d) : "v"(a), "v"(b), "v"(c)); return d; }
__device__ __forceinline__ float mul_s(float a, float b) { float d; asm("v_mul_f32 %0, %1, %2" : "=v"(d) : "v"(a), "v"(b)); return d; }
__device__ __forceinline__ float add_s(float a, float b) { float d; asm("v_add_f32 %0, %1, %2" : "=v"(d) : "v"(a), "v"(b)); return d; }
#define BAR_LDS() asm volatile("s_waitcnt lgkmcnt(0)\n\ts_barrier" ::: "memory")
#define LDS_FENCE() asm volatile("s_waitcnt lgkmcnt(0)" ::: "memory")

struct EpiConvIn {
    static constexpr bool PERM = false, AFTER_DRAIN = false;
    bf16_t* U; bf16_t* G;
    __device__ __forceinline__ void operator()(const f32x4 (&acc)[2][2][4][2], const Unit& u, int wr, int wc, int fr, int fq) const {
        const int row0 = u.pm * 256 + wr * 64 + fr, e0 = u.pn * 64 + wc * 16 + 4 * fq;
#pragma unroll
        for (int ai = 0; ai < 2; ++ai)
#pragma unroll
            for (int m = 0; m < 4; ++m) {
                const size_t o = (size_t)(row0 + ai * 128 + m * 16) * DM + e0;
                float uu[4], gg[4];
#pragma unroll
                for (int j = 0; j < 4; ++j) { uu[j] = acc[ai][0][m][1][j] * acc[ai][1][m][0][j]; gg[j] = acc[ai][0][m][0][j] * siluf_(acc[ai][1][m][1][j]); }
                *(uint2*)(U + o) = make_uint2(pk2(uu[0], uu[1]), pk2(uu[2], uu[3]));
                *(uint2*)(G + o) = make_uint2(pk2(gg[0], gg[1]), pk2(gg[2], gg[3]));
            }
    }
};
struct EpiWout {
    static constexpr bool PERM = false, AFTER_DRAIN = false;
    float* X; bf16_t* RB;
    __device__ __forceinline__ void operator()(const f32x4 (&acc)[2][2][4][2], const Unit& u, int wr, int wc, int fr, int fq) const {
        const int row0 = u.pm * 256 + wr * 64 + fr, col0 = u.pn * 256 + wc * 32 + 4 * fq;
#pragma unroll
        for (int ai = 0; ai < 2; ++ai)
#pragma unroll
            for (int m = 0; m < 4; ++m)
#pragma unroll
                for (int bj = 0; bj < 2; ++bj)
#pragma unroll
                    for (int n = 0; n < 2; ++n) {
                        const size_t o = (size_t)(row0 + ai * 128 + m * 16) * DM + col0 + bj * 128 + n * 16;
                        f32x4 x = *(const f32x4*)(X + o);
                        f32x4 r = x * DN_ALPHA + acc[ai][bj][m][n];
                        *(f32x4*)(X + o) = r;
                        *(uint2*)(RB + o) = make_uint2(pk2(r[0], r[1]), pk2(r[2], r[3]));
                    }
    }
};
template <int ACT> struct EpiBf16T {
    static constexpr bool PERM = false, AFTER_DRAIN = false;
    bf16_t* O; int ldo; int split; size_t stride;
    __device__ __forceinline__ void operator()(const f32x4 (&acc)[2][2][4][2], const Unit& u, int wr, int wc, int fr, int fq) const {
        const int row0 = u.pm * 256 + wr * 64 + fr; const int grp = u.pn / split; const int col0 = (u.pn - grp * split) * 256 + wc * 32 + 4 * fq;
        bf16_t* base = O + (size_t)grp * stride;
#pragma unroll
        for (int ai = 0; ai < 2; ++ai)
#pragma unroll
            for (int m = 0; m < 4; ++m)
#pragma unroll
                for (int bj = 0; bj < 2; ++bj)
#pragma unroll
                    for (int n = 0; n < 2; ++n) {
                        const size_t o = (size_t)(row0 + ai * 128 + m * 16) * ldo + col0 + bj * 128 + n * 16;
                        f32x4 a = acc[ai][bj][m][n];
                        if (ACT == 1) { a[0] = siluf_(a[0]); a[1] = siluf_(a[1]); a[2] = siluf_(a[2]); a[3] = siluf_(a[3]); }
                        *(uint2*)(base + o) = make_uint2(pk2(a[0], a[1]), pk2(a[2], a[3]));
                    }
    }
};
typedef EpiBf16T<0> EpiBf16;
struct EpiPle {
    static constexpr bool PERM = false, AFTER_DRAIN = false;
    float* X; const bf16_t* PE;
    __device__ __forceinline__ void operator()(const f32x4 (&acc)[2][2][4][2], const Unit& u, int wr, int wc, int fr, int fq) const {
        const int row0 = u.pm * 256 + wr * 64 + fr, col0 = u.pn * 256 + wc * 32 + 4 * fq;
#pragma unroll
        for (int ai = 0; ai < 2; ++ai)
#pragma unroll
            for (int m = 0; m < 4; ++m)
#pragma unroll
                for (int bj = 0; bj < 2; ++bj)
#pragma unroll
                    for (int n = 0; n < 2; ++n) {
                        const size_t o = (size_t)(row0 + ai * 128 + m * 16) * DM + col0 + bj * 128 + n * 16;
                        f32x4 x = *(const f32x4*)(X + o); const uint2 pe = *(const uint2*)(PE + o); const f32x4 a = acc[ai][bj][m][n];
                        x[0] += bflo(pe.x) * sigmoidf_(a[0]); x[1] += bfhi(pe.x) * sigmoidf_(a[1]); x[2] += bflo(pe.y) * sigmoidf_(a[2]); x[3] += bfhi(pe.y) * sigmoidf_(a[3]);
                        *(f32x4*)(X + o) = x;
                    }
    }
};
struct EpiSsmIn {
    static constexpr bool PERM = false, AFTER_DRAIN = false;
    float* U; bf16_t* SZ;
    __device__ __forceinline__ void operator()(const f32x4 (&acc)[2][2][4][2], const Unit& u, int wr, int wc, int fr, int fq) const {
        const int row0 = u.pm * 256 + wr * 64 + fr; const bool isz = u.pn >= 4; const int col0 = (u.pn & 3) * 256 + wc * 32 + 4 * fq;
#pragma unroll
        for (int ai = 0; ai < 2; ++ai)
#pragma unroll
            for (int m = 0; m < 4; ++m)
#pragma unroll
                for (int bj = 0; bj < 2; ++bj)
#pragma unroll
                    for (int n = 0; n < 2; ++n) {
                        const size_t o = (size_t)(row0 + ai * 128 + m * 16) * DM + col0 + bj * 128 + n * 16;
                        const f32x4 a = acc[ai][bj][m][n];
                        if (isz) *(uint2*)(SZ + o) = make_uint2(pk2(siluf_(a[0]), siluf_(a[1])), pk2(siluf_(a[2]), siluf_(a[3])));
                        else *(f32x4*)(U + o) = a;
                    }
    }
};
struct EpiGlu {
    static constexpr bool PERM = false, AFTER_DRAIN = false;
    const bf16_t* YG; const bf16_t* SZ; const float* bias; bf16_t* V;
    __device__ __forceinline__ void operator()(const f32x4 (&acc)[2][2][4][2], const Unit& u, int wr, int wc, int fr, int fq) const {
        const int row0 = u.pm * 256 + wr * 64 + fr, col0 = u.pn * 256 + wc * 32 + 4 * fq;
#pragma unroll
        for (int ai = 0; ai < 2; ++ai)
#pragma unroll
            for (int m = 0; m < 4; ++m)
#pragma unroll
                for (int bj = 0; bj < 2; ++bj)
#pragma unroll
                    for (int n = 0; n < 2; ++n) {
                        const int col = col0 + bj * 128 + n * 16;
                        const size_t o = (size_t)(row0 + ai * 128 + m * 16) * DM + col;
                        const f32x4 a = acc[ai][bj][m][n]; const f32x4 bb = *(const f32x4*)(bias + col);
                        const uint2 y = *(const uint2*)(YG + o), z = *(const uint2*)(SZ + o);
                        const float v0 = bflo(y.x) * sigmoidf_(a[0] + bb[0]) * bflo(z.x), v1 = bfhi(y.x) * sigmoidf_(a[1] + bb[1]) * bfhi(z.x);
                        const float v2 = bflo(y.y) * sigmoidf_(a[2] + bb[2]) * bflo(z.y), v3 = bfhi(y.y) * sigmoidf_(a[3] + bb[3]) * bfhi(z.y);
                        *(uint2*)(V + o) = make_uint2(pk2(v0, v1), pk2(v2, v3));
                    }
    }
};
struct EpiRk {
    static constexpr bool PERM = false, AFTER_DRAIN = false;
    bf16_t* RKV; bf16_t* SZ; bf16_t* L1;
    __device__ __forceinline__ void operator()(const f32x4 (&acc)[2][2][4][2], const Unit& u, int wr, int wc, int fr, int fq) const {
        const int row0 = u.pm * 256 + wr * 64 + fr; const int grp = u.pn >> 2; const int colt = (u.pn & 3) * 256 + wc * 32 + 4 * fq;
#pragma unroll
        for (int ai = 0; ai < 2; ++ai)
#pragma unroll
            for (int m = 0; m < 4; ++m)
#pragma unroll
                for (int bj = 0; bj < 2; ++bj)
#pragma unroll
                    for (int n = 0; n < 2; ++n) {
                        const int row = row0 + ai * 128 + m * 16, col = colt + bj * 128 + n * 16;
                        const f32x4 a = acc[ai][bj][m][n];
                        if (grp < 3) *(uint2*)(RKV + (size_t)grp * MTOK * DM + (size_t)row * DM + col) = make_uint2(pk2(a[0], a[1]), pk2(a[2], a[3]));
                        else if (grp == 3) *(uint2*)(SZ + (size_t)row * DM + col) = make_uint2(pk2(siluf_(a[0]), siluf_(a[1])), pk2(siluf_(a[2]), siluf_(a[3])));
                        else { const bool th = col < 64;
                            const float v0 = th ? tanhf_(a[0]) : a[0], v1 = th ? tanhf_(a[1]) : a[1], v2 = th ? tanhf_(a[2]) : a[2], v3 = th ? tanhf_(a[3]) : a[3];
                            *(uint2*)(L1 + (size_t)row * 256 + col) = make_uint2(pk2(v0, v1), pk2(v2, v3)); }
                    }
    }
};

struct EpiLora2 {
    static constexpr bool PERM = false, AFTER_DRAIN = false;
    bf16_t* EW; bf16_t* AA; const float* w0; const float* a0;
    __device__ __forceinline__ void operator()(const f32x4 (&acc)[2][2][4][2], const Unit& u, int wr, int wc, int fr, int fq) const {
        const int row0 = u.pm * 256 + wr * 64 + fr; const bool isa = u.pn >= 4; const int col0 = (u.pn & 3) * 256 + wc * 32 + 4 * fq;
        bf16_t* O = isa ? AA : EW; const float* bias = isa ? a0 : w0;
#pragma unroll
        for (int bj = 0; bj < 2; ++bj)
#pragma unroll
            for (int n = 0; n < 2; ++n) {
                const int col = col0 + bj * 128 + n * 16; const f32x4 bb = *(const f32x4*)(bias + col);
#pragma unroll
                for (int ai = 0; ai < 2; ++ai)
#pragma unroll
                    for (int m = 0; m < 4; ++m) {
                        const f32x4 a = acc[ai][bj][m][n]; float v[4];
#pragma unroll
                        for (int j = 0; j < 4; ++j) { const float t = bb[j] + a[j];
                            if (isa) v[j] = sigmoidf_(t);
                            else { const float x = -t; const float sp = fmaxf(x, 0.f) + __logf(1.0f + __expf(-fabsf(x))); v[j] = __expf(-sp - 0.5f); } }
                        *(uint2*)(O + (size_t)(row0 + ai * 128 + m * 16) * DM + col) = make_uint2(pk2(v[0], v[1]), pk2(v[2], v[3]));
                    }
            }
    }
};

template <class Epi> __device__ __forceinline__ void run_gemm(LAS unsigned char* lds, const bf16_t* A, const bf16_t* Bt, int N, int K, const Epi& E) {
    Gemm g; g.A = A; g.Bt = Bt; g.M = MTOK; g.N = N; g.K = K;
    StaticOrder S; S.init(MTOK, N, (int)gridDim.x, (int)blockIdx.x);
    pg8::gemm_phase<Epi, StaticOrder, false>(lds, g, S, E, nullptr);
}

__device__ __forceinline__ int conv_rowmap(int n) { const int s = n >> 10, e = n & 1023, q = e & 63; return 256 * (e >> 6) + 128 * (s >> 1) + 32 * (q >> 4) + 16 * (s & 1) + (q & 15); }
__device__ __forceinline__ void tr_job(LAS float* tile, const float* src, int ld_src, int K, int N, bf16_t* dst, int ldd, int koff, const float* kscale, int mode, int rot) {
    const int nblk = (int)gridDim.x, blk = ((int)blockIdx.x + rot) % nblk, tid = otid();
    const int tn_ = N >> 6, ntiles = (K >> 6) * tn_;
    const int tk0 = tid >> 6, tn = tid & 63, nl = tid >> 3, kp = (tid & 7) * 8;
    float cur[8];
    if (blk < ntiles) { const int k0 = (blk / tn_) << 6, n0 = (blk % tn_) << 6;
#pragma unroll
        for (int i = 0; i < 8; ++i) cur[i] = src[(size_t)(k0 + tk0 + i * 8) * ld_src + n0 + tn]; }
    for (int t = blk; t < ntiles; t += nblk) {
        const int k0 = (t / tn_) << 6, n0 = (t % tn_) << 6;
        float nxt[8];
        const int t2 = t + nblk;
        if (t2 < ntiles) { const int k2 = (t2 / tn_) << 6, n2 = (t2 % tn_) << 6;
#pragma unroll
            for (int i = 0; i < 8; ++i) nxt[i] = src[(size_t)(k2 + tk0 + i * 8) * ld_src + n2 + tn]; }
        BAR_LDS();
#pragma unroll
        for (int i = 0; i < 8; ++i) tile[(tk0 + i * 8) * 65 + tn] = cur[i];
        BAR_LDS();
        float v[8];
#pragma unroll
        for (int i = 0; i < 8; ++i) { v[i] = tile[(kp + i) * 65 + nl]; if (kscale) v[i] *= kscale[k0 + kp + i]; }
        const int n = n0 + nl; const int row = mode ? conv_rowmap(n) : n;
        *(uint4*)(dst + (size_t)row * ldd + koff + k0 + kp) = make_uint4(pk2(v[0], v[1]), pk2(v[2], v[3]), pk2(v[4], v[5]), pk2(v[6], v[7]));
        if (t2 < ntiles) {
#pragma unroll
            for (int i = 0; i < 8; ++i) cur[i] = nxt[i]; }
    }
}
__device__ __forceinline__ void cvt_pb(const float* src, bf16_t* dst) {
    const size_t n4 = (size_t)MTOK * 256 / 4, nth = (size_t)gridDim.x * 512;
    for (size_t i = (size_t)blockIdx.x * 512 + otid(); i < n4; i += nth) { const float4 v = ((const float4*)src)[i]; ((uint2*)dst)[i] = make_uint2(pk2(v.x, v.y), pk2(v.z, v.w)); }
}
__device__ __forceinline__ void conv_layer_weights(const P& p, LAS float* tile, int j, int L) {
    unsigned char* ws = p.ws;
    tr_job(tile, p.in[2] + (size_t)j * 1024 * 4096, 4096, 1024, 4096, (bf16_t*)(ws + W_CIN), 1024, 0, nullptr, 1, 0);
    tr_job(tile, p.in[4] + (size_t)j * 1024 * 1024, 1024, 1024, 1024, (bf16_t*)(ws + W_COUT), 1024, 0, nullptr, 0, 0);
    tr_job(tile, p.in[31] + (size_t)L * 256 * 1024, 1024, 256, 1024, (bf16_t*)(ws + W_PEC), 256, 0, nullptr, 0, 0);
    tr_job(tile, p.in[32] + (size_t)L * 1024 * 1024, 1024, 1024, 1024, (bf16_t*)(ws + W_PGC), 1024, 0, nullptr, 0, 64);
}

__device__ __forceinline__ void phase_prep(const P& p, LAS float* tile) {
    unsigned char* ws = p.ws; const size_t nth = (size_t)gridDim.x * 512, gt = (size_t)blockIdx.x * 512 + otid();
    {
        const float4* x = (const float4*)p.in[0]; float4* o = (float4*)p.out; uint2* a = (uint2*)(ws + ACT);
        for (size_t i = gt; i < (size_t)MTOK * DM / 4; i += nth) { const float4 v = x[i]; o[i] = v; a[i] = make_uint2(pk2(v.x, v.y), pk2(v.z, v.w)); }
    }
    cvt_pb(p.in[1], (bf16_t*)(ws + PB));
    conv_layer_weights(p, tile, 0, 0);
    tr_job(tile, p.in[5], 2048, 1024, 2048, (bf16_t*)(ws + W_SIN), 1024, 0, nullptr, 0, 128);
    tr_job(tile, p.in[14], 1024, 1024, 1024, (bf16_t*)(ws + W_SGLU), 1024, 0, nullptr, 0, 0);
    tr_job(tile, p.in[16], 1024, 1024, 1024, (bf16_t*)(ws + W_SOUT), 1024, 0, nullptr, 0, 0);
    tr_job(tile, p.in[31] + (size_t)1 * 256 * 1024, 1024, 256, 1024, (bf16_t*)(ws + W_PE1), 256, 0, nullptr, 0, 192);
    tr_job(tile, p.in[32] + (size_t)1 * 1024 * 1024, 1024, 1024, 1024, (bf16_t*)(ws + W_PG1), 1024, 0, nullptr, 0, 0);
    bf16_t* rk = (bf16_t*)(ws + W_RK);
    for (int g = 0; g < 4; ++g)
        tr_job(tile, p.in[18] + (size_t)g * 1024 * 1024, 1024, 1024, 1024, rk + (size_t)g * 1024 * 1024, 1024, 0, nullptr, 0, g * 64);
    bf16_t* wl = rk + (size_t)4096 * 1024;
    tr_job(tile, p.in[20], 64, 1024, 64, wl, 2048, 0, nullptr, 0, 0);
    tr_job(tile, p.in[20], 64, 1024, 64, wl, 2048, 1024, p.in[17] + 4 * 1024, 0, 16);
    tr_job(tile, p.in[23], 64, 1024, 64, wl + (size_t)64 * 2048, 2048, 0, nullptr, 0, 32);
    tr_job(tile, p.in[23], 64, 1024, 64, wl + (size_t)64 * 2048, 2048, 1024, p.in[17] + 5 * 1024, 0, 48);
    bf16_t* l2 = (bf16_t*)(ws + W_L2);
    tr_job(tile, p.in[21], 1024, 64, 1024, l2, 256, 0, nullptr, 0, 64);
    tr_job(tile, p.in[24], 1024, 64, 1024, l2 + (size_t)1024 * 256, 256, 64, nullptr, 0, 80);
    for (size_t i = gt; i < (size_t)2048 * 32; i += nth) { const int row = (int)(i >> 5), c8 = (int)(i & 31); const bool data = row < 1024 ? (c8 < 8) : (c8 >= 8 && c8 < 16);
        if (!data) *(uint4*)(l2 + (size_t)row * 256 + c8 * 8) = make_uint4(0, 0, 0, 0); }
    tr_job(tile, p.in[30], 1024, 1024, 1024, (bf16_t*)(ws + W_ROUT), 1024, 0, nullptr, 0, 96);
    tr_job(tile, p.in[31] + (size_t)2 * 256 * 1024, 1024, 256, 1024, (bf16_t*)(ws + W_PE2), 256, 0, nullptr, 0, 160);
    tr_job(tile, p.in[32] + (size_t)2 * 1024 * 1024, 1024, 1024, 1024, (bf16_t*)(ws + W_PG2), 1024, 0, nullptr, 0, 0);
}

__device__ __forceinline__ void phase_conv_ew(const bf16_t* U, bf16_t* G, const float* ck) {
    const size_t nth = (size_t)gridDim.x * 512;
    for (size_t i = (size_t)blockIdx.x * 512 + otid(); i < (size_t)MTOK * 128; i += nth) {
        const int row = (int)(i >> 7), c8 = (int)(i & 127) * 8, t = row & (SEQL - 1);
        const uint4 z4 = make_uint4(0, 0, 0, 0);
        const uint4 u0 = *(const uint4*)(U + (size_t)row * DM + c8);
        const uint4 u1 = t >= 1 ? *(const uint4*)(U + (size_t)(row - 1) * DM + c8) : z4;
        const uint4 u2 = t >= 2 ? *(const uint4*)(U + (size_t)(row - 2) * DM + c8) : z4;
        const uint4 g = *(const uint4*)(G + (size_t)row * DM + c8);
        const unsigned a0[4] = {u0.x, u0.y, u0.z, u0.w}, a1[4] = {u1.x, u1.y, u1.z, u1.w}, a2[4] = {u2.x, u2.y, u2.z, u2.w}, gg[4] = {g.x, g.y, g.z, g.w};
        unsigned o[4];
#pragma unroll
        for (int q = 0; q < 4; ++q) {
            const int c = c8 + 2 * q;
            const float lo = bflo(gg[q]) * (ck[c] * bflo(a2[q]) + ck[1024 + c] * bflo(a1[q]) + ck[2048 + c] * bflo(a0[q]));
            const float hi = bfhi(gg[q]) * (ck[c + 1] * bfhi(a2[q]) + ck[1024 + c + 1] * bfhi(a1[q]) + ck[2048 + c + 1] * bfhi(a0[q]));
            o[q] = pk2(lo, hi);
        }
        *(uint4*)(G + (size_t)row * DM + c8) = make_uint4(o[0], o[1], o[2], o[3]);
    }
}

__device__ __forceinline__ void phase_ln(float* X, bf16_t* XB, const float* g, const float* b) {
    const int lane = otid() & 63, gw = blockIdx.x * 8 + (otid() >> 6), nw = gridDim.x * 8;
    for (int row = gw; row < MTOK; row += nw) {
        float4 v[4]; float s = 0.f;
#pragma unroll
        for (int i = 0; i < 4; ++i) { v[i] = *(const float4*)(X + (size_t)row * DM + i * 256 + lane * 4); s += v[i].x + v[i].y + v[i].z + v[i].w; }
        const float mean = wave_sum(s) * (1.0f / 1024.0f);
        float q = 0.f;
#pragma unroll
        for (int i = 0; i < 4; ++i) { v[i].x -= mean; v[i].y -= mean; v[i].z -= mean; v[i].w -= mean; q += v[i].x * v[i].x + v[i].y * v[i].y + v[i].z * v[i].z + v[i].w * v[i].w; }
        const float rs = rsqrtf(wave_sum(q) * (1.0f / 1024.0f) + 1e-5f);
#pragma unroll
        for (int i = 0; i < 4; ++i) { const int c = i * 256 + lane * 4; const float4 gg = *(const float4*)(g + c), bb = *(const float4*)(b + c);
            float4 y; y.x = v[i].x * rs * gg.x + bb.x; y.y = v[i].y * rs * gg.y + bb.y; y.z = v[i].z * rs * gg.z + bb.z; y.w = v[i].w * rs * gg.w + bb.w;
            *(float4*)(X + (size_t)row * DM + c) = y; *(uint2*)(XB + (size_t)row * DM + c) = make_uint2(pk2(y.x, y.y), pk2(y.z, y.w)); }
    }
}

template <int FINAL> __device__ __forceinline__ void phase_s5(const P& p, LAS unsigned char* lds_, const float* U, float* HLOC, bf16_t* YG) {
    const int lane = otid() & 63, wid = otid() >> 6, nw = gridDim.x * 8;
    LAS float* ul = (LAS float*)(lds_ + wid * 8192);
    LAS unsigned* S = (LAS unsigned*)(lds_ + wid * 8192 + 2048);
    const int fr = lane & 15, fq = lane >> 4;
    for (int un = blockIdx.x * 8 + wid; un < 2048; un += nw) {
        const int g = un & 63, sc = (un >> 6) & 7, b = un >> 9;
        if (!FINAL && sc == 7) continue;
        const float dt = __expf(p.in[8][g]);
        const float lre = p.in[6][g * 64 + lane], lim = p.in[7][g * 64 + lane];
        const float mag = expf(lre * dt); float sn, cs; sincosf(lim * dt, &sn, &cs);
        const float are = mag * cs, aim = mag * sn;
        const float d2 = lre * lre + lim * lim, cfre = ((are - 1.0f) * lre + aim * lim) / d2, cfim = (aim * lre - (are - 1.0f) * lim) / d2;
        f32x2 Bp[16];
#pragma unroll
        for (int q = 0; q < 4; ++q) { const float4 br = *(const float4*)(p.in[9] + (size_t)(g * 64 + lane) * 16 + q * 4), bi = *(const float4*)(p.in[10] + (size_t)(g * 64 + lane) * 16 + q * 4);
            const float brr[4] = {br.x, br.y, br.z, br.w}, bii[4] = {bi.x, bi.y, bi.z, bi.w};
#pragma unroll
            for (int j = 0; j < 4; ++j) { Bp[q * 4 + j] = (f32x2){cfre * brr[j] - cfim * bii[j], cfre * bii[j] + cfim * brr[j]}; } }
        float hre = 0.f, him = 0.f;
        bf16x8 Cf[4]; float dsk = 0.f;
        if (FINAL) {
            float lr = are, li = aim;
#pragma unroll
            for (int i = 0; i < 9; ++i) { const float t = lr * lr - li * li; li = 2.0f * lr * li; lr = t; }
            for (int s2 = 0; s2 < sc; ++s2) { const float2 hv = *(const float2*)(HLOC + ((size_t)((b * 8 + s2) * 64 + g) * 64 + lane) * 2);
                const float t = lr * hre - li * him + hv.x; him = lr * him + li * hre + hv.y; hre = t; }
#pragma unroll
            for (int kk = 0; kk < 4; ++kk) {
                unsigned w[4];
#pragma unroll
                for (int i = 0; i < 4; ++i) { const int pi = 16 * kk + 4 * fq + i; const size_t o = (size_t)(g * 16 + fr) * 64 + pi; w[i] = pk2(p.in[11][o], -p.in[12][o]); }
                union { unsigned u[4]; bf16x8 v; } cv; cv.u[0] = w[0]; cv.u[1] = w[1]; cv.u[2] = w[2]; cv.u[3] = w[3]; Cf[kk] = cv.v;
            }
            dsk = p.in[13][g * 16 + fr];
        }
        const size_t tok0 = (size_t)b * SEQL + (size_t)sc * 512;
        const float* ug = U + tok0 * DM + g * 16 + (lane & 3) * 4 + (size_t)(lane >> 2) * DM;
        f32x4 nxt = *(const f32x4*)ug;
        LDS_FENCE();
        *(LAS f32x4*)(ul + lane * 4) = nxt;
        for (int blk = 0; blk < 32; ++blk) {
            const int cur = blk & 1;
            if (blk + 1 < 32) nxt = *(const f32x4*)(ug + (size_t)(blk + 1) * 16 * DM);
            LDS_FENCE();
#pragma unroll 4
            for (int tt = 0; tt < 16; ++tt) {
                float uu[16];
#pragma unroll
                for (int q = 0; q < 4; ++q) { const f32x4 t4 = *(const LAS f32x4*)(ul + cur * 256 + tt * 16 + q * 4); uu[q * 4] = t4[0]; uu[q * 4 + 1] = t4[1]; uu[q * 4 + 2] = t4[2]; uu[q * 4 + 3] = t4[3]; }
                f32x2 b0 = {0.f, 0.f}, b1 = {0.f, 0.f};
#pragma unroll
                for (int h = 0; h < 16; h += 2) { b0 = Bp[h] * (f32x2){uu[h], uu[h]} + b0; b1 = Bp[h + 1] * (f32x2){uu[h + 1], uu[h + 1]} + b1; }
                const f32x2 bs = b0 + b1; const float bre = bs[0], bim = bs[1];
                const float t = are * hre - aim * him + bre; him = are * him + aim * hre + bim; hre = t;
                if (FINAL) S[tt * 68 + lane] = pk2(hre, him);
            }
            if (FINAL) {
                LDS_FENCE();
                f32x4 acc = {0.f, 0.f, 0.f, 0.f};
#pragma unroll
                for (int kk = 0; kk < 4; ++kk) { const bf16x8 af = *(const LAS bf16x8*)(S + fr * 68 + 16 * kk + 4 * fq); acc = __builtin_amdgcn_mfma_f32_16x16x32_bf16(af, Cf[kk], acc, 0, 0, 0); }
#pragma unroll
                for (int i = 0; i < 4; ++i) { const int tl = 4 * fq + i; const float y = acc[i] + dsk * ul[cur * 256 + tl * 16 + fr];
                    const unsigned short hb = (unsigned short)(pk2(gelu_tanh(y), 0.f) & 0xffffu);
                    YG[(tok0 + blk * 16 + tl) * DM + g * 16 + fr] = hb; }
            }
            LDS_FENCE();
            if (blk + 1 < 32) *(LAS f32x4*)(ul + (cur ^ 1) * 256 + lane * 4) = nxt;
        }
        if (!FINAL) *(float2*)(HLOC + ((size_t)un * 64 + lane) * 2) = make_float2(hre, him);
    }
}

constexpr int L1_BROW = 72;
__device__ __forceinline__ void phase_rw_lora1(LAS unsigned char* lds_, const float* X, const bf16_t* Wl, bf16_t* L1) {
    LAS bf16_t* Bs = (LAS bf16_t*)lds_;
    const int tid = otid(), lane = tid & 63, wid = tid >> 6, fr = lane & 15, fq = lane >> 4, mt = wid >> 1, ch = wid & 1;
    const int sn = tid >> 2, sq = tid & 3;
    for (int item = blockIdx.x; item < MTOK / 64; item += gridDim.x) {
        const int row = item * 64 + mt * 16 + fr, t = row & (SEQL - 1);
        const float* xr = X + (size_t)row * DM + fq * 8; const float* xpr = xr - DM;
        f32x4 acc[4];
#pragma unroll
        for (int n = 0; n < 4; ++n) acc[n] = (f32x4){0.f, 0.f, 0.f, 0.f};
        __syncthreads();
        pg8::u32x4 sb[2][2];
#pragma unroll
        for (int pt = 0; pt < 2; ++pt)
#pragma unroll
            for (int h = 0; h < 2; ++h) sb[pt][h] = *(const pg8::u32x4*)(Wl + (size_t)sn * 2048 + pt * 1024 + sq * 16 + h * 8);
        for (int ks = 0; ks < 16; ++ks) {
            const int st = ks & 1;
#pragma unroll
            for (int pt = 0; pt < 2; ++pt)
#pragma unroll
                for (int h = 0; h < 2; ++h) *(LAS pg8::u32x4*)(Bs + ((st * 2 + pt) * 128 + sn) * L1_BROW + sq * 16 + h * 8) = sb[pt][h];
            if (ks + 1 < 16) {
#pragma unroll
                for (int pt = 0; pt < 2; ++pt)
#pragma unroll
                    for (int h = 0; h < 2; ++h) sb[pt][h] = *(const pg8::u32x4*)(Wl + (size_t)sn * 2048 + pt * 1024 + (ks + 1) * 64 + sq * 16 + h * 8);
            }
            BAR_LDS();
#pragma unroll
            for (int k2 = 0; k2 < 2; ++k2) {
                const int k = ks * 64 + k2 * 32;
                const float4 x0 = *(const float4*)(xr + k), x1 = *(const float4*)(xr + k + 4);
                float4 p0 = make_float4(0.f, 0.f, 0.f, 0.f), p1 = p0;
                if (t >= 1) { p0 = *(const float4*)(xpr + k); p1 = *(const float4*)(xpr + k + 4); }
                union { unsigned u[4]; bf16x8 v; } ax, ad;
                ax.u[0] = pk2(x0.x, x0.y); ax.u[1] = pk2(x0.z, x0.w); ax.u[2] = pk2(x1.x, x1.y); ax.u[3] = pk2(x1.z, x1.w);
                ad.u[0] = pk2(p0.x - x0.x, p0.y - x0.y); ad.u[1] = pk2(p0.z - x0.z, p0.w - x0.w); ad.u[2] = pk2(p1.x - x1.x, p1.y - x1.y); ad.u[3] = pk2(p1.z - x1.z, p1.w - x1.w);
#pragma unroll
                for (int n = 0; n < 4; ++n) {
                    const bf16x8 b0 = *(const LAS bf16x8*)(Bs + ((st * 2 + 0) * 128 + ch * 64 + n * 16 + fr) * L1_BROW + k2 * 32 + fq * 8);
                    const bf16x8 b1 = *(const LAS bf16x8*)(Bs + ((st * 2 + 1) * 128 + ch * 64 + n * 16 + fr) * L1_BROW + k2 * 32 + fq * 8);
                    acc[n] = __builtin_amdgcn_mfma_f32_16x16x32_bf16(ax.v, b0, acc[n], 0, 0, 0);
                    acc[n] = __builtin_amdgcn_mfma_f32_16x16x32_bf16(ad.v, b1, acc[n], 0, 0, 0);
                }
            }
        }
        const int row0 = item * 64 + mt * 16;
#pragma unroll
        for (int n = 0; n < 4; ++n)
#pragma unroll
            for (int i = 0; i < 4; ++i) { const int r = row0 + fq * 4 + i, col = ch * 64 + n * 16 + fr;
                const float v = ch == 0 ? tanhf_(acc[n][i]) : acc[n][i];
                L1[(size_t)r * 256 + col] = (bf16_t)(pk2(v, 0.f) & 0xffffu); }
#pragma unroll
        for (int q = 0; q < 2; ++q) { const int idx = q * 64 + lane, r = idx >> 3, c8 = idx & 7;
            *(uint4*)(L1 + (size_t)(row0 + r) * 256 + 128 + ch * 64 + c8 * 8) = make_uint4(0, 0, 0, 0); }
    }
}
__device__ __forceinline__ void phase_rw_prep(const float* X, bf16_t* XS, const float* mua, const float* mub) {
    const size_t nth = (size_t)gridDim.x * 512;
    for (size_t i = (size_t)blockIdx.x * 512 + otid(); i < (size_t)MTOK * 256; i += nth) {
        const int row = (int)(i >> 8), c4 = (int)(i & 255) * 4, t = row & (SEQL - 1);
        const float4 x = *(const float4*)(X + (size_t)row * DM + c4);
        float4 xp = make_float4(0.f, 0.f, 0.f, 0.f); if (t >= 1) xp = *(const float4*)(X + (size_t)(row - 1) * DM + c4);
        const float4 ma = *(const float4*)(mua + c4), mb = *(const float4*)(mub + c4);
        const float d0 = xp.x - x.x, d1 = xp.y - x.y, d2 = xp.z - x.z, d3 = xp.w - x.w;
        *(uint2*)(XS + (size_t)row * DM + c4) = make_uint2(pk2(x.x + d0 * ma.x, x.y + d1 * ma.y), pk2(x.z + d2 * ma.z, x.w + d3 * ma.w));
        *(uint2*)(XS + (size_t)MTOK * DM + (size_t)row * DM + c4) = make_uint2(pk2(x.x + d0 * mb.x, x.y + d1 * mb.y), pk2(x.z + d2 * mb.z, x.w + d3 * mb.w));
    }
}
__device__ __forceinline__ void unpack8(const uint4 v, float* f) { f[0] = bflo(v.x); f[1] = bfhi(v.x); f[2] = bflo(v.y); f[3] = bfhi(v.y); f[4] = bflo(v.z); f[5] = bfhi(v.z); f[6] = bflo(v.w); f[7] = bfhi(v.w); }

constexpr int RW_T = 32, RW_STEP = 336;
constexpr int RW_BUF = RW_T * RW_STEP, RW_OB = RW_T * 16 * 16;
struct RwOp { f32x4 r, w, kp, kk, ka; float v; };
__device__ __forceinline__ void rw_load(RwOp& o, const LAS float* sb, int j0, int rr) {
    o.r = *(const LAS f32x4*)(sb + j0); o.w = *(const LAS f32x4*)(sb + 64 + j0); o.kp = *(const LAS f32x4*)(sb + 128 + j0);
    o.kk = *(const LAS f32x4*)(sb + 192 + j0); o.ka = *(const LAS f32x4*)(sb + 256 + j0); o.v = sb[320 + rr];
}
template <int MODE> __device__ __forceinline__ float rw_step(const RwOp& o, float& s0, float& s1, float& s2, float& s3) {
    const float dsum = fmaf(s0, o.kk[0], s1 * o.kk[1]) + fmaf(s2, o.kk[2], s3 * o.kk[3]);
    const float sa = MODE == 3 ? -dsum : -red16(dsum);
    s0 = fmaf(s0, o.w[0], fmaf(sa, o.ka[0], o.v * o.kp[0])); s1 = fmaf(s1, o.w[1], fmaf(sa, o.ka[1], o.v * o.kp[1]));
    s2 = fmaf(s2, o.w[2], fmaf(sa, o.ka[2], o.v * o.kp[2])); s3 = fmaf(s3, o.w[3], fmaf(sa, o.ka[3], o.v * o.kp[3]));
    return fmaf(s0, o.r[0], s1 * o.r[1]) + fmaf(s2, o.r[2], s3 * o.r[3]);
}
__device__ __forceinline__ void rw_flush(const LAS float* ob, bf16_t* dst) {
    float o2[2];
#pragma unroll
    for (int q = 0; q < 2; ++q) { float a = 0.f;
#pragma unroll
        for (int i = 0; i < 4; ++i) { const f32x4 t = *(const LAS f32x4*)(ob + q * 16 + i * 4); a += (t[0] + t[1]) + (t[2] + t[3]); }
        o2[q] = a; }
    *(unsigned*)dst = pk2(o2[0], o2[1]);
}
template <int MODE> __device__ __forceinline__ void phase_rw_scan(const P& p, LAS unsigned char* lds_, const bf16_t* R, const bf16_t* K, const bf16_t* V, const bf16_t* DW, const bf16_t* DA, bf16_t* OUT) {
    LAS float* buf = (LAS float*)lds_;
    LAS float* obuf = buf + 2 * RW_BUF;
    const int tid = otid(), lane = tid & 63, wid = __builtin_amdgcn_readfirstlane(tid >> 6);
    for (int un = blockIdx.x; un < 256; un += gridDim.x) {
        const int bh = un >> 2, rg = un & 3, b = bh >> 4, h = bh & 15;
        __syncthreads();
        if (wid < 4) {
            const int rr = wid * 4 + (lane >> 4), jl = lane & 15, j0 = jl * 4;
            float s0 = 0.f, s1 = 0.f, s2 = 0.f, s3 = 0.f;
            __builtin_amdgcn_s_setprio(3);
            BAR_LDS();
            for (int c = 0; c < SEQL / RW_T; ++c) {
                const LAS float* cb = buf + (c & 1) * RW_BUF; LAS float* ob = obuf + (c & 1) * RW_OB + rr * 16 + jl;
                if (MODE != 1) {
                RwOp ops[3];
                rw_load(ops[0], cb, j0, rr); rw_load(ops[1], cb + RW_STEP, j0, rr);
#pragma unroll
                for (int s = 0; s < RW_T; ++s) {
                    if (s + 2 < RW_T) rw_load(ops[(s + 2) % 3], cb + (s + 2) * RW_STEP, j0, rr);
                    ob[s * 256] = rw_step<MODE>(ops[s % 3], s0, s1, s2, s3);
                }
                }
                BAR_LDS();
            }
            __builtin_amdgcn_s_setprio(0);
        } else {
            const int pt = tid - 256, s = pt >> 3, part = pt & 7, c0 = part * 8, ch = h * 64 + c0;
            float kk_[8], ka_[8];
#pragma unroll
            for (int i = 0; i < 8; ++i) { kk_[i] = p.in[25][ch + i]; ka_[i] = p.in[26][ch + i]; }
            const size_t rowb = (size_t)b * SEQL + s;
            uint4 qr, qk, qw, qa, qv = make_uint4(0, 0, 0, 0);
            { const size_t o = rowb * DM + ch; qr = *(const uint4*)(R + o); qk = *(const uint4*)(K + o); qw = *(const uint4*)(DW + o); qa = *(const uint4*)(DA + o);
              if (part < 2) qv = *(const uint4*)(V + rowb * DM + h * 64 + rg * 16 + part * 8); }
            for (int c = 0; c <= SEQL / RW_T; ++c) {
                uint4 nr = qr, nk = qk, nw = qw, na = qa, nv = qv;
                if (MODE != 2 && c + 1 < SEQL / RW_T) { const size_t row = rowb + (size_t)(c + 1) * RW_T; const size_t o = row * DM + ch;
                    nr = *(const uint4*)(R + o); nk = *(const uint4*)(K + o); nw = *(const uint4*)(DW + o); na = *(const uint4*)(DA + o);
                    if (part < 2) nv = *(const uint4*)(V + row * DM + h * 64 + rg * 16 + part * 8); }
                if (MODE != 2 && c < SEQL / RW_T) {
                    float r[8], k[8], ew[8], aa[8];
                    unpack8(qr, r); unpack8(qk, k); unpack8(qw, ew); unpack8(qa, aa);
                    float wv[8], kp[8], kk[8], ka[8]; float ss = 0.f;
#pragma unroll
                    for (int i = 0; i < 8; ++i) {
                        wv[i] = __expf(-ew[i]);
                        kk[i] = k[i] * kk_[i]; ss = fmaf(kk[i], kk[i], ss);
                        kp[i] = k[i] * fmaf(aa[i] - 1.0f, ka_[i], 1.0f);
                    }
                    ss = red8(ss); const float inv = rcpf_(fmaxf(__builtin_amdgcn_sqrtf(ss), 1e-12f));
#pragma unroll
                    for (int i = 0; i < 8; ++i) { kk[i] *= inv; ka[i] = kk[i] * aa[i]; }
                    LAS float* sb = buf + (c & 1) * RW_BUF + s * RW_STEP + c0;
                    *(LAS f32x4*)(sb) = (f32x4){r[0], r[1], r[2], r[3]}; *(LAS f32x4*)(sb + 4) = (f32x4){r[4], r[5], r[6], r[7]};
                    *(LAS f32x4*)(sb + 64) = (f32x4){wv[0], wv[1], wv[2], wv[3]}; *(LAS f32x4*)(sb + 68) = (f32x4){wv[4], wv[5], wv[6], wv[7]};
                    *(LAS f32x4*)(sb + 128) = (f32x4){kp[0], kp[1], kp[2], kp[3]}; *(LAS f32x4*)(sb + 132) = (f32x4){kp[4], kp[5], kp[6], kp[7]};
                    *(LAS f32x4*)(sb + 192) = (f32x4){kk[0], kk[1], kk[2], kk[3]}; *(LAS f32x4*)(sb + 196) = (f32x4){kk[4], kk[5], kk[6], kk[7]};
                    *(LAS f32x4*)(sb + 256) = (f32x4){ka[0], ka[1], ka[2], ka[3]}; *(LAS f32x4*)(sb + 260) = (f32x4){ka[4], ka[5], ka[6], ka[7]};
                    if (part < 2) { float v[8]; unpack8(qv, v);
                        LAS float* vb = buf + (c & 1) * RW_BUF + s * RW_STEP + 320 + part * 8;
                        *(LAS f32x4*)(vb) = (f32x4){v[0], v[1], v[2], v[3]}; *(LAS f32x4*)(vb + 4) = (f32x4){v[4], v[5], v[6], v[7]}; }
                }
                if (MODE == 0 && c >= 2) {
                    const int cc = c - 2; const size_t row = (size_t)b * SEQL + (size_t)cc * RW_T + s;
                    rw_flush(obuf + (cc & 1) * RW_OB + s * 256 + part * 32, OUT + row * DM + h * 64 + rg * 16 + part * 2);
                }
                BAR_LDS();
                qr = nr; qk = nk; qw = nw; qa = na; qv = nv;
            }
            if (MODE == 0) {
                const int cc = SEQL / RW_T - 1; const size_t row = (size_t)b * SEQL + (size_t)cc * RW_T + s;
                rw_flush(obuf + (cc & 1) * RW_OB + s * 256 + part * 32, OUT + row * DM + h * 64 + rg * 16 + part * 2);
            }
        }
    }
}

__device__ __forceinline__ void phase_rw_post(const P& p, const bf16_t* OUT, const bf16_t* R, const bf16_t* K, const bf16_t* V, const bf16_t* DA, const bf16_t* SZ, bf16_t* OF) {
    const size_t nth = (size_t)gridDim.x * 512;
    for (size_t it = (size_t)blockIdx.x * 512 + otid(); it < (size_t)MTOK * 128; it += nth) {
        const int c0 = (int)(it & 127) * 8; const size_t o = (it >> 7) * DM + c0;
        float ov[8], r[8], k[8], v[8], da[8], sz[8];
        unpack8(*(const uint4*)(OUT + o), ov); unpack8(*(const uint4*)(R + o), r); unpack8(*(const uint4*)(K + o), k); unpack8(*(const uint4*)(V + o), v);
        unpack8(*(const uint4*)(DA + o), da); unpack8(*(const uint4*)(SZ + o), sz);
        float sm = 0.f, dot = 0.f;
#pragma unroll
        for (int i = 0; i < 8; ++i) { const float a = da[i]; const float kp = k[i] * (1.0f + (a - 1.0f) * p.in[26][c0 + i]);
            dot += r[i] * kp * p.in[27][c0 + i]; sm += ov[i]; }
        dot = red8(dot); const float mean = red8(sm) * (1.0f / 64.0f);
        float q = 0.f;
#pragma unroll
        for (int i = 0; i < 8; ++i) { ov[i] -= mean; q += ov[i] * ov[i]; }
        const float rs = rsqrtf(red8(q) * (1.0f / 64.0f) + 64e-5f);
        float y[8];
#pragma unroll
        for (int i = 0; i < 8; ++i) y[i] = (ov[i] * rs * p.in[28][c0 + i] + p.in[29][c0 + i] + dot * v[i]) * sz[i];
        *(uint4*)(OF + o) = make_uint4(pk2(y[0], y[1]), pk2(y[2], y[3]), pk2(y[4], y[5]), pk2(y[6], y[7]));
    }
}

__global__ void __launch_bounds__(512, 2) fwd_mega(P p) {
    extern __shared__ __attribute__((aligned(16))) unsigned char shm[];
    LAS unsigned char* lds = (LAS unsigned char*)shm;
    LAS float* tile = (LAS float*)shm;
    cg::grid_group grid = cg::this_grid();
    volatile LAS unsigned* xst = (volatile LAS unsigned*)(lds + LDS_XST);
    if (threadIdx.x == 0) { xst[0] = 0u; xst[1] = 0u; }
    __syncthreads();
    const XcdBarrier xb = xcd_barrier_post((unsigned*)(p.ws + BAR_OFF), xst);
    unsigned char* ws = p.ws; float* X = p.out;
    bf16_t* act = (bf16_t*)(ws + ACT); bf16_t* pb = (bf16_t*)(ws + PB);
    phase_prep(p, tile);
    grid.sync();
    for (int d = 0; d < DUP_PREP; ++d) { phase_prep(p, tile); xcd_barrier(xb); }
    for (int d = 0; d < DUP_SYNC; ++d) xcd_barrier(xb);
#define LAYER_TAIL(L, Aout, Wout, Wpe, Wpg, PEB) \
    { EpiWout E; E.X = X; E.RB = act; run_gemm(lds, Aout, Wout, 1024, 1024, E); } \
    { EpiBf16 E; E.O = PEB; E.ldo = 1024; E.split = 1 << 20; E.stride = 0; run_gemm(lds, pb, Wpe, 1024, 256, E); } \
    xcd_barrier(xb); \
    { EpiPle E; E.X = X; E.PE = PEB; run_gemm(lds, act, Wpg, 1024, 1024, E); } \
    xcd_barrier(xb); \
    phase_ln(X, act, p.in[33] + (L) * 1024, p.in[34] + (L) * 1024);
#define CONV_LAYER(L, j) { \
        bf16_t* U = (bf16_t*)(ws + T0); bf16_t* G = (bf16_t*)(ws + T0 + 32 * MiB); \
        { EpiConvIn E; E.U = U; E.G = G; run_gemm(lds, act, (const bf16_t*)(ws + W_CIN), 4096, 1024, E); } \
        xcd_barrier(xb); \
        phase_conv_ew(U, G, p.in[3] + (size_t)(j) * 3 * 1024); \
        if ((L) > 0) cvt_pb(p.in[1] + (size_t)(L) * MTOK * 256, pb); \
        xcd_barrier(xb); \
        LAYER_TAIL(L, G, (const bf16_t*)(ws + W_COUT), (const bf16_t*)(ws + W_PEC), (const bf16_t*)(ws + W_PGC), (bf16_t*)(ws + T0 + 64 * MiB)) }
    CONV_LAYER(0, 0)
    xcd_barrier(xb);
    {
        float* U = (float*)(ws + T0); bf16_t* SZ = (bf16_t*)(ws + T0 + 64 * MiB); bf16_t* YG = (bf16_t*)(ws + T0 + 96 * MiB); bf16_t* V = (bf16_t*)(ws + T0 + 128 * MiB);
        float* HL = (float*)(ws + T0 + 160 * MiB);
        { EpiSsmIn E; E.U = U; E.SZ = SZ; run_gemm(lds, act, (const bf16_t*)(ws + W_SIN), 2048, 1024, E); }
        xcd_barrier(xb);
        phase_s5<0>(p, lds, U, HL, YG);
        cvt_pb(p.in[1] + (size_t)1 * MTOK * 256, pb);
        xcd_barrier(xb);
        phase_s5<1>(p, lds, U, HL, YG);
        xcd_barrier(xb);
        for (int d = 0; d < DUP_S5; ++d) { phase_s5<0>(p, lds, U, HL, YG); xcd_barrier(xb); phase_s5<1>(p, lds, U, HL, YG); xcd_barrier(xb); }
        { EpiGlu E; E.YG = YG; E.SZ = SZ; E.bias = p.in[15]; E.V = V; run_gemm(lds, YG, (const bf16_t*)(ws + W_SGLU), 1024, 1024, E); }
        xcd_barrier(xb);
        LAYER_TAIL(1, V, (const bf16_t*)(ws + W_SOUT), (const bf16_t*)(ws + W_PE1), (const bf16_t*)(ws + W_PG1), (bf16_t*)(ws + T0))
    }
    xcd_barrier(xb);
    {
        bf16_t* XS = (bf16_t*)(ws + T0); bf16_t* RKV = (bf16_t*)(ws + T0 + 64 * MiB);
        bf16_t* Rb = RKV; bf16_t* Kb = RKV + (size_t)MTOK * DM; bf16_t* Vb = RKV + (size_t)2 * MTOK * DM;
        bf16_t* SZ = act; bf16_t* L1 = pb; bf16_t* DW = (bf16_t*)(ws + T0); bf16_t* DA = (bf16_t*)(ws + T0 + 32 * MiB);
        bf16_t* OUT = (bf16_t*)(ws + OUT_RW); bf16_t* OF = (bf16_t*)(ws + T0);
        const bf16_t* Wrk = (const bf16_t*)(ws + W_RK);
        phase_rw_prep(X, XS, p.in[17], p.in[17] + 1024);
        xcd_barrier(xb);
        { EpiBf16 E; E.O = Rb; E.ldo = 1024; E.split = 1 << 20; E.stride = 0; run_gemm(lds, XS, Wrk, 1024, 1024, E); }
        { EpiBf16 E; E.O = Kb; E.ldo = 1024; E.split = 1 << 20; E.stride = 0; run_gemm(lds, XS + (size_t)MTOK * DM, Wrk + (size_t)1024 * 1024, 1024, 1024, E); }
        phase_rw_lora1(lds, X, Wrk + (size_t)4096 * 1024, L1);
        xcd_barrier(xb);
        phase_rw_prep(X, XS, p.in[17] + 2 * 1024, p.in[17] + 3 * 1024);
        xcd_barrier(xb);
        { EpiBf16 E; E.O = Vb; E.ldo = 1024; E.split = 1 << 20; E.stride = 0; run_gemm(lds, XS, Wrk + (size_t)2 * 1024 * 1024, 1024, 1024, E); }
        { EpiBf16T<1> E; E.O = SZ; E.ldo = 1024; E.split = 1 << 20; E.stride = 0; run_gemm(lds, XS + (size_t)MTOK * DM, Wrk + (size_t)3 * 1024 * 1024, 1024, 1024, E); }
        xcd_barrier(xb);
        { EpiLora2 E; E.EW = DW; E.AA = DA; E.w0 = p.in[19]; E.a0 = p.in[22]; run_gemm(lds, L1, (const bf16_t*)(ws + W_L2), 2048, 256, E); }
        xcd_barrier(xb);
        phase_rw_scan<0>(p, lds, Rb, Kb, Vb, DW, DA, OUT);
        xcd_barrier(xb);
        for (int d = 0; d < DUP_RWSCAN; ++d) { phase_rw_scan<DUP_MODE>(p, lds, Rb, Kb, Vb, DW, DA, OUT); xcd_barrier(xb); }
        phase_rw_post(p, OUT, Rb, Kb, Vb, DA, SZ, OF);
        for (int d = 0; d < DUP_EW; ++d) { xcd_barrier(xb); phase_rw_post(p, OUT, Rb, Kb, Vb, DA, SZ, OF); }
        cvt_pb(p.in[1] + (size_t)2 * MTOK * 256, pb);
        xcd_barrier(xb);
        LAYER_TAIL(2, OF, (const bf16_t*)(ws + W_ROUT), (const bf16_t*)(ws + W_PE2), (const bf16_t*)(ws + W_PG2), (bf16_t*)(ws + T0 + 32 * MiB))
        __syncthreads();
        conv_layer_weights(p, tile, 1, 3);
    }
    xcd_barrier(xb);
    CONV_LAYER(3, 1)
}

extern "C" void kernel_launch(void* const* d_in, const int* in_sizes, int n_in, void* d_out, int out_size, void* d_ws, size_t ws_size, hipStream_t stream) {
    static int grid_blocks = 0;
    if (!grid_blocks) {
        int dev = 0, cus = 0, per_cu = 0;
        hipGetDevice(&dev);
        hipDeviceGetAttribute(&cus, hipDeviceAttributeMultiprocessorCount, dev);
        hipFuncSetAttribute((const void*)fwd_mega, hipFuncAttributeMaxDynamicSharedMemorySize, LDS_BYTES);
        hipOccupancyMaxActiveBlocksPerMultiprocessor(&per_cu, (const void*)fwd_mega, 512, LDS_BYTES);
        if (per_cu < 1) { fprintf(stderr, "occupancy query returned %d\n", per_cu); per_cu = 1; }
        grid_blocks = cus;
        if (ws_size < 256 * MiB) fprintf(stderr, "workspace too small: %zu\n", ws_size);
    }
    P p{};
    for (int i = 0; i < 35; ++i) p.in[i] = (const float*)d_in[i];
    p.out = (float*)d_out; p.ws = (unsigned char*)d_ws;
    hipMemsetAsync((unsigned char*)d_ws + BAR_OFF, 0, XCD_BAR_WORDS * sizeof(unsigned), stream);
    void* args[] = {&p};
    hipError_t e = hipLaunchCooperativeKernel((const void*)fwd_mega, dim3(grid_blocks), dim3(512), args, LDS_BYTES, stream);
    if (e != hipSuccess) fprintf(stderr, "cooperative launch failed: %s (grid %d)\n", hipGetErrorString(e), grid_blocks);
}
```

```cpp
#include <hip/hip_runtime.h>
#include <hip/hip_cooperative_groups.h>
#include <cstdio>
namespace cg = cooperative_groups;
namespace pg8 {
#define PG8_LAS __attribute__((address_space(3)))
typedef unsigned short bf16_t;
typedef short bf16x8 __attribute__((ext_vector_type(8)));
typedef float f32x4 __attribute__((ext_vector_type(4)));
typedef unsigned u32x4 __attribute__((ext_vector_type(4)));
constexpr int BM = 256, BK = 64, HALF = 128, HTB = HALF * BK * 2  , STAGE_BYTES = 8 * HTB, NXCD = 8, WGM = 8;

__host__ __device__ __forceinline__ int lds_byte(int r, int c) { const int st = (r >> 4) * 2 + (c >> 5), rr = r & 15, cc = c & 31, ob = rr * 64 + cc * 2; return st * 1024 + (ob ^ (((ob >> 9) & 1) << 5)); }
__host__ __device__ __forceinline__ void stage_rc(int b, int& R, int& C) { const int st = b / 1024, sb = b % 1024, swz = sb ^ (((sb >> 9) & 1) << 5); R = (st >> 1) * 16 + swz / 64; C = (st & 1) * 32 + (swz % 64) / 2; }
__host__ __device__ __forceinline__ int perm32(int rho) { const int n = rho >> 4, i = rho & 15; return 8 * (i >> 2) + 4 * n + (i & 3); }

struct Unit { int pm, pn; };
struct Gemm { const bf16_t* A; const bf16_t* Bt; int M, N, K; };
struct StaticOrder {
    int nM, nN, nwg, G, c;
    __host__ __device__ void init(int M, int N, int G_, int c_) { nM = M / BM; nN = N / BM; nwg = nM * nN; G = G_; c = c_; }
    __host__ __device__ bool next(int i, Unit& u) const {
        const long L = (long)i * G + c; if (L >= nwg) return false;
        int wgid = (int)L; { const int q = nwg / NXCD, r = nwg % NXCD, xcd = wgid % NXCD, off = wgid / NXCD; wgid = (xcd < r ? xcd * (q + 1) : r * (q + 1) + (xcd - r) * q) + off; }
        const int nig = WGM * nN, gid = wgid / nig, fm = gid * WGM, gsz = (nM - fm) < WGM ? (nM - fm) : WGM;
        u.pm = fm + ((wgid % nig) % gsz); u.pn = (wgid % nig) / gsz; return true;
    }
    __device__ __forceinline__ void a_ready(const Unit&) const {}
    __device__ __forceinline__ void done(const Unit&) const {}
};
__device__ __forceinline__ unsigned cvt_pk_bf16(float lo, float hi) { unsigned r; asm volatile("v_cvt_pk_bf16_f32 %0, %1, %2" : "=v"(r) : "v"(lo), "v"(hi)); return r; }
template <class Epi, class Sched, bool STAMP = false>
__device__ __forceinline__ void gemm_phase(PG8_LAS unsigned char* lds, const Gemm g, const Sched& S, const Epi& E, unsigned long long* stamps) {
    int tid_o = threadIdx.x; asm volatile("" : "+v"(tid_o)); const int tid = tid_o, wid = __builtin_amdgcn_readfirstlane(tid >> 6), lane = tid & 63, wr = wid >> 2, wc = wid & 3, fr = lane & 15, fq = lane >> 4;
    const int K = g.K, nt = K / BK;
    int ts_lo = 0, ts_hi = 0, nts = 0; const unsigned long long rt_entry = STAMP ? (unsigned long long)wall_clock64() : 0ull;
#define PG8_STAMP() do { if (STAMP && wid == 0 && nts < 64) { const unsigned long long _c = (unsigned long long)clock64(); \
        ts_lo = (lane == nts) ? (int)(unsigned)_c : ts_lo; ts_hi = (lane == nts) ? (int)(unsigned)(_c >> 32) : ts_hi; ++nts; } } while (0)
    PG8_STAMP();
    unsigned voffA[2], voffB[2];
#pragma unroll
    for (int i = 0; i < 2; ++i) { int R, C; stage_rc(tid * 16 + i * 8192, R, C); const int Rb = Epi::PERM ? ((R & ~31) + perm32(R & 31)) : R;
        voffA[i] = (unsigned)(R * K + C) * 2u; voffB[i] = (unsigned)(Rb * K + C) * 2u; }
    const size_t kstep = (size_t)(BK * 2);
    const size_t hstep = (size_t)HALF * K * 2;
    const size_t tstep = 2 * hstep;
    const unsigned ldsw = (unsigned)wid * 1024u;
    const int aoff = lds_byte(wr * 64 + fr, fq * 8), boff = lds_byte(wc * 32 + fr, fq * 8);
#define PG8_SA(b, h) (((b) * 2 + (h)) * HTB)
#define PG8_SB(b, h) ((4 + (b) * 2 + (h)) * HTB)
#define PG8_STAGE(bufoff, gbase, voff) do { _Pragma("unroll") for (int _i = 0; _i < 2; ++_i) \
        __builtin_amdgcn_global_load_lds((const unsigned*)((const char*)(gbase) + (voff)[_i]), (PG8_LAS unsigned*)(lds + (bufoff) + ldsw + _i * 8192), 16, 0, 0); } while (0)
#define PG8_LDA(dst, b, h) do { _Pragma("unroll") for (int m = 0; m < 4; ++m) _Pragma("unroll") for (int k = 0; k < 2; ++k) dst[m][k] = *(const PG8_LAS bf16x8*)(lds + PG8_SA(b, h) + aoff + m * 2048 + k * 1024); } while (0)
#define PG8_LDB(dst, b, h) do { _Pragma("unroll") for (int n = 0; n < 2; ++n) _Pragma("unroll") for (int k = 0; k < 2; ++k) dst[n][k] = *(const PG8_LAS bf16x8*)(lds + PG8_SB(b, h) + boff + n * 2048 + k * 1024); } while (0)
#define PG8_MMA(ai, bj, At, Bt) do { __builtin_amdgcn_s_setprio(1); _Pragma("unroll") for (int m = 0; m < 4; ++m) _Pragma("unroll") for (int n = 0; n < 2; ++n) _Pragma("unroll") for (int k = 0; k < 2; ++k) \
        acc[ai][bj][m][n] = __builtin_amdgcn_mfma_f32_16x16x32_bf16(Bt[n][k], At[m][k], acc[ai][bj][m][n], 0, 0, 0); __builtin_amdgcn_s_setprio(0); } while (0)
#define PG8_WAIT_V(n) asm volatile("s_waitcnt vmcnt(" #n ")" ::: "memory")
#define PG8_WAIT_L(n) asm volatile("s_waitcnt lgkmcnt(" #n ")" ::: "memory")
#define PG8_BAR __builtin_amdgcn_s_barrier()
#define PG8_SCHED __builtin_amdgcn_sched_barrier(0)
    Unit cur, nxt; int ui = 0;
    if (!S.next(0, cur)) return;
    f32x4 acc[2][2][4][2];
#pragma unroll
    for (int a = 0; a < 2; ++a)
#pragma unroll
        for (int b = 0; b < 2; ++b)
#pragma unroll
            for (int m = 0; m < 4; ++m)
#pragma unroll
                for (int n = 0; n < 2; ++n) acc[a][b][m][n] = (f32x4){0.f, 0.f, 0.f, 0.f};
    bf16x8 At[4][2], B0[2][2], B1[2][2];
    const char* cA = (const char*)g.A + (size_t)cur.pm * tstep; const char* cB = (const char*)g.Bt + (size_t)cur.pn * tstep;
    S.a_ready(cur);
    PG8_STAGE(PG8_SB(0, 0), cB, voffB); PG8_STAGE(PG8_SA(0, 0), cA, voffA); PG8_STAGE(PG8_SB(0, 1), cB + hstep, voffB); PG8_STAGE(PG8_SA(0, 1), cA + hstep, voffA);
    if (wr == 1) PG8_BAR;
    PG8_WAIT_V(4); PG8_BAR;
    PG8_STAGE(PG8_SB(1, 0), cB + kstep, voffB); PG8_STAGE(PG8_SA(1, 0), cA + kstep, voffA); PG8_STAGE(PG8_SB(1, 1), cB + hstep + kstep, voffB);
    PG8_WAIT_V(6); PG8_BAR;
    PG8_STAMP();
    for (;;) {
        const bool has_next = S.next(ui + 1, nxt);
        const char* nA = has_next ? (const char*)g.A + (size_t)nxt.pm * tstep : cA; const char* nB = has_next ? (const char*)g.Bt + (size_t)nxt.pn * tstep : cB;
        for (int t = 0; t < nt; t += 2) {
            const bool last = (t == nt - 2);
            const char* a1 = cA + (size_t)(t + 1) * kstep;
            const char* a2 = last ? nA : cA + (size_t)(t + 2) * kstep; const char* b2 = last ? nB : cB + (size_t)(t + 2) * kstep;
            const char* a3 = a2 + kstep; const char* b3 = b2 + kstep;
            if (last && has_next) S.a_ready(nxt);
            PG8_LDB(B0, 0, 0); PG8_SCHED; PG8_LDA(At, 0, 0); PG8_STAGE(PG8_SA(1, 1), a1 + hstep, voffA);
            PG8_WAIT_L(8); PG8_BAR; PG8_WAIT_L(0); PG8_MMA(0, 0, At, B0); PG8_BAR; PG8_SCHED;
            PG8_LDB(B1, 0, 1); PG8_STAGE(PG8_SB(0, 0), b2, voffB);
            PG8_BAR; PG8_WAIT_L(0); PG8_MMA(0, 1, At, B1); PG8_BAR;
            PG8_LDA(At, 0, 1); PG8_STAGE(PG8_SA(0, 0), a2, voffA);
            PG8_BAR; PG8_WAIT_L(0); PG8_MMA(1, 0, At, B0); PG8_BAR; PG8_SCHED;
            PG8_STAGE(PG8_SB(0, 1), b2 + hstep, voffB);
            PG8_WAIT_V(6); PG8_BAR; PG8_MMA(1, 1, At, B1); PG8_BAR;
            PG8_LDB(B0, 1, 0); PG8_SCHED; PG8_LDA(At, 1, 0); PG8_STAGE(PG8_SA(0, 1), a2 + hstep, voffA);
            PG8_WAIT_L(8); PG8_BAR; PG8_WAIT_L(0); PG8_MMA(0, 0, At, B0); PG8_BAR; PG8_SCHED;
            PG8_LDB(B1, 1, 1); PG8_STAGE(PG8_SB(1, 0), b3, voffB);
            PG8_BAR; PG8_WAIT_L(0); PG8_MMA(0, 1, At, B1); PG8_BAR;
            PG8_LDA(At, 1, 1); PG8_STAGE(PG8_SA(1, 0), a3, voffA);
            PG8_BAR; PG8_WAIT_L(0); PG8_MMA(1, 0, At, B0); PG8_BAR; PG8_SCHED;
            PG8_STAGE(PG8_SB(1, 1), b3 + hstep, voffB);
            PG8_WAIT_V(6); PG8_BAR; PG8_MMA(1, 1, At, B1); PG8_BAR;
        }
        PG8_STAMP();
        if constexpr (!Epi::AFTER_DRAIN) { E(acc, cur, wr, wc, fr, fq); S.done(cur); }
        PG8_STAMP();
        if (!has_next) break;
#pragma unroll
        for (int a = 0; a < 2; ++a)
#pragma unroll
            for (int b = 0; b < 2; ++b)
#pragma unroll
                for (int m = 0; m < 4; ++m)
#pragma unroll
                    for (int n = 0; n < 2; ++n) acc[a][b][m][n] = (f32x4){0.f, 0.f, 0.f, 0.f};
        cur = nxt; cA = nA; cB = nB; ++ui;
    }
    PG8_WAIT_V(0);
    if (wr == 0) PG8_BAR;
    PG8_BAR;
    if constexpr (Epi::AFTER_DRAIN) { E.fused(acc, cur, wr, wc, fr, fq, lds, wid, lane); S.done(cur); }
    PG8_STAMP();
    if (STAMP && wid == 0) { stamps[lane] = lane < nts ? (((unsigned long long)(unsigned)ts_hi << 32) | (unsigned)ts_lo) : 0ull;
        if (lane == 62) stamps[62] = rt_entry; if (lane == 63) stamps[63] = (unsigned long long)wall_clock64(); }
#undef PG8_STAMP
#undef PG8_SA
#undef PG8_SB
#undef PG8_STAGE
#undef PG8_LDA
#undef PG8_LDB
#undef PG8_MMA
#undef PG8_WAIT_V
#undef PG8_WAIT_L
#undef PG8_BAR
#undef PG8_SCHED
}
}
using pg8::bf16_t; using pg8::bf16x8; using pg8::f32x4; using pg8::Unit; using pg8::Gemm; using pg8::StaticOrder;
#define LAS __attribute__((address_space(3)))
constexpr int MTOK = 16384, DM = 1024, SEQL = 4096;
constexpr size_t MiB = 1u << 20, KiB = 1u << 10;
constexpr float DN_ALPHA = 1.6817928305074290f;
constexpr size_t W_CIN = 0, W_COUT = 8 * MiB, W_PEC = 10 * MiB, W_PGC = 10 * MiB + 512 * KiB;
constexpr size_t W_SIN = 12 * MiB + 512 * KiB, W_SGLU = 16 * MiB + 512 * KiB, W_SOUT = 18 * MiB + 512 * KiB, W_PE1 = 20 * MiB + 512 * KiB, W_PG1 = 21 * MiB;
constexpr size_t W_RK = 23 * MiB, W_L2 = 40 * MiB, W_ROUT = 41 * MiB, W_PE2 = 43 * MiB, W_PG2 = 43 * MiB + 512 * KiB;
constexpr size_t OUT_RW = 0, PB = 46 * MiB, ACT = 54 * MiB, T0 = 86 * MiB;
constexpr int LDS_XST = 153600;
constexpr int LDS_BYTES = LDS_XST + 16;
#ifndef DUP_PREP
#define DUP_PREP 0
#define DUP_RWSCAN 0
#define DUP_S5 0
#define DUP_RK 0
#define DUP_SYNC 0
#define DUP_EW 0
#endif
#ifndef DUP_MODE
#define DUP_MODE 0
#endif

struct P { const float* in[35]; float* out; unsigned char* ws; };
#define XB_TMO      128
#define XB_XCNT(j)  (256  + 64 * (j))
#define XB_XSUB(j)  (1280 + 64 * (j))
#define XB_XGEN(j)  (2304 + 64 * (j))
#define XB_TOP      3328
#define XB_TOPGEN   3392
#define XCD_BAR_WORDS 3456
#define XB_SPIN_CAP (1u << 18)

__device__ __forceinline__ unsigned xb_ld(unsigned* p)              { return __hip_atomic_load(p, __ATOMIC_RELAXED, __HIP_MEMORY_SCOPE_AGENT); }
__device__ __forceinline__ unsigned xb_add(unsigned* p, unsigned v) { return __hip_atomic_fetch_add(p, v, __ATOMIC_RELAXED, __HIP_MEMORY_SCOPE_AGENT); }
__device__ __forceinline__ unsigned xb_xcc_id() { return (unsigned)__builtin_amdgcn_s_getreg((3 << 11) | 20) & 0xFu; }
#define XB_SPIN(cond, bar) do { unsigned _sp = 0; while (cond) { __builtin_amdgcn_s_sleep(1); \
    if ((++_sp & 255u) == 0u) { if (xb_ld(&(bar)[XB_TMO])) break; if (_sp > XB_SPIN_CAP) { atomicAdd(&(bar)[XB_TMO], 1u); break; } } } } while (0)

struct XcdBarrier {
    unsigned* bar; unsigned x;
    volatile LAS unsigned* st;
};

__device__ __forceinline__ XcdBarrier xcd_barrier_post(unsigned* bar, volatile LAS unsigned* st) {
    XcdBarrier b; b.bar = bar; b.x = xb_xcc_id(); b.st = st;
    if (threadIdx.x == 0) (void)xb_add(&bar[XB_XCNT(b.x)], 1u);
    return b;
}
__device__ __forceinline__ void xcd_barrier_complete(unsigned* bar, unsigned x, unsigned& nloc, unsigned& nx) {
    const unsigned G = gridDim.x * gridDim.y * gridDim.z;
    unsigned sum, cnt, mine, sp = 0u;
    for (;;) {
        sum = 0u; cnt = 0u; mine = 0u;
#pragma unroll
        for (unsigned j = 0; j < 16; ++j) { const unsigned c = xb_ld(&bar[XB_XCNT(j)]); sum += c; cnt += (c > 0u) ? 1u : 0u; mine = (j == x) ? c : mine; }
        if (sum == G) break;
        __builtin_amdgcn_s_sleep(1);
        if ((++sp & 255u) == 0u) { if (xb_ld(&bar[XB_TMO])) break; if (sp > XB_SPIN_CAP) { atomicAdd(&bar[XB_TMO], 1u); break; } }
    }
    nloc = mine > 0u ? mine : 1u; nx = cnt > 0u ? cnt : 1u;
}

__device__ __forceinline__ void xcd_barrier(const XcdBarrier& b) {
    asm volatile("s_waitcnt vmcnt(0)" ::: "memory");
    __syncthreads();
    if (threadIdx.x == 0) {
        unsigned* bar = b.bar;
        __builtin_amdgcn_s_waitcnt(0);
        unsigned nloc = b.st[0], nx = b.st[1];
        if (nloc == 0u) { xcd_barrier_complete(bar, b.x, nloc, nx); b.st[0] = nloc; b.st[1] = nx; }
        const unsigned old = xb_add(&bar[XB_XSUB(b.x)], 1u);
        const unsigned gen = old / nloc;
        if (old + 1u == (gen + 1u) * nloc) {
            __builtin_amdgcn_fence(__ATOMIC_RELEASE, "agent");
            asm volatile("s_waitcnt vmcnt(0)" ::: "memory");
            const unsigned og = xb_add(&bar[XB_TOP], 1u);
            const unsigned tg = og / nx;
            if (og + 1u == (tg + 1u) * nx) xb_add(&bar[XB_TOPGEN], 1u);
            else XB_SPIN(xb_ld(&bar[XB_TOPGEN]) == tg, bar);
            __builtin_amdgcn_fence(__ATOMIC_ACQUIRE, "agent");
            xb_add(&bar[XB_XGEN(b.x)], 1u);
            asm volatile("s_waitcnt vmcnt(0)" ::: "memory");
        } else {
            XB_SPIN(xb_ld(&bar[XB_XGEN(b.x)]) == gen, bar);
            __builtin_amdgcn_fence(__ATOMIC_ACQUIRE, "agent");
            asm volatile("s_waitcnt vmcnt(0)" ::: "memory");
        }
    }
    __syncthreads();
}

constexpr size_t BAR_OFF = 254 * MiB;


typedef __bf16 bf2_t __attribute__((ext_vector_type(2)));
typedef float f2_t __attribute__((ext_vector_type(2)));
__device__ __forceinline__ unsigned pk2(float lo, float hi) { f2_t v = {lo, hi}; bf2_t b = __builtin_convertvector(v, bf2_t); return __builtin_bit_cast(unsigned, b); }
__device__ __forceinline__ float bflo(unsigned u) { return __uint_as_float(u << 16); }
__device__ __forceinline__ float bfhi(unsigned u) { return __uint_as_float(u & 0xffff0000u); }
__device__ __forceinline__ float rcpf_(float x) { return __builtin_amdgcn_rcpf(x); }
__device__ __forceinline__ float sigmoidf_(float x) { return rcpf_(1.0f + __expf(-x)); }
__device__ __forceinline__ float siluf_(float x) { return x * rcpf_(1.0f + __expf(-x)); }
__device__ __forceinline__ float tanhf_(float x) { const float e = __expf(-2.0f * fabsf(x)); const float t = (1.0f - e) * rcpf_(1.0f + e); return x < 0.f ? -t : t; }
__device__ __forceinline__ float gelu_tanh(float x) { return 0.5f * x * (1.0f + tanhf_(0.7978845608028654f * (x + 0.044715f * x * x * x))); }
template <int CTRL> __device__ __forceinline__ float dppf(float x) { return __int_as_float(__builtin_amdgcn_update_dpp(0, __float_as_int(x), CTRL, 0xF, 0xF, true)); }
__device__ __forceinline__ float red8(float x) { x += dppf<0xB1>(x); x += dppf<0x4E>(x); x += dppf<0x141>(x); return x; }
__device__ __forceinline__ float red16(float x) { x = red8(x); x += dppf<0x140>(x); return x; }
__device__ __forceinline__ float wave_sum(float v) { for (int o = 32; o >= 1; o >>= 1) v += __shfl_xor(v, o); return v; }
__device__ __forceinline__ int otid() { int t = threadIdx.x; asm volatile("" : "+v"(t)); return t; }
typedef float f32x2 __attribute__((ext_vector_type(2)));
__device__ __forceinline__ float fma_s(float a, float b, float c) { float d; asm("v_fma_f32 %0, %1, %2, %3" : "=v"(d) : "v"(a), "v"(b), "v"(c)); return d; }
__device__ __forceinline__ float fnma_s(float a, float b, float c) { float d; asm("v_fma_f32 %0, -%1, %2, %3" : "=v"(d) : "v"(a), "v"(b), "v"(c)); return d; }
__device__ __forceinline__ float mul_s(float a, float b) { float d; asm("v_mul_f32 %0, %1, %2" : "=v"(d) : "v"(a), "v"(b)); return d; }
__device__ __forceinline__ float add_s(float a, float b) { float d; asm("v_add_f32 %0, %1, %2" : "=v"(d) : "v"(a), "v"(b)); return d; }
#define BAR_LDS() asm volatile("s_waitcnt lgkmcnt(0)\n\ts_barrier" ::: "memory")
#define LDS_FENCE() asm volatile("s_waitcnt lgkmcnt(0)" ::: "memory")

struct EpiConvIn {
    static constexpr bool PERM = false, AFTER_DRAIN = false;
    bf16_t* U; bf16_t* G;
    __device__ __forceinline__ void operator()(const f32x4 (&acc)[2][2][4][2], const Unit& u, int wr, int wc, int fr, int fq) const {
        const int row0 = u.pm * 256 + wr * 64 + fr, e0 = u.pn * 64 + wc * 16 + 4 * fq;
#pragma unroll
        for (int ai = 0; ai < 2; ++ai)
#pragma unroll
            for (int m = 0; m < 4; ++m) {
                const size_t o = (size_t)(row0 + ai * 128 + m * 16) * DM + e0;
                float uu[4], gg[4];
#pragma unroll
                for (int j = 0; j < 4; ++j) { uu[j] = acc[ai][0][m][1][j] * acc[ai][1][m][0][j]; gg[j] = acc[ai][0][m][0][j] * siluf_(acc[ai][1][m][1][j]); }
                *(uint2*)(U + o) = make_uint2(pk2(uu[0], uu[1]), pk2(uu[2], uu[3]));
                *(uint2*)(G + o) = make_uint2(pk2(gg[0], gg[1]), pk2(gg[2], gg[3]));
            }
    }
};
struct EpiWout {
    static constexpr bool PERM = false, AFTER_DRAIN = false;
    float* X; bf16_t* RB;
    __device__ __forceinline__ void operator()(const f32x4 (&acc)[2][2][4][2], const Unit& u, int wr, int wc, int fr, int fq) const {
        const int row0 = u.pm * 256 + wr * 64 + fr, col0 = u.pn * 256 + wc * 32 + 4 * fq;
#pragma unroll
        for (int ai = 0; ai < 2; ++ai)
#pragma unroll
            for (int m = 0; m < 4; ++m)
#pragma unroll
                for (int bj = 0; bj < 2; ++bj)
#pragma unroll
                    for (int n = 0; n < 2; ++n) {
                        const size_t o = (size_t)(row0 + ai * 128 + m * 16) * DM + col0 + bj * 128 + n * 16;
                        f32x4 x = *(const f32x4*)(X + o);
                        f32x4 r = x * DN_ALPHA + acc[ai][bj][m][n];
                        *(f32x4*)(X + o) = r;
                        *(uint2*)(RB + o) = make_uint2(pk2(r[0], r[1]), pk2(r[2], r[3]));
                    }
    }
};
template <int ACT> struct EpiBf16T {
    static constexpr bool PERM = false, AFTER_DRAIN = false;
    bf16_t* O; int ldo; int split; size_t stride;
    __device__ __forceinline__ void operator()(const f32x4 (&acc)[2][2][4][2], const Unit& u, int wr, int wc, int fr, int fq) const {
        const int row0 = u.pm * 256 + wr * 64 + fr; const int grp = u.pn / split; const int col0 = (u.pn - grp * split) * 256 + wc * 32 + 4 * fq;
        bf16_t* base = O + (size_t)grp * stride;
#pragma unroll
        for (int ai = 0; ai < 2; ++ai)
#pragma unroll
            for (int m = 0; m < 4; ++m)
#pragma unroll
                for (int bj = 0; bj < 2; ++bj)
#pragma unroll
                    for (int n = 0; n < 2; ++n) {
                        const size_t o = (size_t)(row0 + ai * 128 + m * 16) * ldo + col0 + bj * 128 + n * 16;
                        f32x4 a = acc[ai][bj][m][n];
                        if (ACT == 1) { a[0] = siluf_(a[0]); a[1] = siluf_(a[1]); a[2] = siluf_(a[2]); a[3] = siluf_(a[3]); }
                        *(uint2*)(base + o) = make_uint2(pk2(a[0], a[1]), pk2(a[2], a[3]));
                    }
    }
};
typedef EpiBf16T<0> EpiBf16;
struct EpiPle {
    static constexpr bool PERM = false, AFTER_DRAIN = false;
    float* X; const bf16_t* PE;
    __device__ __forceinline__ void operator()(const f32x4 (&acc)[2][2][4][2], const Unit& u, int wr, int wc, int fr, int fq) const {
        const int row0 = u.pm * 256 + wr * 64 + fr, col0 = u.pn * 256 + wc * 32 + 4 * fq;
#pragma unroll
        for (int ai = 0; ai < 2; ++ai)
#pragma unroll
            for (int m = 0; m < 4; ++m)
#pragma unroll
                for (int bj = 0; bj < 2; ++bj)
#pragma unroll
                    for (int n = 0; n < 2; ++n) {
                        const size_t o = (size_t)(row0 + ai * 128 + m * 16) * DM + col0 + bj * 128 + n * 16;
                        f32x4 x = *(const f32x4*)(X + o); const uint2 pe = *(const uint2*)(PE + o); const f32x4 a = acc[ai][bj][m][n];
                        x[0] += bflo(pe.x) * sigmoidf_(a[0]); x[1] += bfhi(pe.x) * sigmoidf_(a[1]); x[2] += bflo(pe.y) * sigmoidf_(a[2]); x[3] += bfhi(pe.y) * sigmoidf_(a[3]);
                        *(f32x4*)(X + o) = x;
                    }
    }
};
struct EpiSsmIn {
    static constexpr bool PERM = false, AFTER_DRAIN = false;
    float* U; bf16_t* SZ;
    __device__ __forceinline__ void operator()(const f32x4 (&acc)[2][2][4][2], const Unit& u, int wr, int wc, int fr, int fq) const {
        const int row0 = u.pm * 256 + wr * 64 + fr; const bool isz = u.pn >= 4; const int col0 = (u.pn & 3) * 256 + wc * 32 + 4 * fq;
#pragma unroll
        for (int ai = 0; ai < 2; ++ai)
#pragma unroll
            for (int m = 0; m < 4; ++m)
#pragma unroll
                for (int bj = 0; bj < 2; ++bj)
#pragma unroll
                    for (int n = 0; n < 2; ++n) {
                        const size_t o = (size_t)(row0 + ai * 128 + m * 16) * DM + col0 + bj * 128 + n * 16;
                        const f32x4 a = acc[ai][bj][m][n];
                        if (isz) *(uint2*)(SZ + o) = make_uint2(pk2(siluf_(a[0]), siluf_(a[1])), pk2(siluf_(a[2]), siluf_(a[3])));
                        else *(f32x4*)(U + o) = a;
                    }
    }
};
struct EpiGlu {
    static constexpr bool PERM = false, AFTER_DRAIN = false;
    const bf16_t* YG; const bf16_t* SZ; const float* bias; bf16_t* V;
    __device__ __forceinline__ void operator()(const f32x4 (&acc)[2][2][4][2], const Unit& u, int wr, int wc, int fr, int fq) const {
        const int row0 = u.pm * 256 + wr * 64 + fr, col0 = u.pn * 256 + wc * 32 + 4 * fq;
#pragma unroll
        for (int ai = 0; ai < 2; ++ai)
#pragma unroll
            for (int m = 0; m < 4; ++m)
#pragma unroll
                for (int bj = 0; bj < 2; ++bj)
#pragma unroll
                    for (int n = 0; n < 2; ++n) {
                        const int col = col0 + bj * 128 + n * 16;
                        const size_t o = (size_t)(row0 + ai * 128 + m * 16) * DM + col;
                        const f32x4 a = acc[ai][bj][m][n]; const f32x4 bb = *(const f32x4*)(bias + col);
                        const uint2 y = *(const uint2*)(YG + o), z = *(const uint2*)(SZ + o);
                        const float v0 = bflo(y.x) * sigmoidf_(a[0] + bb[0]) * bflo(z.x), v1 = bfhi(y.x) * sigmoidf_(a[1] + bb[1]) * bfhi(z.x);
                        const float v2 = bflo(y.y) * sigmoidf_(a[2] + bb[2]) * bflo(z.y), v3 = bfhi(y.y) * sigmoidf_(a[3] + bb[3]) * bfhi(z.y);
                        *(uint2*)(V + o) = make_uint2(pk2(v0, v1), pk2(v2, v3));
                    }
    }
};
struct EpiRk {
    static constexpr bool PERM = false, AFTER_DRAIN = false;
    bf16_t* RKV; bf16_t* SZ; bf16_t* L1;
    __device__ __forceinline__ void operator()(const f32x4 (&acc)[2][2][4][2], const Unit& u, int wr, int wc, int fr, int fq) const {
        const int row0 = u.pm * 256 + wr * 64 + fr; const int grp = u.pn >> 2; const int colt = (u.pn & 3) * 256 + wc * 32 + 4 * fq;
#pragma unroll
        for (int ai = 0; ai < 2; ++ai)
#pragma unroll
            for (int m = 0; m < 4; ++m)
#pragma unroll
                for (int bj = 0; bj < 2; ++bj)
#pragma unroll
                    for (int n = 0; n < 2; ++n) {
                        const int row = row0 + ai * 128 + m * 16, col = colt + bj * 128 + n * 16;
                        const f32x4 a = acc[ai][bj][m][n];
                        if (grp < 3) *(uint2*)(RKV + (size_t)grp * MTOK * DM + (size_t)row * DM + col) = make_uint2(pk2(a[0], a[1]), pk2(a[2], a[3]));
                        else if (grp == 3) *(uint2*)(SZ + (size_t)row * DM + col) = make_uint2(pk2(siluf_(a[0]), siluf_(a[1])), pk2(siluf_(a[2]), siluf_(a[3])));
                        else { const bool th = col < 64;
                            const float v0 = th ? tanhf_(a[0]) : a[0], v1 = th ? tanhf_(a[1]) : a[1], v2 = th ? tanhf_(a[2]) : a[2], v3 = th ? tanhf_(a[3]) : a[3];
                            *(uint2*)(L1 + (size_t)row * 256 + col) = make_uint2(pk2(v0, v1), pk2(v2, v3)); }
                    }
    }
};

struct EpiLora2 {
    static constexpr bool PERM = false, AFTER_DRAIN = false;
    bf16_t* EW; bf16_t* AA; const float* w0; const float* a0;
    __device__ __forceinline__ void operator()(const f32x4 (&acc)[2][2][4][2], const Unit& u, int wr, int wc, int fr, int fq) const {
        const int row0 = u.pm * 256 + wr * 64 + fr; const bool isa = u.pn >= 4; const int col0 = (u.pn & 3) * 256 + wc * 32 + 4 * fq;
        bf16_t* O = isa ? AA : EW; const float* bias = isa ? a0 : w0;
#pragma unroll
        for (int bj = 0; bj < 2; ++bj)
#pragma unroll
            for (int n = 0; n < 2; ++n) {
                const int col = col0 + bj * 128 + n * 16; const f32x4 bb = *(const f32x4*)(bias + col);
#pragma unroll
                for (int ai = 0; ai < 2; ++ai)
#pragma unroll
                    for (int m = 0; m < 4; ++m) {
                        const f32x4 a = acc[ai][bj][m][n]; float v[4];
#pragma unroll
                        for (int j = 0; j < 4; ++j) { const float t = bb[j] + a[j];
                            if (isa) v[j] = sigmoidf_(t);
                            else { const float x = -t; const float sp = fmaxf(x, 0.f) + __logf(1.0f + __expf(-fabsf(x))); v[j] = __expf(-sp - 0.5f); } }
                        *(uint2*)(O + (size_t)(row0 + ai * 128 + m * 16) * DM + col) = make_uint2(pk2(v[0], v[1]), pk2(v[2], v[3]));
                    }
            }
    }
};

template <class Epi> __device__ __forceinline__ void run_gemm(LAS unsigned char* lds, const bf16_t* A, const bf16_t* Bt, int N, int K, const Epi& E) {
    Gemm g; g.A = A; g.Bt = Bt; g.M = MTOK; g.N = N; g.K = K;
    StaticOrder S; S.init(MTOK, N, (int)gridDim.x, (int)blockIdx.x);
    pg8::gemm_phase<Epi, StaticOrder, false>(lds, g, S, E, nullptr);
}

__device__ __forceinline__ int conv_rowmap(int n) { const int s = n >> 10, e = n & 1023, q = e & 63; return 256 * (e >> 6) + 128 * (s >> 1) + 32 * (q >> 4) + 16 * (s & 1) + (q & 15); }
__device__ __forceinline__ void tr_job(LAS float* tile, const float* src, int ld_src, int K, int N, bf16_t* dst, int ldd, int koff, const float* kscale, int mode, int rot) {
    const int nblk = (int)gridDim.x, blk = ((int)blockIdx.x + rot) % nblk, tid = otid();
    const int tn_ = N >> 6, ntiles = (K >> 6) * tn_;
    const int tk0 = tid >> 6, tn = tid & 63, nl = tid >> 3, kp = (tid & 7) * 8;
    float cur[8];
    if (blk < ntiles) { const int k0 = (blk / tn_) << 6, n0 = (blk % tn_) << 6;
#pragma unroll
        for (int i = 0; i < 8; ++i) cur[i] = src[(size_t)(k0 + tk0 + i * 8) * ld_src + n0 + tn]; }
    for (int t = blk; t < ntiles; t += nblk) {
        const int k0 = (t / tn_) << 6, n0 = (t % tn_) << 6;
        float nxt[8];
        const int t2 = t + nblk;
        if (t2 < ntiles) { const int k2 = (t2 / tn_) << 6, n2 = (t2 % tn_) << 6;
#pragma unroll
            for (int i = 0; i < 8; ++i) nxt[i] = src[(size_t)(k2 + tk0 + i * 8) * ld_src + n2 + tn]; }
        BAR_LDS();
#pragma unroll
        for (int i = 0; i < 8; ++i) tile[(tk0 + i * 8) * 65 + tn] = cur[i];
        BAR_LDS();
        float v[8];
#pragma unroll
        for (int i = 0; i < 8; ++i) { v[i] = tile[(kp + i) * 65 + nl]; if (kscale) v[i] *= kscale[k0 + kp + i]; }
        const int n = n0 + nl; const int row = mode ? conv_rowmap(n) : n;
        *(uint4*)(dst + (size_t)row * ldd + koff + k0 + kp) = make_uint4(pk2(v[0], v[1]), pk2(v[2], v[3]), pk2(v[4], v[5]), pk2(v[6], v[7]));
        if (t2 < ntiles) {
#pragma unroll
            for (int i = 0; i < 8; ++i) cur[i] = nxt[i]; }
    }
}
__device__ __forceinline__ void cvt_pb(const float* src, bf16_t* dst) {
    const size_t n4 = (size_t)MTOK * 256 / 4, nth = (size_t)gridDim.x * 512;
    for (size_t i = (size_t)blockIdx.x * 512 + otid(); i < n4; i += nth) { const float4 v = ((const float4*)src)[i]; ((uint2*)dst)[i] = make_uint2(pk2(v.x, v.y), pk2(v.z, v.w)); }
}
__device__ __forceinline__ void conv_layer_weights(const P& p, LAS float* tile, int j, int L) {
    unsigned char* ws = p.ws;
    tr_job(tile, p.in[2] + (size_t)j * 1024 * 4096, 4096, 1024, 4096, (bf16_t*)(ws + W_CIN), 1024, 0, nullptr, 1, 0);
    tr_job(tile, p.in[4] + (size_t)j * 1024 * 1024, 1024, 1024, 1024, (bf16_t*)(ws + W_COUT), 1024, 0, nullptr, 0, 0);
    tr_job(tile, p.in[31] + (size_t)L * 256 * 1024, 1024, 256, 1024, (bf16_t*)(ws + W_PEC), 256, 0, nullptr, 0, 0);
    tr_job(tile, p.in[32] + (size_t)L * 1024 * 1024, 1024, 1024, 1024, (bf16_t*)(ws + W_PGC), 1024, 0, nullptr, 0, 64);
}

__device__ __forceinline__ void phase_prep(const P& p, LAS float* tile) {
    unsigned char* ws = p.ws; const size_t nth = (size_t)gridDim.x * 512, gt = (size_t)blockIdx.x * 512 + otid();
    {
        const float4* x = (const float4*)p.in[0]; float4* o = (float4*)p.out; uint2* a = (uint2*)(ws + ACT);
        for (size_t i = gt; i < (size_t)MTOK * DM / 4; i += nth) { const float4 v = x[i]; o[i] = v; a[i] = make_uint2(pk2(v.x, v.y), pk2(v.z, v.w)); }
    }
    cvt_pb(p.in[1], (bf16_t*)(ws + PB));
    conv_layer_weights(p, tile, 0, 0);
    tr_job(tile, p.in[5], 2048, 1024, 2048, (bf16_t*)(ws + W_SIN), 1024, 0, nullptr, 0, 128);
    tr_job(tile, p.in[14], 1024, 1024, 1024, (bf16_t*)(ws + W_SGLU), 1024, 0, nullptr, 0, 0);
    tr_job(tile, p.in[16], 1024, 1024, 1024, (bf16_t*)(ws + W_SOUT), 1024, 0, nullptr, 0, 0);
    tr_job(tile, p.in[31] + (size_t)1 * 256 * 1024, 1024, 256, 1024, (bf16_t*)(ws + W_PE1), 256, 0, nullptr, 0, 192);
    tr_job(tile, p.in[32] + (size_t)1 * 1024 * 1024, 1024, 1024, 1024, (bf16_t*)(ws + W_PG1), 1024, 0, nullptr, 0, 0);
    bf16_t* rk = (bf16_t*)(ws + W_RK);
    for (int g = 0; g < 4; ++g)
        tr_job(tile, p.in[18] + (size_t)g * 1024 * 1024, 1024, 1024, 1024, rk + (size_t)g * 1024 * 1024, 1024, 0, nullptr, 0, g * 64);
    bf16_t* wl = rk + (size_t)4096 * 1024;
    tr_job(tile, p.in[20], 64, 1024, 64, wl, 2048, 0, nullptr, 0, 0);
    tr_job(tile, p.in[20], 64, 1024, 64, wl, 2048, 1024, p.in[17] + 4 * 1024, 0, 16);
    tr_job(tile, p.in[23], 64, 1024, 64, wl + (size_t)64 * 2048, 2048, 0, nullptr, 0, 32);
    tr_job(tile, p.in[23], 64, 1024, 64, wl + (size_t)64 * 2048, 2048, 1024, p.in[17] + 5 * 1024, 0, 48);
    bf16_t* l2 = (bf16_t*)(ws + W_L2);
    tr_job(tile, p.in[21], 1024, 64, 1024, l2, 256, 0, nullptr, 0, 64);
    tr_job(tile, p.in[24], 1024, 64, 1024, l2 + (size_t)1024 * 256, 256, 64, nullptr, 0, 80);
    for (size_t i = gt; i < (size_t)2048 * 32; i += nth) { const int row = (int)(i >> 5), c8 = (int)(i & 31); const bool data = row < 1024 ? (c8 < 8) : (c8 >= 8 && c8 < 16);
        if (!data) *(uint4*)(l2 + (size_t)row * 256 + c8 * 8) = make_uint4(0, 0, 0, 0); }
    tr_job(tile, p.in[30], 1024, 1024, 1024, (bf16_t*)(ws + W_ROUT), 1024, 0, nullptr, 0, 96);
    tr_job(tile, p.in[31] + (size_t)2 * 256 * 1024, 1024, 256, 1024, (bf16_t*)(ws + W_PE2), 256, 0, nullptr, 0, 160);
    tr_job(tile, p.in[32] + (size_t)2 * 1024 * 1024, 1024, 1024, 1024, (bf16_t*)(ws + W_PG2), 1024, 0, nullptr, 0, 0);
}

__device__ __forceinline__ void phase_conv_ew(const bf16_t* U, bf16_t* G, const float* ck) {
    const size_t nth = (size_t)gridDim.x * 512;
    for (size_t i = (size_t)blockIdx.x * 512 + otid(); i < (size_t)MTOK * 128; i += nth) {
        const int row = (int)(i >> 7), c8 = (int)(i & 127) * 8, t = row & (SEQL - 1);
        const uint4 z4 = make_uint4(0, 0, 0, 0);
        const uint4 u0 = *(const uint4*)(U + (size_t)row * DM + c8);
        const uint4 u1 = t >= 1 ? *(const uint4*)(U + (size_t)(row - 1) * DM + c8) : z4;
        const uint4 u2 = t >= 2 ? *(const uint4*)(U + (size_t)(row - 2) * DM + c8) : z4;
        const uint4 g = *(const uint4*)(G + (size_t)row * DM + c8);
        const unsigned a0[4] = {u0.x, u0.y, u0.z, u0.w}, a1[4] = {u1.x, u1.y, u1.z, u1.w}, a2[4] = {u2.x, u2.y, u2.z, u2.w}, gg[4] = {g.x, g.y, g.z, g.w};
        unsigned o[4];
#pragma unroll
        for (int q = 0; q < 4; ++q) {
            const int c = c8 + 2 * q;
            const float lo = bflo(gg[q]) * (ck[c] * bflo(a2[q]) + ck[1024 + c] * bflo(a1[q]) + ck[2048 + c] * bflo(a0[q]));
            const float hi = bfhi(gg[q]) * (ck[c + 1] * bfhi(a2[q]) + ck[1024 + c + 1] * bfhi(a1[q]) + ck[2048 + c + 1] * bfhi(a0[q]));
            o[q] = pk2(lo, hi);
        }
        *(uint4*)(G + (size_t)row * DM + c8) = make_uint4(o[0], o[1], o[2], o[3]);
    }
}

__device__ __forceinline__ void phase_ln(float* X, bf16_t* XB, const float* g, const float* b) {
    const int lane = otid() & 63, gw = blockIdx.x * 8 + (otid() >> 6), nw = gridDim.x * 8;
    for (int row = gw; row < MTOK; row += nw) {
        float4 v[4]; float s = 0.f;
#pragma unroll
        for (int i = 0; i < 4; ++i) { v[i] = *(const float4*)(X + (size_t)row * DM + i * 256 + lane * 4); s += v[i].x + v[i].y + v[i].z + v[i].w; }
        const float mean = wave_sum(s) * (1.0f / 1024.0f);
        float q = 0.f;
#pragma unroll
        for (int i = 0; i < 4; ++i) { v[i].x -= mean; v[i].y -= mean; v[i].z -= mean; v[i].w -= mean; q += v[i].x * v[i].x + v[i].y * v[i].y + v[i].z * v[i].z + v[i].w * v[i].w; }
        const float rs = rsqrtf(wave_sum(q) * (1.0f / 1024.0f) + 1e-5f);
#pragma unroll
        for (int i = 0; i < 4; ++i) { const int c = i * 256 + lane * 4; const float4 gg = *(const float4*)(g + c), bb = *(const float4*)(b + c);
            float4 y; y.x = v[i].x * rs * gg.x + bb.x; y.y = v[i].y * rs * gg.y + bb.y; y.z = v[i].z * rs * gg.z + bb.z; y.w = v[i].w * rs * gg.w + bb.w;
            *(float4*)(X + (size_t)row * DM + c) = y; *(uint2*)(XB + (size_t)row * DM + c) = make_uint2(pk2(y.x, y.y), pk2(y.z, y.w)); }
    }
}

template <int FINAL> __device__ __forceinline__ void phase_s5(const P& p, LAS unsigned char* lds_, const float* U, float* HLOC, bf16_t* YG) {
    const int lane = otid() & 63, wid = otid() >> 6, nw = gridDim.x * 8;
    LAS float* ul = (LAS float*)(lds_ + wid * 8192);
    LAS unsigned* S = (LAS unsigned*)(lds_ + wid * 8192 + 2048);
    const int fr = lane & 15, fq = lane >> 4;
    for (int un = blockIdx.x * 8 + wid; un < 2048; un += nw) {
        const int g = un & 63, sc = (un >> 6) & 7, b = un >> 9;
        if (!FINAL && sc == 7) continue;
        const float dt = __expf(p.in[8][g]);
        const float lre = p.in[6][g * 64 + lane], lim = p.in[7][g * 64 + lane];
        const float mag = expf(lre * dt); float sn, cs; sincosf(lim * dt, &sn, &cs);
        const float are = mag * cs, aim = mag * sn;
        const float d2 = lre * lre + lim * lim, cfre = ((are - 1.0f) * lre + aim * lim) / d2, cfim = (aim * lre - (are - 1.0f) * lim) / d2;
        f32x2 Bp[16];
#pragma unroll
        for (int q = 0; q < 4; ++q) { const float4 br = *(const float4*)(p.in[9] + (size_t)(g * 64 + lane) * 16 + q * 4), bi = *(const float4*)(p.in[10] + (size_t)(g * 64 + lane) * 16 + q * 4);
            const float brr[4] = {br.x, br.y, br.z, br.w}, bii[4] = {bi.x, bi.y, bi.z, bi.w};
#pragma unroll
            for (int j = 0; j < 4; ++j) { Bp[q * 4 + j] = (f32x2){cfre * brr[j] - cfim * bii[j], cfre * bii[j] + cfim * brr[j]}; } }
        float hre = 0.f, him = 0.f;
        bf16x8 Cf[4]; float dsk = 0.f;
        if (FINAL) {
            float lr = are, li = aim;
#pragma unroll
            for (int i = 0; i < 9; ++i) { const float t = lr * lr - li * li; li = 2.0f * lr * li; lr = t; }
            for (int s2 = 0; s2 < sc; ++s2) { const float2 hv = *(const float2*)(HLOC + ((size_t)((b * 8 + s2) * 64 + g) * 64 + lane) * 2);
                const float t = lr * hre - li * him + hv.x; him = lr * him + li * hre + hv.y; hre = t; }
#pragma unroll
            for (int kk = 0; kk < 4; ++kk) {
                unsigned w[4];
#pragma unroll
                for (int i = 0; i < 4; ++i) { const int pi = 16 * kk + 4 * fq + i; const size_t o = (size_t)(g * 16 + fr) * 64 + pi; w[i] = pk2(p.in[11][o], -p.in[12][o]); }
                union { unsigned u[4]; bf16x8 v; } cv; cv.u[0] = w[0]; cv.u[1] = w[1]; cv.u[2] = w[2]; cv.u[3] = w[3]; Cf[kk] = cv.v;
            }
            dsk = p.in[13][g * 16 + fr];
        }
        const size_t tok0 = (size_t)b * SEQL + (size_t)sc * 512;
        const float* ug = U + tok0 * DM + g * 16 + (lane & 3) * 4 + (size_t)(lane >> 2) * DM;
        f32x4 nxt = *(const f32x4*)ug;
        LDS_FENCE();
        *(LAS f32x4*)(ul + lane * 4) = nxt;
        for (int blk = 0; blk < 32; ++blk) {
            const int cur = blk & 1;
            if (blk + 1 < 32) nxt = *(const f32x4*)(ug + (size_t)(blk + 1) * 16 * DM);
            LDS_FENCE();
#pragma unroll 4
            for (int tt = 0; tt < 16; ++tt) {
                float uu[16];
#pragma unroll
                for (int q = 0; q < 4; ++q) { const f32x4 t4 = *(const LAS f32x4*)(ul + cur * 256 + tt * 16 + q * 4); uu[q * 4] = t4[0]; uu[q * 4 + 1] = t4[1]; uu[q * 4 + 2] = t4[2]; uu[q * 4 + 3] = t4[3]; }
                f32x2 b0 = {0.f, 0.f}, b1 = {0.f, 0.f};
#pragma unroll
                for (int h = 0; h < 16; h += 2) { b0 = Bp[h] * (f32x2){uu[h], uu[h]} + b0; b1 = Bp[h + 1] * (f32x2){uu[h + 1], uu[h + 1]} + b1; }
                const f32x2 bs = b0 + b1; const float bre = bs[0], bim = bs[1];
                const float t = are * hre - aim * him + bre; him = are * him + aim * hre + bim; hre = t;
                if (FINAL) S[tt * 68 + lane] = pk2(hre, him);
            }
            if (FINAL) {
                LDS_FENCE();
                f32x4 acc = {0.f, 0.f, 0.f, 0.f};
#pragma unroll
                for (int kk = 0; kk < 4; ++kk) { const bf16x8 af = *(const LAS bf16x8*)(S + fr * 68 + 16 * kk + 4 * fq); acc = __builtin_amdgcn_mfma_f32_16x16x32_bf16(af, Cf[kk], acc, 0, 0, 0); }
#pragma unroll
                for (int i = 0; i < 4; ++i) { const int tl = 4 * fq + i; const float y = acc[i] + dsk * ul[cur * 256 + tl * 16 + fr];
                    const unsigned short hb = (unsigned short)(pk2(gelu_tanh(y), 0.f) & 0xffffu);
                    YG[(tok0 + blk * 16 + tl) * DM + g * 16 + fr] = hb; }
            }
            LDS_FENCE();
            if (blk + 1 < 32) *(LAS f32x4*)(ul + (cur ^ 1) * 256 + lane * 4) = nxt;
        }
        if (!FINAL) *(float2*)(HLOC + ((size_t)un * 64 + lane) * 2) = make_float2(hre, him);
    }
}

constexpr int L1_BROW = 72;
__device__ __forceinline__ void phase_rw_lora1(LAS unsigned char* lds_, const float* X, const bf16_t* Wl, bf16_t* L1) {
    LAS bf16_t* Bs = (LAS bf16_t*)lds_;
    const int tid = otid(), lane = tid & 63, wid = tid >> 6, fr = lane & 15, fq = lane >> 4, mt = wid >> 1, ch = wid & 1;
    const int sn = tid >> 2, sq = tid & 3;
    for (int item = blockIdx.x; item < MTOK / 64; item += gridDim.x) {
        const int row = item * 64 + mt * 16 + fr, t = row & (SEQL - 1);
        const float* xr = X + (size_t)row * DM + fq * 8; const float* xpr = xr - DM;
        f32x4 acc[4];
#pragma unroll
        for (int n = 0; n < 4; ++n) acc[n] = (f32x4){0.f, 0.f, 0.f, 0.f};
        __syncthreads();
        pg8::u32x4 sb[2][2];
#pragma unroll
        for (int pt = 0; pt < 2; ++pt)
#pragma unroll
            for (int h = 0; h < 2; ++h) sb[pt][h] = *(const pg8::u32x4*)(Wl + (size_t)sn * 2048 + pt * 1024 + sq * 16 + h * 8);
        for (int ks = 0; ks < 16; ++ks) {
            const int st = ks & 1;
#pragma unroll
            for (int pt = 0; pt < 2; ++pt)
#pragma unroll
                for (int h = 0; h < 2; ++h) *(LAS pg8::u32x4*)(Bs + ((st * 2 + pt) * 128 + sn) * L1_BROW + sq * 16 + h * 8) = sb[pt][h];
            if (ks + 1 < 16) {
#pragma unroll
                for (int pt = 0; pt < 2; ++pt)
#pragma unroll
                    for (int h = 0; h < 2; ++h) sb[pt][h] = *(const pg8::u32x4*)(Wl + (size_t)sn * 2048 + pt * 1024 + (ks + 1) * 64 + sq * 16 + h * 8);
            }
            BAR_LDS();
#pragma unroll
            for (int k2 = 0; k2 < 2; ++k2) {
                const int k = ks * 64 + k2 * 32;
                const float4 x0 = *(const float4*)(xr + k), x1 = *(const float4*)(xr + k + 4);
                float4 p0 = make_float4(0.f, 0.f, 0.f, 0.f), p1 = p0;
                if (t >= 1) { p0 = *(const float4*)(xpr + k); p1 = *(const float4*)(xpr + k + 4); }
                union { unsigned u[4]; bf16x8 v; } ax, ad;
                ax.u[0] = pk2(x0.x, x0.y); ax.u[1] = pk2(x0.z, x0.w); ax.u[2] = pk2(x1.x, x1.y); ax.u[3] = pk2(x1.z, x1.w);
                ad.u[0] = pk2(p0.x - x0.x, p0.y - x0.y); ad.u[1] = pk2(p0.z - x0.z, p0.w - x0.w); ad.u[2] = pk2(p1.x - x1.x, p1.y - x1.y); ad.u[3] = pk2(p1.z - x1.z, p1.w - x1.w);
#pragma unroll
                for (int n = 0; n < 4; ++n) {
                    const bf16x8 b0 = *(const LAS bf16x8*)(Bs + ((st * 2 + 0) * 128 + ch * 64 + n * 16 + fr) * L1_BROW + k2 * 32 + fq * 8);
                    const bf16x8 b1 = *(const LAS bf16x8*)(Bs + ((st * 2 + 1) * 128 + ch * 64 + n * 16 + fr) * L1_BROW + k2 * 32 + fq * 8);
                    acc[n] = __builtin_amdgcn_mfma_f32_16x16x32_bf16(ax.v, b0, acc[n], 0, 0, 0);
                    acc[n] = __builtin_amdgcn_mfma_f32_16x16x32_bf16(ad.v, b1, acc[n], 0, 0, 0);
                }
            }
        }
        const int row0 = item * 64 + mt * 16;
#pragma unroll
        for (int n = 0; n < 4; ++n)
#pragma unroll
            for (int i = 0; i < 4; ++i) { const int r = row0 + fq * 4 + i, col = ch * 64 + n * 16 + fr;
                const float v = ch == 0 ? tanhf_(acc[n][i]) : acc[n][i];
                L1[(size_t)r * 256 + col] = (bf16_t)(pk2(v, 0.f) & 0xffffu); }
#pragma unroll
        for (int q = 0; q < 2; ++q) { const int idx = q * 64 + lane, r = idx >> 3, c8 = idx & 7;
            *(uint4*)(L1 + (size_t)(row0 + r) * 256 + 128 + ch * 64 + c8 * 8) = make_uint4(0, 0, 0, 0); }
    }
}
__device__ __forceinline__ void phase_rw_prep(const float* X, bf16_t* XS, const float* mua, const float* mub) {
    const size_t nth = (size_t)gridDim.x * 512;
    for (size_t i = (size_t)blockIdx.x * 512 + otid(); i < (size_t)MTOK * 256; i += nth) {
        const int row = (int)(i >> 8), c4 = (int)(i & 255) * 4, t = row & (SEQL - 1);
        const float4 x = *(const float4*)(X + (size_t)row * DM + c4);
        float4 xp = make_float4(0.f, 0.f, 0.f, 0.f); if (t >= 1) xp = *(const float4*)(X + (size_t)(row - 1) * DM + c4);
        const float4 ma = *(const float4*)(mua + c4), mb = *(const float4*)(mub + c4);
        const float d0 = xp.x - x.x, d1 = xp.y - x.y, d2 = xp.z - x.z, d3 = xp.w - x.w;
        *(uint2*)(XS + (size_t)row * DM + c4) = make_uint2(pk2(x.x + d0 * ma.x, x.y + d1 * ma.y), pk2(x.z + d2 * ma.z, x.w + d3 * ma.w));
        *(uint2*)(XS + (size_t)MTOK * DM + (size_t)row * DM + c4) = make_uint2(pk2(x.x + d0 * mb.x, x.y + d1 * mb.y), pk2(x.z + d2 * mb.z, x.w + d3 * mb.w));
    }
}
__device__ __forceinline__ void unpack8(const uint4 v, float* f) { f[0] = bflo(v.x); f[1] = bfhi(v.x); f[2] = bflo(v.y); f[3] = bfhi(v.y); f[4] = bflo(v.z); f[5] = bfhi(v.z); f[6] = bflo(v.w); f[7] = bfhi(v.w); }

constexpr int RW_T = 32, RW_STEP = 336;
constexpr int RW_BUF = RW_T * RW_STEP, RW_OB = RW_T * 16 * 16;
struct RwOp { f32x4 r, w, kp, kk, ka; float v; };
__device__ __forceinline__ void rw_load(RwOp& o, const LAS float* sb, int j0, int rr) {
    o.r = *(const LAS f32x4*)(sb + j0); o.w = *(const LAS f32x4*)(sb + 64 + j0); o.kp = *(const LAS f32x4*)(sb + 128 + j0);
    o.kk = *(const LAS f32x4*)(sb + 192 + j0); o.ka = *(const LAS f32x4*)(sb + 256 + j0); o.v = sb[320 + rr];
}
template <int MODE> __device__ __forceinline__ float rw_step(const RwOp& o, float& s0, float& s1, float& s2, float& s3) {
    const float dsum = fmaf(s0, o.kk[0], s1 * o.kk[1]) + fmaf(s2, o.kk[2], s3 * o.kk[3]);
    const float sa = MODE == 3 ? -dsum : -red16(dsum);
    s0 = fmaf(s0, o.w[0], fmaf(sa, o.ka[0], o.v * o.kp[0])); s1 = fmaf(s1, o.w[1], fmaf(sa, o.ka[1], o.v * o.kp[1]));
    s2 = fmaf(s2, o.w[2], fmaf(sa, o.ka[2], o.v * o.kp[2])); s3 = fmaf(s3, o.w[3], fmaf(sa, o.ka[3], o.v * o.kp[3]));
    return fmaf(s0, o.r[0], s1 * o.r[1]) + fmaf(s2, o.r[2], s3 * o.r[3]);
}
__device__ __forceinline__ void rw_flush(const LAS float* ob, bf16_t* dst) {
    float o2[2];
#pragma unroll
    for (int q = 0; q < 2; ++q) { float a = 0.f;
#pragma unroll
        for (int i = 0; i < 4; ++i) { const f32x4 t = *(const LAS f32x4*)(ob + q * 16 + i * 4); a += (t[0] + t[1]) + (t[2] + t[3]); }
        o2[q] = a; }
    *(unsigned*)dst = pk2(o2[0], o2[1]);
}
template <int MODE> __device__ __forceinline__ void phase_rw_scan(const P& p, LAS unsigned char* lds_, const bf16_t* R, const bf16_t* K, const bf16_t* V, const bf16_t* DW, const bf16_t* DA, bf16_t* OUT) {
    LAS float* buf = (LAS float*)lds_;
    LAS float* obuf = buf + 2 * RW_BUF;
    const int tid = otid(), lane = tid & 63, wid = __builtin_amdgcn_readfirstlane(tid >> 6);
    for (int un = blockIdx.x; un < 256; un += gridDim.x) {
        const int bh = un >> 2, rg = un & 3, b = bh >> 4, h = bh & 15;
        __syncthreads();
        if (wid < 4) {
            const int rr = wid * 4 + (lane >> 4), jl = lane & 15, j0 = jl * 4;
            float s0 = 0.f, s1 = 0.f, s2 = 0.f, s3 = 0.f;
            __builtin_amdgcn_s_setprio(3);
            BAR_LDS();
            for (int c = 0; c < SEQL / RW_T; ++c) {
                const LAS float* cb = buf + (c & 1) * RW_BUF; LAS float* ob = obuf + (c & 1) * RW_OB + rr * 16 + jl;
                if (MODE != 1) {
                RwOp ops[3];
                rw_load(ops[0], cb, j0, rr); rw_load(ops[1], cb + RW_STEP, j0, rr);
#pragma unroll
                for (int s = 0; s < RW_T; ++s) {
                    if (s + 2 < RW_T) rw_load(ops[(s + 2) % 3], cb + (s + 2) * RW_STEP, j0, rr);
                    ob[s * 256] = rw_step<MODE>(ops[s % 3], s0, s1, s2, s3);
                }
                }
                BAR_LDS();
            }
            __builtin_amdgcn_s_setprio(0);
        } else {
            const int pt = tid - 256, s = pt >> 3, part = pt & 7, c0 = part * 8, ch = h * 64 + c0;
            float kk_[8], ka_[8];
#pragma unroll
            for (int i = 0; i < 8; ++i) { kk_[i] = p.in[25][ch + i]; ka_[i] = p.in[26][ch + i]; }
            const size_t rowb = (size_t)b * SEQL + s;
            uint4 qr, qk, qw, qa, qv = make_uint4(0, 0, 0, 0);
            { const size_t o = rowb * DM + ch; qr = *(const uint4*)(R + o); qk = *(const uint4*)(K + o); qw = *(const uint4*)(DW + o); qa = *(const uint4*)(DA + o);
              if (part < 2) qv = *(const uint4*)(V + rowb * DM + h * 64 + rg * 16 + part * 8); }
            for (int c = 0; c <= SEQL / RW_T; ++c) {
                uint4 nr = qr, nk = qk, nw = qw, na = qa, nv = qv;
                if (MODE != 2 && c + 1 < SEQL / RW_T) { const size_t row = rowb + (size_t)(c + 1) * RW_T; const size_t o = row * DM + ch;
                    nr = *(const uint4*)(R + o); nk = *(const uint4*)(K + o); nw = *(const uint4*)(DW + o); na = *(const uint4*)(DA + o);
                    if (part < 2) nv = *(const uint4*)(V + row * DM + h * 64 + rg * 16 + part * 8); }
                if (MODE != 2 && c < SEQL / RW_T) {
                    float r[8], k[8], ew[8], aa[8];
                    unpack8(qr, r); unpack8(qk, k); unpack8(qw, ew); unpack8(qa, aa);
                    float wv[8], kp[8], kk[8], ka[8]; float ss = 0.f;
#pragma unroll
                    for (int i = 0; i < 8; ++i) {
                        wv[i] = __expf(-ew[i]);
                        kk[i] = k[i] * kk_[i]; ss = fmaf(kk[i], kk[i], ss);
                        kp[i] = k[i] * fmaf(aa[i] - 1.0f, ka_[i], 1.0f);
                    }
                    ss = red8(ss); const float inv = rcpf_(fmaxf(__builtin_amdgcn_sqrtf(ss), 1e-12f));
#pragma unroll
                    for (int i = 0; i < 8; ++i) { kk[i] *= inv; ka[i] = kk[i] * aa[i]; }
                    LAS float* sb = buf + (c & 1) * RW_BUF + s * RW_STEP + c0;
                    *(LAS f32x4*)(sb) = (f32x4){r[0], r[1], r[2], r[3]}; *(LAS f32x4*)(sb + 4) = (f32x4){r[4], r[5], r[6], r[7]};
                    *(LAS f32x4*)(sb + 64) = (f32x4){wv[0], wv[1], wv[2], wv[3]}; *(LAS f32x4*)(sb + 68) = (f32x4){wv[4], wv[5], wv[6], wv[7]};
                    *(LAS f32x4*)(sb + 128) = (f32x4){kp[0], kp[1], kp[2], kp[3]}; *(LAS f32x4*)(sb + 132) = (f32x4){kp[4], kp[5], kp[6], kp[7]};
                    *(LAS f32x4*)(sb + 192) = (f32x4){kk[0], kk[1], kk[2], kk[3]}; *(LAS f32x4*)(sb + 196) = (f32x4){kk[4], kk[5], kk[6], kk[7]};
                    *(LAS f32x4*)(sb + 256) = (f32x4){ka[0], ka[1], ka[2], ka[3]}; *(LAS f32x4*)(sb + 260) = (f32x4){ka[4], ka[5], ka[6], ka[7]};
                    if (part < 2) { float v[8]; unpack8(qv, v);
                        LAS float* vb = buf + (c & 1) * RW_BUF + s * RW_STEP + 320 + part * 8;
                        *(LAS f32x4*)(vb) = (f32x4){v[0], v[1], v[2], v[3]}; *(LAS f32x4*)(vb + 4) = (f32x4){v[4], v[5], v[6], v[7]}; }
                }
                if (MODE == 0 && c >= 2) {
                    const int cc = c - 2; const size_t row = (size_t)b * SEQL + (size_t)cc * RW_T + s;
                    rw_flush(obuf + (cc & 1) * RW_OB + s * 256 + part * 32, OUT + row * DM + h * 64 + rg * 16 + part * 2);
                }
                BAR_LDS();
                qr = nr; qk = nk; qw = nw; qa = na; qv = nv;
            }
            if (MODE == 0) {
                const int cc = SEQL / RW_T - 1; const size_t row = (size_t)b * SEQL + (size_t)cc * RW_T + s;
                rw_flush(obuf + (cc & 1) * RW_OB + s * 256 + part * 32, OUT + row * DM + h * 64 + rg * 16 + part * 2);
            }
        }
    }
}


constexpr int RW2_NP = 5, RW2_NS = 8, RW2_SLOT = 11264, RW2_SCR = 12544;
constexpr int SL_P1T = 0, SL_RT = 2304, SL_BPT = 4608, SL_KPT = 6656, SL_AM = 8704, SL_A2 = 9728, SL_VP = 10240, SL_GC = 10752;
constexpr int SC_AT = 0, SC_BT = 2304, SC_KT = 4608, SC_ATT = 6912, SC_L = 9984, SC_NT = 11008, SC_LKA = 11776;
constexpr int RW2_FLG = RW2_NS * RW2_SLOT + RW2_NP * RW2_SCR;
__device__ __forceinline__ float bf_us(unsigned short x) { return __uint_as_float(((unsigned)x) << 16); }
__device__ __forceinline__ unsigned short us_bf(float v) { return (unsigned short)(pk2(v, 0.f) & 0xffffu); }
typedef unsigned u32x2 __attribute__((ext_vector_type(2)));
union Frag8 { unsigned u[4]; bf16x8 v; };

__device__ __forceinline__ void phase_rw_scan2(const P& p, LAS unsigned char* lds_, const bf16_t* R, const bf16_t* K, const bf16_t* V, const bf16_t* EW, const bf16_t* AA, bf16_t* OUT) {
    const int tid = otid(), lane = tid & 63, wid = __builtin_amdgcn_readfirstlane(tid >> 6), fr = lane & 15, fq = lane >> 4;
    volatile LAS unsigned* flags = (volatile LAS unsigned*)(lds_ + RW2_FLG);
    for (int un = blockIdx.x; un < 256; un += gridDim.x) {
        const int bh = un >> 2, rg = un & 3, b = bh >> 4, h = bh & 15;
        __syncthreads();
        if (tid < RW2_NS + 1) flags[tid] = 0u;
        __syncthreads();
        if (wid == 0) {
            f32x4 accS[4];
#pragma unroll
            for (int m = 0; m < 4; ++m) accS[m] = (f32x4){0.f, 0.f, 0.f, 0.f};
            for (int c = 0; c < SEQL / 16; ++c) {
                const int slot = c & (RW2_NS - 1); LAS unsigned char* sl = lds_ + slot * RW2_SLOT;
                while (flags[slot] != (unsigned)(c + 1)) __builtin_amdgcn_s_sleep(1);
                LDS_FENCE();
                Frag8 Bs[2];
#pragma unroll
                for (int k2 = 0; k2 < 2; ++k2) { Bs[k2].u[0] = pk2(accS[2 * k2][0], accS[2 * k2][1]); Bs[k2].u[1] = pk2(accS[2 * k2][2], accS[2 * k2][3]);
                    Bs[k2].u[2] = pk2(accS[2 * k2 + 1][0], accS[2 * k2 + 1][1]); Bs[k2].u[3] = pk2(accS[2 * k2 + 1][2], accS[2 * k2 + 1][3]); }
                Frag8 A1[2], AR[2];
#pragma unroll
                for (int k2 = 0; k2 < 2; ++k2) {
                    const u32x2 x0 = *(const LAS u32x2*)(sl + SL_P1T + (fr * 72 + 32 * k2 + 4 * fq) * 2), x1 = *(const LAS u32x2*)(sl + SL_P1T + (fr * 72 + 32 * k2 + 16 + 4 * fq) * 2);
                    A1[k2].u[0] = x0[0]; A1[k2].u[1] = x0[1]; A1[k2].u[2] = x1[0]; A1[k2].u[3] = x1[1];
                    const u32x2 y0 = *(const LAS u32x2*)(sl + SL_RT + (fr * 72 + 32 * k2 + 4 * fq) * 2), y1 = *(const LAS u32x2*)(sl + SL_RT + (fr * 72 + 32 * k2 + 16 + 4 * fq) * 2);
                    AR[k2].u[0] = y0[0]; AR[k2].u[1] = y0[1]; AR[k2].u[2] = y1[0]; AR[k2].u[3] = y1[1];
                }
                const u32x2 a2 = *(const LAS u32x2*)(sl + SL_A2 + lane * 8), vp = *(const LAS u32x2*)(sl + SL_VP + lane * 8);
                Frag8 AM; { const pg8::u32x4 t4 = *(const LAS pg8::u32x4*)(sl + SL_AM + lane * 16); AM.u[0] = t4[0]; AM.u[1] = t4[1]; AM.u[2] = t4[2]; AM.u[3] = t4[3]; }
                Frag8 A2f, Bv; A2f.u[0] = 0u; A2f.u[1] = 0u; A2f.u[2] = a2[0]; A2f.u[3] = a2[1]; Bv.u[0] = 0u; Bv.u[1] = 0u; Bv.u[2] = vp[0]; Bv.u[3] = vp[1];
                f32x4 accU = {0.f, 0.f, 0.f, 0.f};
                accU = __builtin_amdgcn_mfma_f32_16x16x32_bf16(A1[0].v, Bs[0].v, accU, 0, 0, 0);
                accU = __builtin_amdgcn_mfma_f32_16x16x32_bf16(A1[1].v, Bs[1].v, accU, 0, 0, 0);
                accU = __builtin_amdgcn_mfma_f32_16x16x32_bf16(A2f.v, Bv.v, accU, 0, 0, 0);
                f32x4 accO = {0.f, 0.f, 0.f, 0.f};
                accO = __builtin_amdgcn_mfma_f32_16x16x32_bf16(AR[0].v, Bs[0].v, accO, 0, 0, 0);
                accO = __builtin_amdgcn_mfma_f32_16x16x32_bf16(AR[1].v, Bs[1].v, accO, 0, 0, 0);
                Frag8 Buv; Buv.u[0] = pk2(accU[0], accU[1]); Buv.u[1] = pk2(accU[2], accU[3]); Buv.u[2] = vp[0]; Buv.u[3] = vp[1];
                accO = __builtin_amdgcn_mfma_f32_16x16x32_bf16(AM.v, Buv.v, accO, 0, 0, 0);
#pragma unroll
                for (int m = 0; m < 4; ++m) {
                    const f32x4 gc = *(const LAS f32x4*)(sl + SL_GC + (16 * m + 4 * fq) * 4);
                    const u32x2 bp = *(const LAS u32x2*)(sl + SL_BPT + ((16 * m + fr) * 16 + 4 * fq) * 2), kp = *(const LAS u32x2*)(sl + SL_KPT + ((16 * m + fr) * 16 + 4 * fq) * 2);
                    Frag8 AS; AS.u[0] = bp[0]; AS.u[1] = bp[1]; AS.u[2] = kp[0]; AS.u[3] = kp[1];
                    f32x4 s = accS[m]; s[0] *= gc[0]; s[1] *= gc[1]; s[2] *= gc[2]; s[3] *= gc[3];
                    accS[m] = __builtin_amdgcn_mfma_f32_16x16x32_bf16(AS.v, Buv.v, s, 0, 0, 0);
                }
                LDS_FENCE();
                if (lane == 0) flags[RW2_NS] = (unsigned)(c + 1);
                const size_t row0 = (size_t)b * SEQL + (size_t)c * 16 + 4 * fq;
#pragma unroll
                for (int i = 0; i < 4; ++i) OUT[(row0 + i) * DM + h * 64 + rg * 16 + fr] = us_bf(accO[i]);
            }
        } else if (wid <= RW2_NP) {
            const int pj = wid - 1; LAS unsigned char* sc = lds_ + RW2_NS * RW2_SLOT + pj * RW2_SCR;
            const int ch = h * 64 + lane; const float kkm = p.in[25][ch], kam = p.in[26][ch];
            for (int c = pj; c < SEQL / 16; c += RW2_NP) {
                const int slot = c & (RW2_NS - 1); LAS unsigned char* sl = lds_ + slot * RW2_SLOT;
                const size_t row0 = (size_t)b * SEQL + (size_t)c * 16;
                unsigned short rr[16], kr[16], er[16], ar[16], vq[4];
#pragma unroll
                for (int t = 0; t < 16; ++t) { const size_t o = (row0 + t) * DM + ch; rr[t] = R[o]; kr[t] = K[o]; er[t] = EW[o]; ar[t] = AA[o]; }
#pragma unroll
                for (int i = 0; i < 4; ++i) vq[i] = V[(row0 + 4 * fq + i) * DM + h * 64 + rg * 16 + fr];
                while ((int)flags[RW2_NS] < c - (RW2_NS - 1)) __builtin_amdgcn_s_sleep(2);
                LDS_FENCE();
                float kf[16], n2[16];
#pragma unroll
                for (int t = 0; t < 16; ++t) { kf[t] = bf_us(kr[t]); const float x = kf[t] * kkm; n2[t] = x * x; }
#pragma unroll
                for (int t = 0; t < 16; ++t) n2[t] = red16(n2[t]);
#pragma unroll
                for (int t = 0; t < 16; ++t) n2[t] += __shfl_xor(n2[t], 16);
#pragma unroll
                for (int t = 0; t < 16; ++t) n2[t] += __shfl_xor(n2[t], 32);
                float at[16], bt[16], kt[16]; float g = 1.0f;
#pragma unroll
                for (int t = 0; t < 16; ++t) {
                    const float w = __expf(-bf_us(er[t])), a = bf_us(ar[t]);
                    const float kk = kf[t] * kkm * __builtin_amdgcn_rsqf(fmaxf(n2[t], 1e-24f));
                    const float kp = kf[t] * (1.0f + (a - 1.0f) * kam), kka = kk * a;
                    const float gp = g; g *= w; const float ig = rcpf_(g);
                    at[t] = -kk * gp; bt[t] = kka * ig; kt[t] = kp * ig;
                    *(LAS unsigned short*)(sc + SC_AT + (t * 72 + lane) * 2) = us_bf(at[t]);
                    *(LAS unsigned short*)(sc + SC_BT + (t * 72 + lane) * 2) = us_bf(bt[t]);
                    *(LAS unsigned short*)(sc + SC_KT + (t * 72 + lane) * 2) = us_bf(kt[t]);
                    *(LAS unsigned short*)(sl + SL_RT + (t * 72 + lane) * 2) = us_bf(bf_us(rr[t]) * g);
                }
                {
                    pg8::u32x4 q0, q1;
#pragma unroll
                    for (int i = 0; i < 4; ++i) { q0[i] = pk2(bt[2 * i] * g, bt[2 * i + 1] * g); q1[i] = pk2(bt[8 + 2 * i] * g, bt[8 + 2 * i + 1] * g); }
                    *(LAS pg8::u32x4*)(sl + SL_BPT + lane * 32) = q0; *(LAS pg8::u32x4*)(sl + SL_BPT + lane * 32 + 16) = q1;
#pragma unroll
                    for (int i = 0; i < 4; ++i) { q0[i] = pk2(kt[2 * i] * g, kt[2 * i + 1] * g); q1[i] = pk2(kt[8 + 2 * i] * g, kt[8 + 2 * i + 1] * g); }
                    *(LAS pg8::u32x4*)(sl + SL_KPT + lane * 32) = q0; *(LAS pg8::u32x4*)(sl + SL_KPT + lane * 32 + 16) = q1;
#pragma unroll
                    for (int i = 0; i < 4; ++i) { q0[i] = pk2(at[2 * i], at[2 * i + 1]); q1[i] = pk2(at[8 + 2 * i], at[8 + 2 * i + 1]); }
                    *(LAS pg8::u32x4*)(sc + SC_ATT + lane * 48) = q0; *(LAS pg8::u32x4*)(sc + SC_ATT + lane * 48 + 16) = q1;
                    *(LAS float*)(sl + SL_GC + lane * 4) = g;
                    *(LAS u32x2*)(sl + SL_VP + lane * 8) = (u32x2){(unsigned)vq[0] | ((unsigned)vq[1] << 16), (unsigned)vq[2] | ((unsigned)vq[3] << 16)};
                }
                LDS_FENCE();
                f32x4 gba = {0.f, 0.f, 0.f, 0.f}, gka = gba, gbr = gba, gkr = gba;
#pragma unroll
                for (int k2 = 0; k2 < 2; ++k2) {
                    const int off = (fr * 72 + 32 * k2 + 8 * fq) * 2;
                    const bf16x8 fb = *(const LAS bf16x8*)(sc + SC_BT + off), fk = *(const LAS bf16x8*)(sc + SC_KT + off), fa = *(const LAS bf16x8*)(sc + SC_AT + off), frt = *(const LAS bf16x8*)(sl + SL_RT + off);
                    gba = __builtin_amdgcn_mfma_f32_16x16x32_bf16(fb, fa, gba, 0, 0, 0); gka = __builtin_amdgcn_mfma_f32_16x16x32_bf16(fk, fa, gka, 0, 0, 0);
                    gbr = __builtin_amdgcn_mfma_f32_16x16x32_bf16(fb, frt, gbr, 0, 0, 0); gkr = __builtin_amdgcn_mfma_f32_16x16x32_bf16(fk, frt, gkr, 0, 0, 0);
                }
                {
                    Frag8 am;
#pragma unroll
                    for (int i = 0; i < 4; ++i) { const int ii = 4 * fq + i; const bool st = ii < fr, le = ii <= fr;
                        *(LAS float*)(sc + SC_L + (ii * 16 + fr) * 4) = st ? gba[i] : 0.f;
                        *(LAS unsigned short*)(sc + SC_LKA + (ii * 24 + fr) * 2) = us_bf(st ? gka[i] : 0.f);
                        gbr[i] = le ? gbr[i] : 0.f; gkr[i] = le ? gkr[i] : 0.f; }
                    am.u[0] = pk2(gbr[0], gbr[1]); am.u[1] = pk2(gbr[2], gbr[3]); am.u[2] = pk2(gkr[0], gkr[1]); am.u[3] = pk2(gkr[2], gkr[3]);
                    pg8::u32x4 t4; t4[0] = am.u[0]; t4[1] = am.u[1]; t4[2] = am.u[2]; t4[3] = am.u[3];
                    *(LAS pg8::u32x4*)(sl + SL_AM + lane * 16) = t4;
                }
                LDS_FENCE();
                float n[16];
#pragma unroll
                for (int j = 0; j < 16; ++j) n[j] = (fr == j) ? 1.0f : 0.f;
#pragma unroll
                for (int i = 14; i >= 0; --i) {
                    float Lr[16];
#pragma unroll
                    for (int q = 0; q < 4; ++q) { const f32x4 t4 = *(const LAS f32x4*)(sc + SC_L + (i * 16 + q * 4) * 4); Lr[q * 4] = t4[0]; Lr[q * 4 + 1] = t4[1]; Lr[q * 4 + 2] = t4[2]; Lr[q * 4 + 3] = t4[3]; }
                    float a = n[i];
#pragma unroll
                    for (int j = i + 1; j < 16; ++j) a = fmaf(Lr[j], n[j], a);
                    n[i] = a;
                }
                {
                    pg8::u32x4 q0, q1;
#pragma unroll
                    for (int i = 0; i < 4; ++i) { q0[i] = pk2(n[2 * i], n[2 * i + 1]); q1[i] = pk2(n[8 + 2 * i], n[8 + 2 * i + 1]); }
                    if (fq == 0) { *(LAS pg8::u32x4*)(sc + SC_NT + fr * 48) = q0; *(LAS pg8::u32x4*)(sc + SC_NT + fr * 48 + 16) = q1; }
                }
                LDS_FENCE();
                const bf16x8 z8 = {0, 0, 0, 0, 0, 0, 0, 0};
                const bf16x8 fnt = fq < 2 ? *(const LAS bf16x8*)(sc + SC_NT + fr * 48 + fq * 16) : z8;
                const bf16x8 flk = fq < 2 ? *(const LAS bf16x8*)(sc + SC_LKA + fr * 48 + fq * 16) : z8;
                f32x4 z4 = {0.f, 0.f, 0.f, 0.f};
                const f32x4 d2 = __builtin_amdgcn_mfma_f32_16x16x32_bf16(flk, fnt, z4, 0, 0, 0);
                *(LAS u32x2*)(sl + SL_A2 + lane * 8) = (u32x2){pk2(d2[0], d2[1]), pk2(d2[2], d2[3])};
#pragma unroll
                for (int tl = 0; tl < 4; ++tl) {
                    const bf16x8 fat = fq < 2 ? *(const LAS bf16x8*)(sc + SC_ATT + (16 * tl + fr) * 48 + fq * 16) : z8;
                    const f32x4 d = __builtin_amdgcn_mfma_f32_16x16x32_bf16(fnt, fat, z4, 0, 0, 0);
#pragma unroll
                    for (int i = 0; i < 4; ++i) *(LAS unsigned short*)(sl + SL_P1T + ((4 * fq + i) * 72 + 16 * tl + fr) * 2) = us_bf(d[i]);
                }
                LDS_FENCE();
                if (lane == 0) flags[slot] = (unsigned)(c + 1);
            }
        }
    }
}

__device__ __forceinline__ void phase_rw_post(const P& p, const bf16_t* OUT, const bf16_t* R, const bf16_t* K, const bf16_t* V, const bf16_t* DA, const bf16_t* SZ, bf16_t* OF) {
    const size_t nth = (size_t)gridDim.x * 512;
    for (size_t it = (size_t)blockIdx.x * 512 + otid(); it < (size_t)MTOK * 128; it += nth) {
        const int c0 = (int)(it & 127) * 8; const size_t o = (it >> 7) * DM + c0;
        float ov[8], r[8], k[8], v[8], da[8], sz[8];
        unpack8(*(const uint4*)(OUT + o), ov); unpack8(*(const uint4*)(R + o), r); unpack8(*(const uint4*)(K + o), k); unpack8(*(const uint4*)(V + o), v);
        unpack8(*(const uint4*)(DA + o), da); unpack8(*(const uint4*)(SZ + o), sz);
        float sm = 0.f, dot = 0.f;
#pragma unroll
        for (int i = 0; i < 8; ++i) { const float a = da[i]; const float kp = k[i] * (1.0f + (a - 1.0f) * p.in[26][c0 + i]);
            dot += r[i] * kp * p.in[27][c0 + i]; sm += ov[i]; }
        dot = red8(dot); const float mean = red8(sm) * (1.0f / 64.0f);
        float q = 0.f;
#pragma unroll
        for (int i = 0; i < 8; ++i) { ov[i] -= mean; q += ov[i] * ov[i]; }
        const float rs = rsqrtf(red8(q) * (1.0f / 64.0f) + 64e-5f);
        float y[8];
#pragma unroll
        for (int i = 0; i < 8; ++i) y[i] = (ov[i] * rs * p.in[28][c0 + i] + p.in[29][c0 + i] + dot * v[i]) * sz[i];
        *(uint4*)(OF + o) = make_uint4(pk2(y[0], y[1]), pk2(y[2], y[3]), pk2(y[4], y[5]), pk2(y[6], y[7]));
    }
}

__global__ void __launch_bounds__(512, 2) fwd_mega(P p) {
    extern __shared__ __attribute__((aligned(16))) unsigned char shm[];
    LAS unsigned char* lds = (LAS unsigned char*)shm;
    LAS float* tile = (LAS float*)shm;
    cg::grid_group grid = cg::this_grid();
    volatile LAS unsigned* xst = (volatile LAS unsigned*)(lds + LDS_XST);
    if (threadIdx.x == 0) { xst[0] = 0u; xst[1] = 0u; }
    __syncthreads();
    const XcdBarrier xb = xcd_barrier_post((unsigned*)(p.ws + BAR_OFF), xst);
    unsigned char* ws = p.ws; float* X = p.out;
    bf16_t* act = (bf16_t*)(ws + ACT); bf16_t* pb = (bf16_t*)(ws + PB);
    phase_prep(p, tile);
    grid.sync();
    for (int d = 0; d < DUP_PREP; ++d) { phase_prep(p, tile); xcd_barrier(xb); }
    for (int d = 0; d < DUP_SYNC; ++d) xcd_barrier(xb);
#define LAYER_TAIL(L, Aout, Wout, Wpe, Wpg, PEB) \
    { EpiWout E; E.X = X; E.RB = act; run_gemm(lds, Aout, Wout, 1024, 1024, E); } \
    { EpiBf16 E; E.O = PEB; E.ldo = 1024; E.split = 1 << 20; E.stride = 0; run_gemm(lds, pb, Wpe, 1024, 256, E); } \
    xcd_barrier(xb); \
    { EpiPle E; E.X = X; E.PE = PEB; run_gemm(lds, act, Wpg, 1024, 1024, E); } \
    xcd_barrier(xb); \
    phase_ln(X, act, p.in[33] + (L) * 1024, p.in[34] + (L) * 1024);
#define CONV_LAYER(L, j) { \
        bf16_t* U = (bf16_t*)(ws + T0); bf16_t* G = (bf16_t*)(ws + T0 + 32 * MiB); \
        { EpiConvIn E; E.U = U; E.G = G; run_gemm(lds, act, (const bf16_t*)(ws + W_CIN), 4096, 1024, E); } \
        xcd_barrier(xb); \
        phase_conv_ew(U, G, p.in[3] + (size_t)(j) * 3 * 1024); \
        if ((L) > 0) cvt_pb(p.in[1] + (size_t)(L) * MTOK * 256, pb); \
        xcd_barrier(xb); \
        LAYER_TAIL(L, G, (const bf16_t*)(ws + W_COUT), (const bf16_t*)(ws + W_PEC), (const bf16_t*)(ws + W_PGC), (bf16_t*)(ws + T0 + 64 * MiB)) }
    CONV_LAYER(0, 0)
    xcd_barrier(xb);
    {
        float* U = (float*)(ws + T0); bf16_t* SZ = (bf16_t*)(ws + T0 + 64 * MiB); bf16_t* YG = (bf16_t*)(ws + T0 + 96 * MiB); bf16_t* V = (bf16_t*)(ws + T0 + 128 * MiB);
        float* HL = (float*)(ws + T0 + 160 * MiB);
        { EpiSsmIn E; E.U = U; E.SZ = SZ; run_gemm(lds, act, (const bf16_t*)(ws + W_SIN), 2048, 1024, E); }
        xcd_barrier(xb);
        phase_s5<0>(p, lds, U, HL, YG);
        cvt_pb(p.in[1] + (size_t)1 * MTOK * 256, pb);
        xcd_barrier(xb);
        phase_s5<1>(p, lds, U, HL, YG);
        xcd_barrier(xb);
        for (int d = 0; d < DUP_S5; ++d) { phase_s5<0>(p, lds, U, HL, YG); xcd_barrier(xb); phase_s5<1>(p, lds, U, HL, YG); xcd_barrier(xb); }
        { EpiGlu E; E.YG = YG; E.SZ = SZ; E.bias = p.in[15]; E.V = V; run_gemm(lds, YG, (const bf16_t*)(ws + W_SGLU), 1024, 1024, E); }
        xcd_barrier(xb);
        LAYER_TAIL(1, V, (const bf16_t*)(ws + W_SOUT), (const bf16_t*)(ws + W_PE1), (const bf16_t*)(ws + W_PG1), (bf16_t*)(ws + T0))
    }
    xcd_barrier(xb);
    {
        bf16_t* XS = (bf16_t*)(ws + T0); bf16_t* RKV = (bf16_t*)(ws + T0 + 64 * MiB);
        bf16_t* Rb = RKV; bf16_t* Kb = RKV + (size_t)MTOK * DM; bf16_t* Vb = RKV + (size_t)2 * MTOK * DM;
        bf16_t* SZ = act; bf16_t* L1 = pb; bf16_t* DW = (bf16_t*)(ws + T0); bf16_t* DA = (bf16_t*)(ws + T0 + 32 * MiB);
        bf16_t* OUT = (bf16_t*)(ws + OUT_RW); bf16_t* OF = (bf16_t*)(ws + T0);
        const bf16_t* Wrk = (const bf16_t*)(ws + W_RK);
        phase_rw_prep(X, XS, p.in[17], p.in[17] + 1024);
        xcd_barrier(xb);
        { EpiBf16 E; E.O = Rb; E.ldo = 1024; E.split = 1 << 20; E.stride = 0; run_gemm(lds, XS, Wrk, 1024, 1024, E); }
        { EpiBf16 E; E.O = Kb; E.ldo = 1024; E.split = 1 << 20; E.stride = 0; run_gemm(lds, XS + (size_t)MTOK * DM, Wrk + (size_t)1024 * 1024, 1024, 1024, E); }
        phase_rw_lora1(lds, X, Wrk + (size_t)4096 * 1024, L1);
        xcd_barrier(xb);
        phase_rw_prep(X, XS, p.in[17] + 2 * 1024, p.in[17] + 3 * 1024);
        xcd_barrier(xb);
        { EpiBf16 E; E.O = Vb; E.ldo = 1024; E.split = 1 << 20; E.stride = 0; run_gemm(lds, XS, Wrk + (size_t)2 * 1024 * 1024, 1024, 1024, E); }
        { EpiBf16T<1> E; E.O = SZ; E.ldo = 1024; E.split = 1 << 20; E.stride = 0; run_gemm(lds, XS + (size_t)MTOK * DM, Wrk + (size_t)3 * 1024 * 1024, 1024, 1024, E); }
        xcd_barrier(xb);
        { EpiLora2 E; E.EW = DW; E.AA = DA; E.w0 = p.in[19]; E.a0 = p.in[22]; run_gemm(lds, L1, (const bf16_t*)(ws + W_L2), 2048, 256, E); }
        xcd_barrier(xb);
        phase_rw_scan2(p, lds, Rb, Kb, Vb, DW, DA, OUT);
        xcd_barrier(xb);
        for (int d = 0; d < DUP_RWSCAN; ++d) { phase_rw_scan<DUP_MODE>(p, lds, Rb, Kb, Vb, DW, DA, OUT); xcd_barrier(xb); }
        phase_rw_post(p, OUT, Rb, Kb, Vb, DA, SZ, OF);
        for (int d = 0; d < DUP_EW; ++d) { xcd_barrier(xb); phase_rw_post(p, OUT, Rb, Kb, Vb, DA, SZ, OF); }
        cvt_pb(p.in[1] + (size_t)2 * MTOK * 256, pb);
        xcd_barrier(xb);
        LAYER_TAIL(2, OF, (const bf16_t*)(ws + W_ROUT), (const bf16_t*)(ws + W_PE2), (const bf16_t*)(ws + W_PG2), (bf16_t*)(ws + T0 + 32 * MiB))
        __syncthreads();
        conv_layer_weights(p, tile, 1, 3);
    }
    xcd_barrier(xb);
    CONV_LAYER(3, 1)
}

extern "C" void kernel_launch(void* const* d_in, const int* in_sizes, int n_in, void* d_out, int out_size, void* d_ws, size_t ws_size, hipStream_t stream) {
    static int grid_blocks = 0;
    if (!grid_blocks) {
        int dev = 0, cus = 0, per_cu = 0;
        hipGetDevice(&dev);
        hipDeviceGetAttribute(&cus, hipDeviceAttributeMultiprocessorCount, dev);
        hipFuncSetAttribute((const void*)fwd_mega, hipFuncAttributeMaxDynamicSharedMemorySize, LDS_BYTES);
        hipOccupancyMaxActiveBlocksPerMultiprocessor(&per_cu, (const void*)fwd_mega, 512, LDS_BYTES);
        if (per_cu < 1) { fprintf(stderr, "occupancy query returned %d\n", per_cu); per_cu = 1; }
        grid_blocks = cus;
        if (ws_size < 256 * MiB) fprintf(stderr, "workspace too small: %zu\n", ws_size);
    }
    P p{};
    for (int i = 0; i < 35; ++i) p.in[i] = (const float*)d_in[i];
    p.out = (float*)d_out; p.ws = (unsigned char*)d_ws;
    hipMemsetAsync((unsigned char*)d_ws + BAR_OFF, 0, XCD_BAR_WORDS * sizeof(unsigned), stream);
    void* args[] = {&p};
    hipError_t e = hipLaunchCooperativeKernel((const void*)fwd_mega, dim3(grid_blocks), dim3(512), args, LDS_BYTES, stream);
    if (e != hipSuccess) fprintf(stderr, "cooperative launch failed: %s (grid %d)\n", hipGetErrorString(e), grid_blocks);
}
```

```cpp
#include <hip/hip_runtime.h>
#include <hip/hip_cooperative_groups.h>
#include <cstdio>
namespace cg = cooperative_groups;
namespace pg8 {
#define PG8_LAS __attribute__((address_space(3)))
typedef unsigned short bf16_t;
typedef short bf16x8 __attribute__((ext_vector_type(8)));
typedef float f32x4 __attribute__((ext_vector_type(4)));
typedef unsigned u32x4 __attribute__((ext_vector_type(4)));
constexpr int BM = 256, BK = 64, HALF = 128, HTB = HALF * BK * 2  , STAGE_BYTES = 8 * HTB, NXCD = 8, WGM = 8;

__host__ __device__ __forceinline__ int lds_byte(int r, int c) { const int st = (r >> 4) * 2 + (c >> 5), rr = r & 15, cc = c & 31, ob = rr * 64 + cc * 2; return st * 1024 + (ob ^ (((ob >> 9) & 1) << 5)); }
__host__ __device__ __forceinline__ void stage_rc(int b, int& R, int& C) { const int st = b / 1024, sb = b % 1024, swz = sb ^ (((sb >> 9) & 1) << 5); R = (st >> 1) * 16 + swz / 64; C = (st & 1) * 32 + (swz % 64) / 2; }
__host__ __device__ __forceinline__ int perm32(int rho) { const int n = rho >> 4, i = rho & 15; return 8 * (i >> 2) + 4 * n + (i & 3); }

struct Unit { int pm, pn; };
struct Gemm { const bf16_t* A; const bf16_t* Bt; int M, N, K; };
struct StaticOrder {
    int nM, nN, nwg, G, c;
    __host__ __device__ void init(int M, int N, int G_, int c_) { nM = M / BM; nN = N / BM; nwg = nM * nN; G = G_; c = c_; }
    __host__ __device__ bool next(int i, Unit& u) const {
        const long L = (long)i * G + c; if (L >= nwg) return false;
        int wgid = (int)L; { const int q = nwg / NXCD, r = nwg % NXCD, xcd = wgid % NXCD, off = wgid / NXCD; wgid = (xcd < r ? xcd * (q + 1) : r * (q + 1) + (xcd - r) * q) + off; }
        const int nig = WGM * nN, gid = wgid / nig, fm = gid * WGM, gsz = (nM - fm) < WGM ? (nM - fm) : WGM;
        u.pm = fm + ((wgid % nig) % gsz); u.pn = (wgid % nig) / gsz; return true;
    }
    __device__ __forceinline__ void a_ready(const Unit&) const {}
    __device__ __forceinline__ void done(const Unit&) const {}
};
__device__ __forceinline__ unsigned cvt_pk_bf16(float lo, float hi) { unsigned r; asm volatile("v_cvt_pk_bf16_f32 %0, %1, %2" : "=v"(r) : "v"(lo), "v"(hi)); return r; }
template <class Epi, class Sched, bool STAMP = false>
__device__ __forceinline__ void gemm_phase(PG8_LAS unsigned char* lds, const Gemm g, const Sched& S, const Epi& E, unsigned long long* stamps) {
    int tid_o = threadIdx.x; asm volatile("" : "+v"(tid_o)); const int tid = tid_o, wid = __builtin_amdgcn_readfirstlane(tid >> 6), lane = tid & 63, wr = wid >> 2, wc = wid & 3, fr = lane & 15, fq = lane >> 4;
    const int K = g.K, nt = K / BK;
    int ts_lo = 0, ts_hi = 0, nts = 0; const unsigned long long rt_entry = STAMP ? (unsigned long long)wall_clock64() : 0ull;
#define PG8_STAMP() do { if (STAMP && wid == 0 && nts < 64) { const unsigned long long _c = (unsigned long long)clock64(); \
        ts_lo = (lane == nts) ? (int)(unsigned)_c : ts_lo; ts_hi = (lane == nts) ? (int)(unsigned)(_c >> 32) : ts_hi; ++nts; } } while (0)
    PG8_STAMP();
    unsigned voffA[2], voffB[2];
#pragma unroll
    for (int i = 0; i < 2; ++i) { int R, C; stage_rc(tid * 16 + i * 8192, R, C); const int Rb = Epi::PERM ? ((R & ~31) + perm32(R & 31)) : R;
        voffA[i] = (unsigned)(R * K + C) * 2u; voffB[i] = (unsigned)(Rb * K + C) * 2u; }
    const size_t kstep = (size_t)(BK * 2);
    const size_t hstep = (size_t)HALF * K * 2;
    const size_t tstep = 2 * hstep;
    const unsigned ldsw = (unsigned)wid * 1024u;
    const int aoff = lds_byte(wr * 64 + fr, fq * 8), boff = lds_byte(wc * 32 + fr, fq * 8);
#define PG8_SA(b, h) (((b) * 2 + (h)) * HTB)
#define PG8_SB(b, h) ((4 + (b) * 2 + (h)) * HTB)
#define PG8_STAGE(bufoff, gbase, voff) do { _Pragma("unroll") for (int _i = 0; _i < 2; ++_i) \
        __builtin_amdgcn_global_load_lds((const unsigned*)((const char*)(gbase) + (voff)[_i]), (PG8_LAS unsigned*)(lds + (bufoff) + ldsw + _i * 8192), 16, 0, 0); } while (0)
#define PG8_LDA(dst, b, h) do { _Pragma("unroll") for (int m = 0; m < 4; ++m) _Pragma("unroll") for (int k = 0; k < 2; ++k) dst[m][k] = *(const PG8_LAS bf16x8*)(lds + PG8_SA(b, h) + aoff + m * 2048 + k * 1024); } while (0)
#define PG8_LDB(dst, b, h) do { _Pragma("unroll") for (int n = 0; n < 2; ++n) _Pragma("unroll") for (int k = 0; k < 2; ++k) dst[n][k] = *(const PG8_LAS bf16x8*)(lds + PG8_SB(b, h) + boff + n * 2048 + k * 1024); } while (0)
#define PG8_MMA(ai, bj, At, Bt) do { __builtin_amdgcn_s_setprio(1); _Pragma("unroll") for (int m = 0; m < 4; ++m) _Pragma("unroll") for (int n = 0; n < 2; ++n) _Pragma("unroll") for (int k = 0; k < 2; ++k) \
        acc[ai][bj][m][n] = __builtin_amdgcn_mfma_f32_16x16x32_bf16(Bt[n][k], At[m][k], acc[ai][bj][m][n], 0, 0, 0); __builtin_amdgcn_s_setprio(0); } while (0)
#define PG8_WAIT_V(n) asm volatile("s_waitcnt vmcnt(" #n ")" ::: "memory")
#define PG8_WAIT_L(n) asm volatile("s_waitcnt lgkmcnt(" #n ")" ::: "memory")
#define PG8_BAR __builtin_amdgcn_s_barrier()
#define PG8_SCHED __builtin_amdgcn_sched_barrier(0)
    Unit cur, nxt; int ui = 0;
    if (!S.next(0, cur)) return;
    f32x4 acc[2][2][4][2];
#pragma unroll
    for (int a = 0; a < 2; ++a)
#pragma unroll
        for (int b = 0; b < 2; ++b)
#pragma unroll
            for (int m = 0; m < 4; ++m)
#pragma unroll
                for (int n = 0; n < 2; ++n) acc[a][b][m][n] = (f32x4){0.f, 0.f, 0.f, 0.f};
    bf16x8 At[4][2], B0[2][2], B1[2][2];
    const char* cA = (const char*)g.A + (size_t)cur.pm * tstep; const char* cB = (const char*)g.Bt + (size_t)cur.pn * tstep;
    S.a_ready(cur);
    PG8_STAGE(PG8_SB(0, 0), cB, voffB); PG8_STAGE(PG8_SA(0, 0), cA, voffA); PG8_STAGE(PG8_SB(0, 1), cB + hstep, voffB); PG8_STAGE(PG8_SA(0, 1), cA + hstep, voffA);
    if (wr == 1) PG8_BAR;
    PG8_WAIT_V(4); PG8_BAR;
    PG8_STAGE(PG8_SB(1, 0), cB + kstep, voffB); PG8_STAGE(PG8_SA(1, 0), cA + kstep, voffA); PG8_STAGE(PG8_SB(1, 1), cB + hstep + kstep, voffB);
    PG8_WAIT_V(6); PG8_BAR;
    PG8_STAMP();
    for (;;) {
        const bool has_next = S.next(ui + 1, nxt);
        const char* nA = has_next ? (const char*)g.A + (size_t)nxt.pm * tstep : cA; const char* nB = has_next ? (const char*)g.Bt + (size_t)nxt.pn * tstep : cB;
        for (int t = 0; t < nt; t += 2) {
            const bool last = (t == nt - 2);
            const char* a1 = cA + (size_t)(t + 1) * kstep;
            const char* a2 = last ? nA : cA + (size_t)(t + 2) * kstep; const char* b2 = last ? nB : cB + (size_t)(t + 2) * kstep;
            const char* a3 = a2 + kstep; const char* b3 = b2 + kstep;
            if (last && has_next) S.a_ready(nxt);
            PG8_LDB(B0, 0, 0); PG8_SCHED; PG8_LDA(At, 0, 0); PG8_STAGE(PG8_SA(1, 1), a1 + hstep, voffA);
            PG8_WAIT_L(8); PG8_BAR; PG8_WAIT_L(0); PG8_MMA(0, 0, At, B0); PG8_BAR; PG8_SCHED;
            PG8_LDB(B1, 0, 1); PG8_STAGE(PG8_SB(0, 0), b2, voffB);
            PG8_BAR; PG8_WAIT_L(0); PG8_MMA(0, 1, At, B1); PG8_BAR;
            PG8_LDA(At, 0, 1); PG8_STAGE(PG8_SA(0, 0), a2, voffA);
            PG8_BAR; PG8_WAIT_L(0); PG8_MMA(1, 0, At, B0); PG8_BAR; PG8_SCHED;
            PG8_STAGE(PG8_SB(0, 1), b2 + hstep, voffB);
            PG8_WAIT_V(6); PG8_BAR; PG8_MMA(1, 1, At, B1); PG8_BAR;
            PG8_LDB(B0, 1, 0); PG8_SCHED; PG8_LDA(At, 1, 0); PG8_STAGE(PG8_SA(0, 1), a2 + hstep, voffA);
            PG8_WAIT_L(8); PG8_BAR; PG8_WAIT_L(0); PG8_MMA(0, 0, At, B0); PG8_BAR; PG8_SCHED;
            PG8_LDB(B1, 1, 1); PG8_STAGE(PG8_SB(1, 0), b3, voffB);
            PG8_BAR; PG8_WAIT_L(0); PG8_MMA(0, 1, At, B1); PG8_BAR;
            PG8_LDA(At, 1, 1); PG8_STAGE(PG8_SA(1, 0), a3, voffA);
            PG8_BAR; PG8_WAIT_L(0); PG8_MMA(1, 0, At, B0); PG8_BAR; PG8_SCHED;
            PG8_STAGE(PG8_SB(1, 1), b3 + hstep, voffB);
            PG8_WAIT_V(6); PG8_BAR; PG8_MMA(1, 1, At, B1); PG8_BAR;
        }
        PG8_STAMP();
        if constexpr (!Epi::AFTER_DRAIN) { E(acc, cur, wr, wc, fr, fq); S.done(cur); }
        PG8_STAMP();
        if (!has_next) break;
#pragma unroll
        for (int a = 0; a < 2; ++a)
#pragma unroll
            for (int b = 0; b < 2; ++b)
#pragma unroll
                for (int m = 0; m < 4; ++m)
#pragma unroll
                    for (int n = 0; n < 2; ++n) acc[a][b][m][n] = (f32x4){0.f, 0.f, 0.f, 0.f};
        cur = nxt; cA = nA; cB = nB; ++ui;
    }
    PG8_WAIT_V(0);
    if (wr == 0) PG8_BAR;
    PG8_BAR;
    if constexpr (Epi::AFTER_DRAIN) { E.fused(acc, cur, wr, wc, fr, fq, lds, wid, lane); S.done(cur); }
    PG8_STAMP();
    if (STAMP && wid == 0) { stamps[lane] = lane < nts ? (((unsigned long long)(unsigned)ts_hi << 32) | (unsigned)ts_lo) : 0ull;
        if (lane == 62) stamps[62] = rt_entry; if (lane == 63) stamps[63] = (unsigned long long)wall_clock64(); }
#undef PG8_STAMP
#undef PG8_SA
#undef PG8_SB
#undef PG8_STAGE
#undef PG8_LDA
#undef PG8_LDB
#undef PG8_MMA
#undef PG8_WAIT_V
#undef PG8_WAIT_L
#undef PG8_BAR
#undef PG8_SCHED
}
}
using pg8::bf16_t; using pg8::bf16x8; using pg8::f32x4; using pg8::Unit; using pg8::Gemm; using pg8::StaticOrder;
#define LAS __attribute__((address_space(3)))
constexpr int MTOK = 16384, DM = 1024, SEQL = 4096;
constexpr size_t MiB = 1u << 20, KiB = 1u << 10;
constexpr float DN_ALPHA = 1.6817928305074290f;
constexpr size_t W_CIN = 0, W_COUT = 8 * MiB, W_PEC = 10 * MiB, W_PGC = 10 * MiB + 512 * KiB;
constexpr size_t W_SIN = 12 * MiB + 512 * KiB, W_SGLU = 16 * MiB + 512 * KiB, W_SOUT = 18 * MiB + 512 * KiB, W_PE1 = 20 * MiB + 512 * KiB, W_PG1 = 21 * MiB;
constexpr size_t W_RK = 23 * MiB, W_L2 = 40 * MiB, W_ROUT = 41 * MiB, W_PE2 = 43 * MiB, W_PG2 = 43 * MiB + 512 * KiB;
constexpr size_t OUT_RW = 0, PB = 46 * MiB, ACT = 54 * MiB, T0 = 86 * MiB;
constexpr int LDS_XST = 155648;
constexpr int LDS_BYTES = LDS_XST + 16;
#ifndef DUP_PREP
#define DUP_PREP 0
#define DUP_RWSCAN 0
#define DUP_S5 0
#define DUP_RK 0
#define DUP_SYNC 0
#define DUP_EW 0
#endif
#ifndef DUP_MODE
#define DUP_MODE 0
#endif

struct P { const float* in[35]; float* out; unsigned char* ws; };
#define XB_TMO      128
#define XB_XCNT(j)  (256  + 64 * (j))
#define XB_XSUB(j)  (1280 + 64 * (j))
#define XB_XGEN(j)  (2304 + 64 * (j))
#define XB_TOP      3328
#define XB_TOPGEN   3392
#define XCD_BAR_WORDS 3456
#define XB_SPIN_CAP (1u << 18)

__device__ __forceinline__ unsigned xb_ld(unsigned* p)              { return __hip_atomic_load(p, __ATOMIC_RELAXED, __HIP_MEMORY_SCOPE_AGENT); }
__device__ __forceinline__ unsigned xb_add(unsigned* p, unsigned v) { return __hip_atomic_fetch_add(p, v, __ATOMIC_RELAXED, __HIP_MEMORY_SCOPE_AGENT); }
__device__ __forceinline__ unsigned xb_xcc_id() { return (unsigned)__builtin_amdgcn_s_getreg((3 << 11) | 20) & 0xFu; }
#define XB_SPIN(cond, bar) do { unsigned _sp = 0; while (cond) { __builtin_amdgcn_s_sleep(1); \
    if ((++_sp & 255u) == 0u) { if (xb_ld(&(bar)[XB_TMO])) break; if (_sp > XB_SPIN_CAP) { atomicAdd(&(bar)[XB_TMO], 1u); break; } } } } while (0)

struct XcdBarrier {
    unsigned* bar; unsigned x;
    volatile LAS unsigned* st;
};

__device__ __forceinline__ XcdBarrier xcd_barrier_post(unsigned* bar, volatile LAS unsigned* st) {
    XcdBarrier b; b.bar = bar; b.x = xb_xcc_id(); b.st = st;
    if (threadIdx.x == 0) (void)xb_add(&bar[XB_XCNT(b.x)], 1u);
    return b;
}
__device__ __forceinline__ void xcd_barrier_complete(unsigned* bar, unsigned x, unsigned& nloc, unsigned& nx) {
    const unsigned G = gridDim.x * gridDim.y * gridDim.z;
    unsigned sum, cnt, mine, sp = 0u;
    for (;;) {
        sum = 0u; cnt = 0u; mine = 0u;
#pragma unroll
        for (unsigned j = 0; j < 16; ++j) { const unsigned c = xb_ld(&bar[XB_XCNT(j)]); sum += c; cnt += (c > 0u) ? 1u : 0u; mine = (j == x) ? c : mine; }
        if (sum == G) break;
        __builtin_amdgcn_s_sleep(1);
        if ((++sp & 255u) == 0u) { if (xb_ld(&bar[XB_TMO])) break; if (sp > XB_SPIN_CAP) { atomicAdd(&bar[XB_TMO], 1u); break; } }
    }
    nloc = mine > 0u ? mine : 1u; nx = cnt > 0u ? cnt : 1u;
}

__device__ __forceinline__ void xcd_barrier(const XcdBarrier& b) {
    asm volatile("s_waitcnt vmcnt(0)" ::: "memory");
    __syncthreads();
    if (threadIdx.x == 0) {
        unsigned* bar = b.bar;
        __builtin_amdgcn_s_waitcnt(0);
        unsigned nloc = b.st[0], nx = b.st[1];
        if (nloc == 0u) { xcd_barrier_complete(bar, b.x, nloc, nx); b.st[0] = nloc; b.st[1] = nx; }
        const unsigned old = xb_add(&bar[XB_XSUB(b.x)], 1u);
        const unsigned gen = old / nloc;
        if (old + 1u == (gen + 1u) * nloc) {
            __builtin_amdgcn_fence(__ATOMIC_RELEASE, "agent");
            asm volatile("s_waitcnt vmcnt(0)" ::: "memory");
            const unsigned og = xb_add(&bar[XB_TOP], 1u);
            const unsigned tg = og / nx;
            if (og + 1u == (tg + 1u) * nx) xb_add(&bar[XB_TOPGEN], 1u);
            else XB_SPIN(xb_ld(&bar[XB_TOPGEN]) == tg, bar);
            __builtin_amdgcn_fence(__ATOMIC_ACQUIRE, "agent");
            xb_add(&bar[XB_XGEN(b.x)], 1u);
            asm volatile("s_waitcnt vmcnt(0)" ::: "memory");
        } else {
            XB_SPIN(xb_ld(&bar[XB_XGEN(b.x)]) == gen, bar);
            __builtin_amdgcn_fence(__ATOMIC_ACQUIRE, "agent");
            asm volatile("s_waitcnt vmcnt(0)" ::: "memory");
        }
    }
    __syncthreads();
}

constexpr size_t BAR_OFF = 254 * MiB;


typedef __bf16 bf2_t __attribute__((ext_vector_type(2)));
typedef float f2_t __attribute__((ext_vector_type(2)));
__device__ __forceinline__ unsigned pk2(float lo, float hi) { f2_t v = {lo, hi}; bf2_t b = __builtin_convertvector(v, bf2_t); return __builtin_bit_cast(unsigned, b); }
__device__ __forceinline__ float bflo(unsigned u) { return __uint_as_float(u << 16); }
__device__ __forceinline__ float bfhi(unsigned u) { return __uint_as_float(u & 0xffff0000u); }
__device__ __forceinline__ float rcpf_(float x) { return __builtin_amdgcn_rcpf(x); }
__device__ __forceinline__ float sigmoidf_(float x) { return rcpf_(1.0f + __expf(-x)); }
__device__ __forceinline__ float siluf_(float x) { return x * rcpf_(1.0f + __expf(-x)); }
__device__ __forceinline__ float tanhf_(float x) { const float e = __expf(-2.0f * fabsf(x)); const float t = (1.0f - e) * rcpf_(1.0f + e); return x < 0.f ? -t : t; }
__device__ __forceinline__ float gelu_tanh(float x) { return 0.5f * x * (1.0f + tanhf_(0.7978845608028654f * (x + 0.044715f * x * x * x))); }
template <int CTRL> __device__ __forceinline__ float dppf(float x) { return __int_as_float(__builtin_amdgcn_update_dpp(0, __float_as_int(x), CTRL, 0xF, 0xF, true)); }
__device__ __forceinline__ float red8(float x) { x += dppf<0xB1>(x); x += dppf<0x4E>(x); x += dppf<0x141>(x); return x; }
__device__ __forceinline__ float red16(float x) { x = red8(x); x += dppf<0x140>(x); return x; }
__device__ __forceinline__ float wave_sum(float v) { for (int o = 32; o >= 1; o >>= 1) v += __shfl_xor(v, o); return v; }
__device__ __forceinline__ int otid() { int t = threadIdx.x; asm volatile("" : "+v"(t)); return t; }
typedef float f32x2 __attribute__((ext_vector_type(2)));
__device__ __forceinline__ float fma_s(float a, float b, float c) { float d; asm("v_fma_f32 %0, %1, %2, %3" : "=v"(d) : "v"(a), "v"(b), "v"(c)); return d; }
__device__ __forceinline__ float fnma_s(float a, float b, float c) { float d; asm("v_fma_f32 %0, -%1, %2, %3" : "=v"(d) : "v"(a), "v"(b), "v"(c)); return d; }
__device__ __forceinline__ float mul_s(float a, float b) { float d; asm("v_mul_f32 %0, %1, %2" : "=v"(d) : "v"(a), "v"(b)); return d; }
__device__ __forceinline__ float add_s(float a, float b) { float d; asm("v_add_f32 %0, %1, %2" : "=v"(d) : "v"(a), "v"(b)); return d; }
#define BAR_LDS() asm volatile("s_waitcnt lgkmcnt(0)\n\ts_barrier" ::: "memory")
#define LDS_FENCE() asm volatile("s_waitcnt lgkmcnt(0)" ::: "memory")

struct EpiConvIn {
    static constexpr bool PERM = false, AFTER_DRAIN = false;
    bf16_t* U; bf16_t* G;
    __device__ __forceinline__ void operator()(const f32x4 (&acc)[2][2][4][2], const Unit& u, int wr, int wc, int fr, int fq) const {
        const int row0 = u.pm * 256 + wr * 64 + fr, e0 = u.pn * 64 + wc * 16 + 4 * fq;
#pragma unroll
        for (int ai = 0; ai < 2; ++ai)
#pragma unroll
            for (int m = 0; m < 4; ++m) {
                const size_t o = (size_t)(row0 + ai * 128 + m * 16) * DM + e0;
                float uu[4], gg[4];
#pragma unroll
                for (int j = 0; j < 4; ++j) { uu[j] = acc[ai][0][m][1][j] * acc[ai][1][m][0][j]; gg[j] = acc[ai][0][m][0][j] * siluf_(acc[ai][1][m][1][j]); }
                *(uint2*)(U + o) = make_uint2(pk2(uu[0], uu[1]), pk2(uu[2], uu[3]));
                *(uint2*)(G + o) = make_uint2(pk2(gg[0], gg[1]), pk2(gg[2], gg[3]));
            }
    }
};
struct EpiWout {
    static constexpr bool PERM = false, AFTER_DRAIN = false;
    float* X; bf16_t* RB;
    __device__ __forceinline__ void operator()(const f32x4 (&acc)[2][2][4][2], const Unit& u, int wr, int wc, int fr, int fq) const {
        const int row0 = u.pm * 256 + wr * 64 + fr, col0 = u.pn * 256 + wc * 32 + 4 * fq;
#pragma unroll
        for (int ai = 0; ai < 2; ++ai)
#pragma unroll
            for (int m = 0; m < 4; ++m)
#pragma unroll
                for (int bj = 0; bj < 2; ++bj)
#pragma unroll
                    for (int n = 0; n < 2; ++n) {
                        const size_t o = (size_t)(row0 + ai * 128 + m * 16) * DM + col0 + bj * 128 + n * 16;
                        f32x4 x = *(const f32x4*)(X + o);
                        f32x4 r = x * DN_ALPHA + acc[ai][bj][m][n];
                        *(f32x4*)(X + o) = r;
                        *(uint2*)(RB + o) = make_uint2(pk2(r[0], r[1]), pk2(r[2], r[3]));
                    }
    }
};
template <int ACT> struct EpiBf16T {
    static constexpr bool PERM = false, AFTER_DRAIN = false;
    bf16_t* O; int ldo; int split; size_t stride;
    __device__ __forceinline__ void operator()(const f32x4 (&acc)[2][2][4][2], const Unit& u, int wr, int wc, int fr, int fq) const {
        const int row0 = u.pm * 256 + wr * 64 + fr; const int grp = u.pn / split; const int col0 = (u.pn - grp * split) * 256 + wc * 32 + 4 * fq;
        bf16_t* base = O + (size_t)grp * stride;
#pragma unroll
        for (int ai = 0; ai < 2; ++ai)
#pragma unroll
            for (int m = 0; m < 4; ++m)
#pragma unroll
                for (int bj = 0; bj < 2; ++bj)
#pragma unroll
                    for (int n = 0; n < 2; ++n) {
                        const size_t o = (size_t)(row0 + ai * 128 + m * 16) * ldo + col0 + bj * 128 + n * 16;
                        f32x4 a = acc[ai][bj][m][n];
                        if (ACT == 1) { a[0] = siluf_(a[0]); a[1] = siluf_(a[1]); a[2] = siluf_(a[2]); a[3] = siluf_(a[3]); }
                        *(uint2*)(base + o) = make_uint2(pk2(a[0], a[1]), pk2(a[2], a[3]));
                    }
    }
};
typedef EpiBf16T<0> EpiBf16;
struct EpiPle {
    static constexpr bool PERM = false, AFTER_DRAIN = false;
    float* X; const bf16_t* PE;
    __device__ __forceinline__ void operator()(const f32x4 (&acc)[2][2][4][2], const Unit& u, int wr, int wc, int fr, int fq) const {
        const int row0 = u.pm * 256 + wr * 64 + fr, col0 = u.pn * 256 + wc * 32 + 4 * fq;
#pragma unroll
        for (int ai = 0; ai < 2; ++ai)
#pragma unroll
            for (int m = 0; m < 4; ++m)
#pragma unroll
                for (int bj = 0; bj < 2; ++bj)
#pragma unroll
                    for (int n = 0; n < 2; ++n) {
                        const size_t o = (size_t)(row0 + ai * 128 + m * 16) * DM + col0 + bj * 128 + n * 16;
                        f32x4 x = *(const f32x4*)(X + o); const uint2 pe = *(const uint2*)(PE + o); const f32x4 a = acc[ai][bj][m][n];
                        x[0] += bflo(pe.x) * sigmoidf_(a[0]); x[1] += bfhi(pe.x) * sigmoidf_(a[1]); x[2] += bflo(pe.y) * sigmoidf_(a[2]); x[3] += bfhi(pe.y) * sigmoidf_(a[3]);
                        *(f32x4*)(X + o) = x;
                    }
    }
};
struct EpiSsmIn {
    static constexpr bool PERM = false, AFTER_DRAIN = false;
    float* U; bf16_t* SZ;
    __device__ __forceinline__ void operator()(const f32x4 (&acc)[2][2][4][2], const Unit& u, int wr, int wc, int fr, int fq) const {
        const int row0 = u.pm * 256 + wr * 64 + fr; const bool isz = u.pn >= 4; const int col0 = (u.pn & 3) * 256 + wc * 32 + 4 * fq;
#pragma unroll
        for (int ai = 0; ai < 2; ++ai)
#pragma unroll
            for (int m = 0; m < 4; ++m)
#pragma unroll
                for (int bj = 0; bj < 2; ++bj)
#pragma unroll
                    for (int n = 0; n < 2; ++n) {
                        const size_t o = (size_t)(row0 + ai * 128 + m * 16) * DM + col0 + bj * 128 + n * 16;
                        const f32x4 a = acc[ai][bj][m][n];
                        if (isz) *(uint2*)(SZ + o) = make_uint2(pk2(siluf_(a[0]), siluf_(a[1])), pk2(siluf_(a[2]), siluf_(a[3])));
                        else *(f32x4*)(U + o) = a;
                    }
    }
};
struct EpiGlu {
    static constexpr bool PERM = false, AFTER_DRAIN = false;
    const bf16_t* YG; const bf16_t* SZ; const float* bias; bf16_t* V;
    __device__ __forceinline__ void operator()(const f32x4 (&acc)[2][2][4][2], const Unit& u, int wr, int wc, int fr, int fq) const {
        const int row0 = u.pm * 256 + wr * 64 + fr, col0 = u.pn * 256 + wc * 32 + 4 * fq;
#pragma unroll
        for (int ai = 0; ai < 2; ++ai)
#pragma unroll
            for (int m = 0; m < 4; ++m)
#pragma unroll
                for (int bj = 0; bj < 2; ++bj)
#pragma unroll
                    for (int n = 0; n < 2; ++n) {
                        const int col = col0 + bj * 128 + n * 16;
                        const size_t o = (size_t)(row0 + ai * 128 + m * 16) * DM + col;
                        const f32x4 a = acc[ai][bj][m][n]; const f32x4 bb = *(const f32x4*)(bias + col);
                        const uint2 y = *(const uint2*)(YG + o), z = *(const uint2*)(SZ + o);
                        const float v0 = bflo(y.x) * sigmoidf_(a[0] + bb[0]) * bflo(z.x), v1 = bfhi(y.x) * sigmoidf_(a[1] + bb[1]) * bfhi(z.x);
                        const float v2 = bflo(y.y) * sigmoidf_(a[2] + bb[2]) * bflo(z.y), v3 = bfhi(y.y) * sigmoidf_(a[3] + bb[3]) * bfhi(z.y);
                        *(uint2*)(V + o) = make_uint2(pk2(v0, v1), pk2(v2, v3));
                    }
    }
};
struct EpiRk {
    static constexpr bool PERM = false, AFTER_DRAIN = false;
    bf16_t* RKV; bf16_t* SZ; bf16_t* L1;
    __device__ __forceinline__ void operator()(const f32x4 (&acc)[2][2][4][2], const Unit& u, int wr, int wc, int fr, int fq) const {
        const int row0 = u.pm * 256 + wr * 64 + fr; const int grp = u.pn >> 2; const int colt = (u.pn & 3) * 256 + wc * 32 + 4 * fq;
#pragma unroll
        for (int ai = 0; ai < 2; ++ai)
#pragma unroll
            for (int m = 0; m < 4; ++m)
#pragma unroll
                for (int bj = 0; bj < 2; ++bj)
#pragma unroll
                    for (int n = 0; n < 2; ++n) {
                        const int row = row0 + ai * 128 + m * 16, col = colt + bj * 128 + n * 16;
                        const f32x4 a = acc[ai][bj][m][n];
                        if (grp < 3) *(uint2*)(RKV + (size_t)grp * MTOK * DM + (size_t)row * DM + col) = make_uint2(pk2(a[0], a[1]), pk2(a[2], a[3]));
                        else if (grp == 3) *(uint2*)(SZ + (size_t)row * DM + col) = make_uint2(pk2(siluf_(a[0]), siluf_(a[1])), pk2(siluf_(a[2]), siluf_(a[3])));
                        else { const bool th = col < 64;
                            const float v0 = th ? tanhf_(a[0]) : a[0], v1 = th ? tanhf_(a[1]) : a[1], v2 = th ? tanhf_(a[2]) : a[2], v3 = th ? tanhf_(a[3]) : a[3];
                            *(uint2*)(L1 + (size_t)row * 256 + col) = make_uint2(pk2(v0, v1), pk2(v2, v3)); }
                    }
    }
};

struct EpiLora2 {
    static constexpr bool PERM = false, AFTER_DRAIN = false;
    bf16_t* EW; bf16_t* AA; const float* w0; const float* a0;
    template <int ISA> __device__ __forceinline__ void body(const f32x4 (&acc)[2][2][4][2], bf16_t* O, const float* bias, int row0, int col0) const {
#pragma unroll
        for (int ai = 0; ai < 2; ++ai)
#pragma unroll
            for (int m = 0; m < 4; ++m)
#pragma unroll
                for (int bj = 0; bj < 2; ++bj)
#pragma unroll
                    for (int n = 0; n < 2; ++n) {
                        const int col = col0 + bj * 128 + n * 16; const f32x4 bb = *(const f32x4*)(bias + col);
                        const f32x4 a = acc[ai][bj][m][n]; float v[4];
#pragma unroll
                        for (int j = 0; j < 4; ++j) { const float t = bb[j] + a[j];
                            if (ISA) v[j] = sigmoidf_(t);
                            else { const float sp = fmaxf(-t, 0.f) + __logf(1.0f + __expf(-fabsf(t))); v[j] = __expf(-sp - 0.5f); } }
                        *(uint2*)(O + (size_t)(row0 + ai * 128 + m * 16) * DM + col) = make_uint2(pk2(v[0], v[1]), pk2(v[2], v[3]));
                    }
    }
    __device__ __forceinline__ void operator()(const f32x4 (&acc)[2][2][4][2], const Unit& u, int wr, int wc, int fr, int fq) const {
        const int row0 = u.pm * 256 + wr * 64 + fr; const int col0 = (u.pn & 3) * 256 + wc * 32 + 4 * fq;
        if (u.pn >= 4) body<1>(acc, AA, a0, row0, col0); else body<0>(acc, EW, w0, row0, col0);
    }
};

template <class Epi> __device__ __forceinline__ void run_gemm(LAS unsigned char* lds, const bf16_t* A, const bf16_t* Bt, int N, int K, const Epi& E) {
    int Kv = K; asm volatile("" : "+s"(Kv));
    Gemm g; g.A = A; g.Bt = Bt; g.M = MTOK; g.N = N; g.K = Kv;
    StaticOrder S; S.init(MTOK, N, (int)gridDim.x, (int)blockIdx.x);
    pg8::gemm_phase<Epi, StaticOrder, false>(lds, g, S, E, nullptr);
}

__device__ __forceinline__ int conv_rowmap(int n) { const int s = n >> 10, e = n & 1023, q = e & 63; return 256 * (e >> 6) + 128 * (s >> 1) + 32 * (q >> 4) + 16 * (s & 1) + (q & 15); }
__device__ __forceinline__ void tr_job(LAS float* tile, const float* src, int ld_src, int K, int N, bf16_t* dst, int ldd, int koff, const float* kscale, int mode, int rot) {
    const int nblk = (int)gridDim.x, blk = ((int)blockIdx.x + rot) % nblk, tid = otid();
    const int tn_ = N >> 6, ntiles = (K >> 6) * tn_;
    const int tk0 = tid >> 6, tn = tid & 63, nl = tid >> 3, kp = (tid & 7) * 8;
    float cur[8];
    if (blk < ntiles) { const int k0 = (blk / tn_) << 6, n0 = (blk % tn_) << 6;
#pragma unroll
        for (int i = 0; i < 8; ++i) cur[i] = src[(size_t)(k0 + tk0 + i * 8) * ld_src + n0 + tn]; }
    for (int t = blk; t < ntiles; t += nblk) {
        const int k0 = (t / tn_) << 6, n0 = (t % tn_) << 6;
        float nxt[8];
        const int t2 = t + nblk;
        if (t2 < ntiles) { const int k2 = (t2 / tn_) << 6, n2 = (t2 % tn_) << 6;
#pragma unroll
            for (int i = 0; i < 8; ++i) nxt[i] = src[(size_t)(k2 + tk0 + i * 8) * ld_src + n2 + tn]; }
        BAR_LDS();
#pragma unroll
        for (int i = 0; i < 8; ++i) tile[(tk0 + i * 8) * 65 + tn] = cur[i];
        BAR_LDS();
        float v[8];
#pragma unroll
        for (int i = 0; i < 8; ++i) { v[i] = tile[(kp + i) * 65 + nl]; if (kscale) v[i] *= kscale[k0 + kp + i]; }
        const int n = n0 + nl; const int row = mode ? conv_rowmap(n) : n;
        *(uint4*)(dst + (size_t)row * ldd + koff + k0 + kp) = make_uint4(pk2(v[0], v[1]), pk2(v[2], v[3]), pk2(v[4], v[5]), pk2(v[6], v[7]));
        if (t2 < ntiles) {
#pragma unroll
            for (int i = 0; i < 8; ++i) cur[i] = nxt[i]; }
    }
}
__device__ __forceinline__ void cvt_pb(const float* src, bf16_t* dst) {
    const size_t n4 = (size_t)MTOK * 256 / 4, nth = (size_t)gridDim.x * 512;
    for (size_t i = (size_t)blockIdx.x * 512 + otid(); i < n4; i += nth) { const float4 v = ((const float4*)src)[i]; ((uint2*)dst)[i] = make_uint2(pk2(v.x, v.y), pk2(v.z, v.w)); }
}
__device__ __forceinline__ void conv_layer_weights(const P& p, LAS float* tile, int j, int L) {
    unsigned char* ws = p.ws;
    tr_job(tile, p.in[2] + (size_t)j * 1024 * 4096, 4096, 1024, 4096, (bf16_t*)(ws + W_CIN), 1024, 0, nullptr, 1, 0);
    tr_job(tile, p.in[4] + (size_t)j * 1024 * 1024, 1024, 1024, 1024, (bf16_t*)(ws + W_COUT), 1024, 0, nullptr, 0, 0);
    tr_job(tile, p.in[31] + (size_t)L * 256 * 1024, 1024, 256, 1024, (bf16_t*)(ws + W_PEC), 256, 0, nullptr, 0, 0);
    tr_job(tile, p.in[32] + (size_t)L * 1024 * 1024, 1024, 1024, 1024, (bf16_t*)(ws + W_PGC), 1024, 0, nullptr, 0, 64);
}

__device__ __forceinline__ void phase_prep(const P& p, LAS float* tile) {
    unsigned char* ws = p.ws; const size_t nth = (size_t)gridDim.x * 512, gt = (size_t)blockIdx.x * 512 + otid();
    {
        const float4* x = (const float4*)p.in[0]; float4* o = (float4*)p.out; uint2* a = (uint2*)(ws + ACT);
        for (size_t i = gt; i < (size_t)MTOK * DM / 4; i += nth) { const float4 v = x[i]; o[i] = v; a[i] = make_uint2(pk2(v.x, v.y), pk2(v.z, v.w)); }
    }
    cvt_pb(p.in[1], (bf16_t*)(ws + PB));
    conv_layer_weights(p, tile, 0, 0);
    tr_job(tile, p.in[5], 2048, 1024, 2048, (bf16_t*)(ws + W_SIN), 1024, 0, nullptr, 0, 128);
    tr_job(tile, p.in[14], 1024, 1024, 1024, (bf16_t*)(ws + W_SGLU), 1024, 0, nullptr, 0, 0);
    tr_job(tile, p.in[16], 1024, 1024, 1024, (bf16_t*)(ws + W_SOUT), 1024, 0, nullptr, 0, 0);
    tr_job(tile, p.in[31] + (size_t)1 * 256 * 1024, 1024, 256, 1024, (bf16_t*)(ws + W_PE1), 256, 0, nullptr, 0, 192);
    tr_job(tile, p.in[32] + (size_t)1 * 1024 * 1024, 1024, 1024, 1024, (bf16_t*)(ws + W_PG1), 1024, 0, nullptr, 0, 0);
    bf16_t* rk = (bf16_t*)(ws + W_RK);
    for (int g = 0; g < 4; ++g)
        tr_job(tile, p.in[18] + (size_t)g * 1024 * 1024, 1024, 1024, 1024, rk + (size_t)g * 1024 * 1024, 1024, 0, nullptr, 0, g * 64);
    bf16_t* wl = rk + (size_t)4096 * 1024;
    tr_job(tile, p.in[20], 64, 1024, 64, wl, 2048, 0, nullptr, 0, 0);
    tr_job(tile, p.in[20], 64, 1024, 64, wl, 2048, 1024, p.in[17] + 4 * 1024, 0, 16);
    tr_job(tile, p.in[23], 64, 1024, 64, wl + (size_t)64 * 2048, 2048, 0, nullptr, 0, 32);
    tr_job(tile, p.in[23], 64, 1024, 64, wl + (size_t)64 * 2048, 2048, 1024, p.in[17] + 5 * 1024, 0, 48);
    bf16_t* l2 = (bf16_t*)(ws + W_L2);
    tr_job(tile, p.in[21], 1024, 64, 1024, l2, 256, 0, nullptr, 0, 64);
    tr_job(tile, p.in[24], 1024, 64, 1024, l2 + (size_t)1024 * 256, 256, 64, nullptr, 0, 80);
    for (size_t i = gt; i < (size_t)2048 * 32; i += nth) { const int row = (int)(i >> 5), c8 = (int)(i & 31); const bool data = row < 1024 ? (c8 < 8) : (c8 >= 8 && c8 < 16);
        if (!data) *(uint4*)(l2 + (size_t)row * 256 + c8 * 8) = make_uint4(0, 0, 0, 0); }
    tr_job(tile, p.in[30], 1024, 1024, 1024, (bf16_t*)(ws + W_ROUT), 1024, 0, nullptr, 0, 96);
    tr_job(tile, p.in[31] + (size_t)2 * 256 * 1024, 1024, 256, 1024, (bf16_t*)(ws + W_PE2), 256, 0, nullptr, 0, 160);
    tr_job(tile, p.in[32] + (size_t)2 * 1024 * 1024, 1024, 1024, 1024, (bf16_t*)(ws + W_PG2), 1024, 0, nullptr, 0, 0);
}

__device__ __forceinline__ void phase_conv_ew(const bf16_t* U, bf16_t* G, const float* ck) {
    const size_t nth = (size_t)gridDim.x * 512;
    for (size_t i = (size_t)blockIdx.x * 512 + otid(); i < (size_t)MTOK * 128; i += nth) {
        const int row = (int)(i >> 7), c8 = (int)(i & 127) * 8, t = row & (SEQL - 1);
        const uint4 z4 = make_uint4(0, 0, 0, 0);
        const uint4 u0 = *(const uint4*)(U + (size_t)row * DM + c8);
        const uint4 u1 = t >= 1 ? *(const uint4*)(U + (size_t)(row - 1) * DM + c8) : z4;
        const uint4 u2 = t >= 2 ? *(const uint4*)(U + (size_t)(row - 2) * DM + c8) : z4;
        const uint4 g = *(const uint4*)(G + (size_t)row * DM + c8);
        const unsigned a0[4] = {u0.x, u0.y, u0.z, u0.w}, a1[4] = {u1.x, u1.y, u1.z, u1.w}, a2[4] = {u2.x, u2.y, u2.z, u2.w}, gg[4] = {g.x, g.y, g.z, g.w};
        unsigned o[4];
#pragma unroll
        for (int q = 0; q < 4; ++q) {
            const int c = c8 + 2 * q;
            const float lo = bflo(gg[q]) * (ck[c] * bflo(a2[q]) + ck[1024 + c] * bflo(a1[q]) + ck[2048 + c] * bflo(a0[q]));
            const float hi = bfhi(gg[q]) * (ck[c + 1] * bfhi(a2[q]) + ck[1024 + c + 1] * bfhi(a1[q]) + ck[2048 + c + 1] * bfhi(a0[q]));
            o[q] = pk2(lo, hi);
        }
        *(uint4*)(G + (size_t)row * DM + c8) = make_uint4(o[0], o[1], o[2], o[3]);
    }
}

__device__ __forceinline__ void phase_ln(float* X, bf16_t* XB, const float* g, const float* b) {
    const int lane = otid() & 63, gw = blockIdx.x * 8 + (otid() >> 6), nw = gridDim.x * 8;
    for (int row = gw; row < MTOK; row += nw) {
        float4 v[4]; float s = 0.f;
#pragma unroll
        for (int i = 0; i < 4; ++i) { v[i] = *(const float4*)(X + (size_t)row * DM + i * 256 + lane * 4); s += v[i].x + v[i].y + v[i].z + v[i].w; }
        const float mean = wave_sum(s) * (1.0f / 1024.0f);
        float q = 0.f;
#pragma unroll
        for (int i = 0; i < 4; ++i) { v[i].x -= mean; v[i].y -= mean; v[i].z -= mean; v[i].w -= mean; q += v[i].x * v[i].x + v[i].y * v[i].y + v[i].z * v[i].z + v[i].w * v[i].w; }
        const float rs = rsqrtf(wave_sum(q) * (1.0f / 1024.0f) + 1e-5f);
#pragma unroll
        for (int i = 0; i < 4; ++i) { const int c = i * 256 + lane * 4; const float4 gg = *(const float4*)(g + c), bb = *(const float4*)(b + c);
            float4 y; y.x = v[i].x * rs * gg.x + bb.x; y.y = v[i].y * rs * gg.y + bb.y; y.z = v[i].z * rs * gg.z + bb.z; y.w = v[i].w * rs * gg.w + bb.w;
            *(float4*)(X + (size_t)row * DM + c) = y; *(uint2*)(XB + (size_t)row * DM + c) = make_uint2(pk2(y.x, y.y), pk2(y.z, y.w)); }
    }
}

template <int FINAL> __device__ __forceinline__ void phase_s5(const P& p, LAS unsigned char* lds_, const float* U, float* HLOC, bf16_t* YG) {
    const int lane = otid() & 63, wid = otid() >> 6, nw = gridDim.x * 8;
    LAS float* ul = (LAS float*)(lds_ + wid * 8192);
    LAS unsigned* S = (LAS unsigned*)(lds_ + wid * 8192 + 2048);
    const int fr = lane & 15, fq = lane >> 4;
    for (int un = blockIdx.x * 8 + wid; un < 2048; un += nw) {
        const int g = un & 63, sc = (un >> 6) & 7, b = un >> 9;
        if (!FINAL && sc == 7) continue;
        const float dt = __expf(p.in[8][g]);
        const float lre = p.in[6][g * 64 + lane], lim = p.in[7][g * 64 + lane];
        const float mag = expf(lre * dt); float sn, cs; sincosf(lim * dt, &sn, &cs);
        const float are = mag * cs, aim = mag * sn;
        const float d2 = lre * lre + lim * lim, cfre = ((are - 1.0f) * lre + aim * lim) / d2, cfim = (aim * lre - (are - 1.0f) * lim) / d2;
        f32x2 Bp[16];
#pragma unroll
        for (int q = 0; q < 4; ++q) { const float4 br = *(const float4*)(p.in[9] + (size_t)(g * 64 + lane) * 16 + q * 4), bi = *(const float4*)(p.in[10] + (size_t)(g * 64 + lane) * 16 + q * 4);
            const float brr[4] = {br.x, br.y, br.z, br.w}, bii[4] = {bi.x, bi.y, bi.z, bi.w};
#pragma unroll
            for (int j = 0; j < 4; ++j) { Bp[q * 4 + j] = (f32x2){cfre * brr[j] - cfim * bii[j], cfre * bii[j] + cfim * brr[j]}; } }
        float hre = 0.f, him = 0.f;
        bf16x8 Cf[4]; float dsk = 0.f;
        if (FINAL) {
            float lr = are, li = aim;
#pragma unroll
            for (int i = 0; i < 9; ++i) { const float t = lr * lr - li * li; li = 2.0f * lr * li; lr = t; }
            for (int s2 = 0; s2 < sc; ++s2) { const float2 hv = *(const float2*)(HLOC + ((size_t)((b * 8 + s2) * 64 + g) * 64 + lane) * 2);
                const float t = lr * hre - li * him + hv.x; him = lr * him + li * hre + hv.y; hre = t; }
#pragma unroll
            for (int kk = 0; kk < 4; ++kk) {
                unsigned w[4];
#pragma unroll
                for (int i = 0; i < 4; ++i) { const int pi = 16 * kk + 4 * fq + i; const size_t o = (size_t)(g * 16 + fr) * 64 + pi; w[i] = pk2(p.in[11][o], -p.in[12][o]); }
                union { unsigned u[4]; bf16x8 v; } cv; cv.u[0] = w[0]; cv.u[1] = w[1]; cv.u[2] = w[2]; cv.u[3] = w[3]; Cf[kk] = cv.v;
            }
            dsk = p.in[13][g * 16 + fr];
        }
        const size_t tok0 = (size_t)b * SEQL + (size_t)sc * 512;
        const float* ug = U + tok0 * DM + g * 16 + (lane & 3) * 4 + (size_t)(lane >> 2) * DM;
        f32x4 nxt = *(const f32x4*)ug;
        LDS_FENCE();
        *(LAS f32x4*)(ul + lane * 4) = nxt;
        for (int blk = 0; blk < 32; ++blk) {
            const int cur = blk & 1;
            if (blk + 1 < 32) nxt = *(const f32x4*)(ug + (size_t)(blk + 1) * 16 * DM);
            LDS_FENCE();
#pragma unroll 4
            for (int tt = 0; tt < 16; ++tt) {
                float uu[16];
#pragma unroll
                for (int q = 0; q < 4; ++q) { const f32x4 t4 = *(const LAS f32x4*)(ul + cur * 256 + tt * 16 + q * 4); uu[q * 4] = t4[0]; uu[q * 4 + 1] = t4[1]; uu[q * 4 + 2] = t4[2]; uu[q * 4 + 3] = t4[3]; }
                f32x2 b0 = {0.f, 0.f}, b1 = {0.f, 0.f};
#pragma unroll
                for (int h = 0; h < 16; h += 2) { b0 = Bp[h] * (f32x2){uu[h], uu[h]} + b0; b1 = Bp[h + 1] * (f32x2){uu[h + 1], uu[h + 1]} + b1; }
                const f32x2 bs = b0 + b1; const float bre = bs[0], bim = bs[1];
                const float t = are * hre - aim * him + bre; him = are * him + aim * hre + bim; hre = t;
                if (FINAL) S[tt * 68 + lane] = pk2(hre, him);
            }
            if (FINAL) {
                LDS_FENCE();
                f32x4 acc = {0.f, 0.f, 0.f, 0.f};
#pragma unroll
                for (int kk = 0; kk < 4; ++kk) { const bf16x8 af = *(const LAS bf16x8*)(S + fr * 68 + 16 * kk + 4 * fq); acc = __builtin_amdgcn_mfma_f32_16x16x32_bf16(af, Cf[kk], acc, 0, 0, 0); }
#pragma unroll
                for (int i = 0; i < 4; ++i) { const int tl = 4 * fq + i; const float y = acc[i] + dsk * ul[cur * 256 + tl * 16 + fr];
                    const unsigned short hb = (unsigned short)(pk2(gelu_tanh(y), 0.f) & 0xffffu);
                    YG[(tok0 + blk * 16 + tl) * DM + g * 16 + fr] = hb; }
            }
            LDS_FENCE();
            if (blk + 1 < 32) *(LAS f32x4*)(ul + (cur ^ 1) * 256 + lane * 4) = nxt;
        }
        if (!FINAL) *(float2*)(HLOC + ((size_t)un * 64 + lane) * 2) = make_float2(hre, him);
    }
}

constexpr int L1_BROW = 72;
__device__ __forceinline__ void phase_rw_lora1(LAS unsigned char* lds_, const float* X, const bf16_t* Wl, bf16_t* L1) {
    LAS bf16_t* Bs = (LAS bf16_t*)lds_;
    const int tid = otid(), lane = tid & 63, wid = tid >> 6, fr = lane & 15, fq = lane >> 4, mt = wid >> 1, ch = wid & 1;
    const int sn = tid >> 2, sq = tid & 3;
    for (int item = blockIdx.x; item < MTOK / 64; item += gridDim.x) {
        const int row = item * 64 + mt * 16 + fr, t = row & (SEQL - 1);
        const float* xr = X + (size_t)row * DM + fq * 8; const float* xpr = xr - DM;
        f32x4 acc[4];
#pragma unroll
        for (int n = 0; n < 4; ++n) acc[n] = (f32x4){0.f, 0.f, 0.f, 0.f};
        __syncthreads();
        pg8::u32x4 sb[2][2];
#pragma unroll
        for (int pt = 0; pt < 2; ++pt)
#pragma unroll
            for (int h = 0; h < 2; ++h) sb[pt][h] = *(const pg8::u32x4*)(Wl + (size_t)sn * 2048 + pt * 1024 + sq * 16 + h * 8);
        for (int ks = 0; ks < 16; ++ks) {
            const int st = ks & 1;
#pragma unroll
            for (int pt = 0; pt < 2; ++pt)
#pragma unroll
                for (int h = 0; h < 2; ++h) *(LAS pg8::u32x4*)(Bs + ((st * 2 + pt) * 128 + sn) * L1_BROW + sq * 16 + h * 8) = sb[pt][h];
            if (ks + 1 < 16) {
#pragma unroll
                for (int pt = 0; pt < 2; ++pt)
#pragma unroll
                    for (int h = 0; h < 2; ++h) sb[pt][h] = *(const pg8::u32x4*)(Wl + (size_t)sn * 2048 + pt * 1024 + (ks + 1) * 64 + sq * 16 + h * 8);
            }
            BAR_LDS();
#pragma unroll
            for (int k2 = 0; k2 < 2; ++k2) {
                const int k = ks * 64 + k2 * 32;
                const float4 x0 = *(const float4*)(xr + k), x1 = *(const float4*)(xr + k + 4);
                float4 p0 = make_float4(0.f, 0.f, 0.f, 0.f), p1 = p0;
                if (t >= 1) { p0 = *(const float4*)(xpr + k); p1 = *(const float4*)(xpr + k + 4); }
                union { unsigned u[4]; bf16x8 v; } ax, ad;
                ax.u[0] = pk2(x0.x, x0.y); ax.u[1] = pk2(x0.z, x0.w); ax.u[2] = pk2(x1.x, x1.y); ax.u[3] = pk2(x1.z, x1.w);
                ad.u[0] = pk2(p0.x - x0.x, p0.y - x0.y); ad.u[1] = pk2(p0.z - x0.z, p0.w - x0.w); ad.u[2] = pk2(p1.x - x1.x, p1.y - x1.y); ad.u[3] = pk2(p1.z - x1.z, p1.w - x1.w);
#pragma unroll
                for (int n = 0; n < 4; ++n) {
                    const bf16x8 b0 = *(const LAS bf16x8*)(Bs + ((st * 2 + 0) * 128 + ch * 64 + n * 16 + fr) * L1_BROW + k2 * 32 + fq * 8);
                    const bf16x8 b1 = *(const LAS bf16x8*)(Bs + ((st * 2 + 1) * 128 + ch * 64 + n * 16 + fr) * L1_BROW + k2 * 32 + fq * 8);
                    acc[n] = __builtin_amdgcn_mfma_f32_16x16x32_bf16(ax.v, b0, acc[n], 0, 0, 0);
                    acc[n] = __builtin_amdgcn_mfma_f32_16x16x32_bf16(ad.v, b1, acc[n], 0, 0, 0);
                }
            }
        }
        const int row0 = item * 64 + mt * 16;
#pragma unroll
        for (int n = 0; n < 4; ++n)
#pragma unroll
            for (int i = 0; i < 4; ++i) { const int r = row0 + fq * 4 + i, col = ch * 64 + n * 16 + fr;
                const float v = ch == 0 ? tanhf_(acc[n][i]) : acc[n][i];
                L1[(size_t)r * 256 + col] = (bf16_t)(pk2(v, 0.f) & 0xffffu); }
#pragma unroll
        for (int q = 0; q < 2; ++q) { const int idx = q * 64 + lane, r = idx >> 3, c8 = idx & 7;
            *(uint4*)(L1 + (size_t)(row0 + r) * 256 + 128 + ch * 64 + c8 * 8) = make_uint4(0, 0, 0, 0); }
    }
}
__device__ __forceinline__ void phase_rw_prep(const float* X, bf16_t* XS, const float* mua, const float* mub) {
    const size_t nth = (size_t)gridDim.x * 512;
    for (size_t i = (size_t)blockIdx.x * 512 + otid(); i < (size_t)MTOK * 256; i += nth) {
        const int row = (int)(i >> 8), c4 = (int)(i & 255) * 4, t = row & (SEQL - 1);
        const float4 x = *(const float4*)(X + (size_t)row * DM + c4);
        float4 xp = make_float4(0.f, 0.f, 0.f, 0.f); if (t >= 1) xp = *(const float4*)(X + (size_t)(row - 1) * DM + c4);
        const float4 ma = *(const float4*)(mua + c4), mb = *(const float4*)(mub + c4);
        const float d0 = xp.x - x.x, d1 = xp.y - x.y, d2 = xp.z - x.z, d3 = xp.w - x.w;
        *(uint2*)(XS + (size_t)row * DM + c4) = make_uint2(pk2(x.x + d0 * ma.x, x.y + d1 * ma.y), pk2(x.z + d2 * ma.z, x.w + d3 * ma.w));
        *(uint2*)(XS + (size_t)MTOK * DM + (size_t)row * DM + c4) = make_uint2(pk2(x.x + d0 * mb.x, x.y + d1 * mb.y), pk2(x.z + d2 * mb.z, x.w + d3 * mb.w));
    }
}
__device__ __forceinline__ void unpack8(const uint4 v, float* f) { f[0] = bflo(v.x); f[1] = bfhi(v.x); f[2] = bflo(v.y); f[3] = bfhi(v.y); f[4] = bflo(v.z); f[5] = bfhi(v.z); f[6] = bflo(v.w); f[7] = bfhi(v.w); }

constexpr int RW_T = 32, RW_STEP = 336;
constexpr int RW_BUF = RW_T * RW_STEP, RW_OB = RW_T * 16 * 16;
struct RwOp { f32x4 r, w, kp, kk, ka; float v; };
__device__ __forceinline__ void rw_load(RwOp& o, const LAS float* sb, int j0, int rr) {
    o.r = *(const LAS f32x4*)(sb + j0); o.w = *(const LAS f32x4*)(sb + 64 + j0); o.kp = *(const LAS f32x4*)(sb + 128 + j0);
    o.kk = *(const LAS f32x4*)(sb + 192 + j0); o.ka = *(const LAS f32x4*)(sb + 256 + j0); o.v = sb[320 + rr];
}
template <int MODE> __device__ __forceinline__ float rw_step(const RwOp& o, float& s0, float& s1, float& s2, float& s3) {
    const float dsum = fmaf(s0, o.kk[0], s1 * o.kk[1]) + fmaf(s2, o.kk[2], s3 * o.kk[3]);
    const float sa = MODE == 3 ? -dsum : -red16(dsum);
    s0 = fmaf(s0, o.w[0], fmaf(sa, o.ka[0], o.v * o.kp[0])); s1 = fmaf(s1, o.w[1], fmaf(sa, o.ka[1], o.v * o.kp[1]));
    s2 = fmaf(s2, o.w[2], fmaf(sa, o.ka[2], o.v * o.kp[2])); s3 = fmaf(s3, o.w[3], fmaf(sa, o.ka[3], o.v * o.kp[3]));
    return fmaf(s0, o.r[0], s1 * o.r[1]) + fmaf(s2, o.r[2], s3 * o.r[3]);
}
__device__ __forceinline__ void rw_flush(const LAS float* ob, bf16_t* dst) {
    float o2[2];
#pragma unroll
    for (int q = 0; q < 2; ++q) { float a = 0.f;
#pragma unroll
        for (int i = 0; i < 4; ++i) { const f32x4 t = *(const LAS f32x4*)(ob + q * 16 + i * 4); a += (t[0] + t[1]) + (t[2] + t[3]); }
        o2[q] = a; }
    *(unsigned*)dst = pk2(o2[0], o2[1]);
}
template <int MODE> __device__ __forceinline__ void phase_rw_scan(const P& p, LAS unsigned char* lds_, const bf16_t* R, const bf16_t* K, const bf16_t* V, const bf16_t* DW, const bf16_t* DA, bf16_t* OUT) {
    LAS float* buf = (LAS float*)lds_;
    LAS float* obuf = buf + 2 * RW_BUF;
    const int tid = otid(), lane = tid & 63, wid = __builtin_amdgcn_readfirstlane(tid >> 6);
    for (int un = blockIdx.x; un < 256; un += gridDim.x) {
        const int bh = un >> 2, rg = un & 3, b = bh >> 4, h = bh & 15;
        __syncthreads();
        if (wid < 4) {
            const int rr = wid * 4 + (lane >> 4), jl = lane & 15, j0 = jl * 4;
            float s0 = 0.f, s1 = 0.f, s2 = 0.f, s3 = 0.f;
            __builtin_amdgcn_s_setprio(3);
            BAR_LDS();
            for (int c = 0; c < SEQL / RW_T; ++c) {
                const LAS float* cb = buf + (c & 1) * RW_BUF; LAS float* ob = obuf + (c & 1) * RW_OB + rr * 16 + jl;
                if (MODE != 1) {
                RwOp ops[3];
                rw_load(ops[0], cb, j0, rr); rw_load(ops[1], cb + RW_STEP, j0, rr);
#pragma unroll
                for (int s = 0; s < RW_T; ++s) {
                    if (s + 2 < RW_T) rw_load(ops[(s + 2) % 3], cb + (s + 2) * RW_STEP, j0, rr);
                    ob[s * 256] = rw_step<MODE>(ops[s % 3], s0, s1, s2, s3);
                }
                }
                BAR_LDS();
            }
            __builtin_amdgcn_s_setprio(0);
        } else {
            const int pt = tid - 256, s = pt >> 3, part = pt & 7, c0 = part * 8, ch = h * 64 + c0;
            float kk_[8], ka_[8];
#pragma unroll
            for (int i = 0; i < 8; ++i) { kk_[i] = p.in[25][ch + i]; ka_[i] = p.in[26][ch + i]; }
            const size_t rowb = (size_t)b * SEQL + s;
            uint4 qr, qk, qw, qa, qv = make_uint4(0, 0, 0, 0);
            { const size_t o = rowb * DM + ch; qr = *(const uint4*)(R + o); qk = *(const uint4*)(K + o); qw = *(const uint4*)(DW + o); qa = *(const uint4*)(DA + o);
              if (part < 2) qv = *(const uint4*)(V + rowb * DM + h * 64 + rg * 16 + part * 8); }
            for (int c = 0; c <= SEQL / RW_T; ++c) {
                uint4 nr = qr, nk = qk, nw = qw, na = qa, nv = qv;
                if (MODE != 2 && c + 1 < SEQL / RW_T) { const size_t row = rowb + (size_t)(c + 1) * RW_T; const size_t o = row * DM + ch;
                    nr = *(const uint4*)(R + o); nk = *(const uint4*)(K + o); nw = *(const uint4*)(DW + o); na = *(const uint4*)(DA + o);
                    if (part < 2) nv = *(const uint4*)(V + row * DM + h * 64 + rg * 16 + part * 8); }
                if (MODE != 2 && c < SEQL / RW_T) {
                    float r[8], k[8], ew[8], aa[8];
                    unpack8(qr, r); unpack8(qk, k); unpack8(qw, ew); unpack8(qa, aa);
                    float wv[8], kp[8], kk[8], ka[8]; float ss = 0.f;
#pragma unroll
                    for (int i = 0; i < 8; ++i) {
                        wv[i] = __expf(-ew[i]);
                        kk[i] = k[i] * kk_[i]; ss = fmaf(kk[i], kk[i], ss);
                        kp[i] = k[i] * fmaf(aa[i] - 1.0f, ka_[i], 1.0f);
                    }
                    ss = red8(ss); const float inv = rcpf_(fmaxf(__builtin_amdgcn_sqrtf(ss), 1e-12f));
#pragma unroll
                    for (int i = 0; i < 8; ++i) { kk[i] *= inv; ka[i] = kk[i] * aa[i]; }
                    LAS float* sb = buf + (c & 1) * RW_BUF + s * RW_STEP + c0;
                    *(LAS f32x4*)(sb) = (f32x4){r[0], r[1], r[2], r[3]}; *(LAS f32x4*)(sb + 4) = (f32x4){r[4], r[5], r[6], r[7]};
                    *(LAS f32x4*)(sb + 64) = (f32x4){wv[0], wv[1], wv[2], wv[3]}; *(LAS f32x4*)(sb + 68) = (f32x4){wv[4], wv[5], wv[6], wv[7]};
                    *(LAS f32x4*)(sb + 128) = (f32x4){kp[0], kp[1], kp[2], kp[3]}; *(LAS f32x4*)(sb + 132) = (f32x4){kp[4], kp[5], kp[6], kp[7]};
                    *(LAS f32x4*)(sb + 192) = (f32x4){kk[0], kk[1], kk[2], kk[3]}; *(LAS f32x4*)(sb + 196) = (f32x4){kk[4], kk[5], kk[6], kk[7]};
                    *(LAS f32x4*)(sb + 256) = (f32x4){ka[0], ka[1], ka[2], ka[3]}; *(LAS f32x4*)(sb + 260) = (f32x4){ka[4], ka[5], ka[6], ka[7]};
                    if (part < 2) { float v[8]; unpack8(qv, v);
                        LAS float* vb = buf + (c & 1) * RW_BUF + s * RW_STEP + 320 + part * 8;
                        *(LAS f32x4*)(vb) = (f32x4){v[0], v[1], v[2], v[3]}; *(LAS f32x4*)(vb + 4) = (f32x4){v[4], v[5], v[6], v[7]}; }
                }
                if (MODE == 0 && c >= 2) {
                    const int cc = c - 2; const size_t row = (size_t)b * SEQL + (size_t)cc * RW_T + s;
                    rw_flush(obuf + (cc & 1) * RW_OB + s * 256 + part * 32, OUT + row * DM + h * 64 + rg * 16 + part * 2);
                }
                BAR_LDS();
                qr = nr; qk = nk; qw = nw; qa = na; qv = nv;
            }
            if (MODE == 0) {
                const int cc = SEQL / RW_T - 1; const size_t row = (size_t)b * SEQL + (size_t)cc * RW_T + s;
                rw_flush(obuf + (cc & 1) * RW_OB + s * 256 + part * 32, OUT + row * DM + h * 64 + rg * 16 + part * 2);
            }
        }
    }
}


constexpr int RW2_NP = 7, RW2_NS = 8, RW2_SLOT = 11264, RW2_SCR = 9216;
constexpr int SL_P1T = 0, SL_RT = 2304, SL_BPT = 4608, SL_KPT = 6656, SL_AM = 8704, SL_A2 = 9728, SL_VP = 10240, SL_GC = 10752;
constexpr int SC_BT = 0, SC_KT = 2304, SC_ATT = 4608, SC_L = 6656, SC_NT = 7680, SC_LKA = 8448;
constexpr int RW2_FLG = RW2_NS * RW2_SLOT + RW2_NP * RW2_SCR;
__device__ __forceinline__ float bf_us(unsigned short x) { return __uint_as_float(((unsigned)x) << 16); }
__device__ __forceinline__ unsigned short us_bf(float v) { return (unsigned short)(pk2(v, 0.f) & 0xffffu); }
typedef unsigned u32x2 __attribute__((ext_vector_type(2)));
union Frag8 { unsigned u[4]; bf16x8 v; };

__device__ __forceinline__ float wave_total(float x) {
    float y = red16(x);
    y += __int_as_float(__builtin_amdgcn_update_dpp(0, __float_as_int(y), 0x142, 0xA, 0xF, false));
    y += __int_as_float(__builtin_amdgcn_update_dpp(0, __float_as_int(y), 0x143, 0xC, 0xF, false));
    return __int_as_float(__builtin_amdgcn_readlane(__float_as_int(y), 63));
}
__device__ __forceinline__ void phase_rw_tables(const P& p, bf16_t* R, bf16_t* K, bf16_t* EW, bf16_t* AA, float* GC, float* CB) {
    const int tid = otid(), lane = tid & 63, wid = tid >> 6, nw = gridDim.x * 8;
    for (int task = blockIdx.x * 8 + wid; task < 16384; task += nw) {
        const int h = task & 15, c = (task >> 4) & 255, b = task >> 12, ch = h * 64 + lane;
        const size_t row0 = (size_t)b * SEQL + (size_t)c * 16;
        const float kkm = p.in[25][ch], kam = p.in[26][ch], rkm = p.in[27][ch];
        unsigned short xr[16], xk[16], xe[16], xa[16];
#pragma unroll
        for (int t = 0; t < 16; ++t) { const size_t o = (row0 + t) * DM + ch; xr[t] = R[o]; xk[t] = K[o]; xe[t] = EW[o]; xa[t] = AA[o]; }
        float n2[16];
#pragma unroll
        for (int t = 0; t < 16; ++t) { const float x = bf_us(xk[t]) * kkm; n2[t] = wave_total(x * x); }
        float g = 1.0f;
#pragma unroll
        for (int t = 0; t < 16; ++t) {
            const float w = __expf(-bf_us(xe[t])), a = bf_us(xa[t]), kft = bf_us(xk[t]), rft = bf_us(xr[t]);
            const float kk = kft * kkm * __builtin_amdgcn_rsqf(fmaxf(n2[t], 1e-24f));
            const float kp = kft * (1.0f + (a - 1.0f) * kam), kka = kk * a;
            const float cb = wave_total(rft * kp * rkm);
            const float gp = g; g *= w; const float ig = rcpf_(g);
            const size_t o = (row0 + t) * DM + ch;
            AA[o] = us_bf(-kk * gp); EW[o] = us_bf(kka * ig); K[o] = us_bf(kp * ig); R[o] = us_bf(rft * g);
            if (lane == 0) CB[(row0 + t) * 16 + h] = cb;
        }
        GC[((size_t)b * 256 + c) * DM + ch] = g;
    }
}

__device__ __forceinline__ void phase_rw_scan2(const P& p, LAS unsigned char* lds_, const bf16_t* R, const bf16_t* K, const bf16_t* V, const bf16_t* EW, const bf16_t* AA, const float* GC, bf16_t* OUT) {
    const int tid = otid(), lane = tid & 63, wid = __builtin_amdgcn_readfirstlane(tid >> 6), fr = lane & 15, fq = lane >> 4;
    volatile LAS unsigned* flags = (volatile LAS unsigned*)(lds_ + RW2_FLG);
    for (int un = blockIdx.x; un < 256; un += gridDim.x) {
        const int bh = un >> 2, rg = un & 3, b = bh >> 4, h = bh & 15;
        __syncthreads();
        if (tid < RW2_NS + 1) flags[tid] = 0u;
        __syncthreads();
        if (wid == 0) {
            f32x4 accS[4];
#pragma unroll
            for (int m = 0; m < 4; ++m) accS[m] = (f32x4){0.f, 0.f, 0.f, 0.f};
            __builtin_amdgcn_s_setprio(3);
            for (int c = 0; c < SEQL / 16; ++c) {
                const int slot = c & (RW2_NS - 1); LAS unsigned char* sl = lds_ + slot * RW2_SLOT;
                while (flags[slot] != (unsigned)(c + 1)) __builtin_amdgcn_s_sleep(1);
                LDS_FENCE();
                Frag8 Bs[2];
#pragma unroll
                for (int k2 = 0; k2 < 2; ++k2) { Bs[k2].u[0] = pk2(accS[2 * k2][0], accS[2 * k2][1]); Bs[k2].u[1] = pk2(accS[2 * k2][2], accS[2 * k2][3]);
                    Bs[k2].u[2] = pk2(accS[2 * k2 + 1][0], accS[2 * k2 + 1][1]); Bs[k2].u[3] = pk2(accS[2 * k2 + 1][2], accS[2 * k2 + 1][3]); }
                Frag8 A1[2], AR[2];
#pragma unroll
                for (int k2 = 0; k2 < 2; ++k2) {
                    const u32x2 x0 = *(const LAS u32x2*)(sl + SL_P1T + (fr * 72 + 32 * k2 + 4 * fq) * 2), x1 = *(const LAS u32x2*)(sl + SL_P1T + (fr * 72 + 32 * k2 + 16 + 4 * fq) * 2);
                    A1[k2].u[0] = x0[0]; A1[k2].u[1] = x0[1]; A1[k2].u[2] = x1[0]; A1[k2].u[3] = x1[1];
                    const u32x2 y0 = *(const LAS u32x2*)(sl + SL_RT + (fr * 72 + 32 * k2 + 4 * fq) * 2), y1 = *(const LAS u32x2*)(sl + SL_RT + (fr * 72 + 32 * k2 + 16 + 4 * fq) * 2);
                    AR[k2].u[0] = y0[0]; AR[k2].u[1] = y0[1]; AR[k2].u[2] = y1[0]; AR[k2].u[3] = y1[1];
                }
                const u32x2 a2 = *(const LAS u32x2*)(sl + SL_A2 + lane * 8), vp = *(const LAS u32x2*)(sl + SL_VP + lane * 8);
                Frag8 AM; { const pg8::u32x4 t4 = *(const LAS pg8::u32x4*)(sl + SL_AM + lane * 16); AM.u[0] = t4[0]; AM.u[1] = t4[1]; AM.u[2] = t4[2]; AM.u[3] = t4[3]; }
                Frag8 A2f, Bv; A2f.u[0] = 0u; A2f.u[1] = 0u; A2f.u[2] = a2[0]; A2f.u[3] = a2[1]; Bv.u[0] = 0u; Bv.u[1] = 0u; Bv.u[2] = vp[0]; Bv.u[3] = vp[1];
                f32x4 accU = {0.f, 0.f, 0.f, 0.f};
                accU = __builtin_amdgcn_mfma_f32_16x16x32_bf16(A1[0].v, Bs[0].v, accU, 0, 0, 0);
                accU = __builtin_amdgcn_mfma_f32_16x16x32_bf16(A1[1].v, Bs[1].v, accU, 0, 0, 0);
                accU = __builtin_amdgcn_mfma_f32_16x16x32_bf16(A2f.v, Bv.v, accU, 0, 0, 0);
                f32x4 accO = {0.f, 0.f, 0.f, 0.f};
                accO = __builtin_amdgcn_mfma_f32_16x16x32_bf16(AR[0].v, Bs[0].v, accO, 0, 0, 0);
                accO = __builtin_amdgcn_mfma_f32_16x16x32_bf16(AR[1].v, Bs[1].v, accO, 0, 0, 0);
                Frag8 Buv; Buv.u[0] = pk2(accU[0], accU[1]); Buv.u[1] = pk2(accU[2], accU[3]); Buv.u[2] = vp[0]; Buv.u[3] = vp[1];
                accO = __builtin_amdgcn_mfma_f32_16x16x32_bf16(AM.v, Buv.v, accO, 0, 0, 0);
#pragma unroll
                for (int m = 0; m < 4; ++m) {
                    const f32x4 gc = *(const LAS f32x4*)(sl + SL_GC + (16 * m + 4 * fq) * 4);
                    const u32x2 bp = *(const LAS u32x2*)(sl + SL_BPT + ((16 * m + fr) * 16 + 4 * fq) * 2), kp = *(const LAS u32x2*)(sl + SL_KPT + ((16 * m + fr) * 16 + 4 * fq) * 2);
                    Frag8 AS; AS.u[0] = bp[0]; AS.u[1] = bp[1]; AS.u[2] = kp[0]; AS.u[3] = kp[1];
                    f32x4 s = accS[m]; s[0] *= gc[0]; s[1] *= gc[1]; s[2] *= gc[2]; s[3] *= gc[3];
                    accS[m] = __builtin_amdgcn_mfma_f32_16x16x32_bf16(AS.v, Buv.v, s, 0, 0, 0);
                }
                LDS_FENCE();
                if (lane == 0) flags[RW2_NS] = (unsigned)(c + 1);
                const size_t row0 = (size_t)b * SEQL + (size_t)c * 16 + 4 * fq;
#pragma unroll
                for (int i = 0; i < 4; ++i) OUT[(row0 + i) * DM + h * 64 + rg * 16 + fr] = us_bf(accO[i]);
            }
            __builtin_amdgcn_s_setprio(0);
        } else if (wid <= RW2_NP) {
            const int pj = wid - 1; LAS unsigned char* sc = lds_ + RW2_NS * RW2_SLOT + pj * RW2_SCR;
            const int ch = h * 64 + lane; const float kkm = p.in[25][ch], kam = p.in[26][ch];
            const int ss = lane >> 3, sp8 = (lane & 7) * 8;
            pg8::u32x4 qR[2], qK[2], qE[2], qA[2]; unsigned qV[2]; float qG;
#define RW2_LOAD(ROW) do { _Pragma("unroll") for (int j2 = 0; j2 < 2; ++j2) { const size_t o_ = ((ROW) + ss + 8 * j2) * DM + h * 64 + sp8; \
                    qR[j2] = *(const pg8::u32x4*)(R + o_); qK[j2] = *(const pg8::u32x4*)(K + o_); qE[j2] = *(const pg8::u32x4*)(EW + o_); qA[j2] = *(const pg8::u32x4*)(AA + o_); } \
                    _Pragma("unroll") for (int i2 = 0; i2 < 2; ++i2) { const size_t ov = ((ROW) + 4 * fq + 2 * i2) * DM + h * 64 + rg * 16 + fr; qV[i2] = (unsigned)V[ov] | ((unsigned)V[ov + DM] << 16); } \
                    qG = GC[((ROW) >> 4) * DM + h * 64 + lane]; } while (0)
#define RAWK(t) bf_us(*(const LAS unsigned short*)(sc + SC_KT + ((t) * 72 + lane) * 2))
#define RAWE(t) bf_us(*(const LAS unsigned short*)(sc + SC_BT + ((t) * 72 + lane) * 2))
#define RAWA(t) bf_us(*(const LAS unsigned short*)(sl + SL_P1T + ((t) * 72 + lane) * 2))
#define RAWR(t) bf_us(*(const LAS unsigned short*)(sl + SL_RT + ((t) * 72 + lane) * 2))
            RW2_LOAD((size_t)b * SEQL + (size_t)pj * 16);
            for (int c = pj; c < SEQL / 16; c += RW2_NP) {
                const int slot = c & (RW2_NS - 1); LAS unsigned char* sl = lds_ + slot * RW2_SLOT;
                const size_t row0 = (size_t)b * SEQL + (size_t)c * 16;
                while ((int)flags[RW2_NS] < c - (RW2_NS - 1)) __builtin_amdgcn_s_sleep(2);
                LDS_FENCE();
#pragma unroll
                for (int j2 = 0; j2 < 2; ++j2) { const int so = ((ss + 8 * j2) * 72 + sp8) * 2;
                    *(LAS pg8::u32x4*)(sl + SL_RT + so) = qR[j2]; *(LAS pg8::u32x4*)(sc + SC_KT + so) = qK[j2]; *(LAS pg8::u32x4*)(sc + SC_BT + so) = qE[j2]; *(LAS pg8::u32x4*)(sl + SL_P1T + so) = qA[j2]; }
                *(LAS u32x2*)(sl + SL_VP + lane * 8) = (u32x2){qV[0], qV[1]};
                const float gCv = qG;
                LDS_FENCE();
                if (c + RW2_NP < SEQL / 16) RW2_LOAD(row0 + (size_t)RW2_NP * 16);
                {
                    pg8::u32x4 q0, q1;
#pragma unroll
                    for (int i = 0; i < 4; ++i) { q0[i] = pk2(RAWA(2 * i), RAWA(2 * i + 1)); q1[i] = pk2(RAWA(8 + 2 * i), RAWA(8 + 2 * i + 1)); }
                    *(LAS pg8::u32x4*)(sc + SC_ATT + lane * 32) = q0; *(LAS pg8::u32x4*)(sc + SC_ATT + lane * 32 + 16) = q1;
#pragma unroll
                    for (int i = 0; i < 4; ++i) { q0[i] = pk2(RAWE(2 * i) * gCv, RAWE(2 * i + 1) * gCv); q1[i] = pk2(RAWE(8 + 2 * i) * gCv, RAWE(8 + 2 * i + 1) * gCv); }
                    *(LAS pg8::u32x4*)(sl + SL_BPT + lane * 32) = q0; *(LAS pg8::u32x4*)(sl + SL_BPT + lane * 32 + 16) = q1;
#pragma unroll
                    for (int i = 0; i < 4; ++i) { q0[i] = pk2(RAWK(2 * i) * gCv, RAWK(2 * i + 1) * gCv); q1[i] = pk2(RAWK(8 + 2 * i) * gCv, RAWK(8 + 2 * i + 1) * gCv); }
                    *(LAS pg8::u32x4*)(sl + SL_KPT + lane * 32) = q0; *(LAS pg8::u32x4*)(sl + SL_KPT + lane * 32 + 16) = q1;
                    *(LAS float*)(sl + SL_GC + lane * 4) = gCv;
                }
                LDS_FENCE();
                f32x4 gba = {0.f, 0.f, 0.f, 0.f}, gka = gba, gbr = gba, gkr = gba;
#pragma unroll
                for (int k2 = 0; k2 < 2; ++k2) {
                    const int off = (fr * 72 + 32 * k2 + 8 * fq) * 2;
                    const bf16x8 fb = *(const LAS bf16x8*)(sc + SC_BT + off), fk = *(const LAS bf16x8*)(sc + SC_KT + off), fa = *(const LAS bf16x8*)(sl + SL_P1T + off), frt = *(const LAS bf16x8*)(sl + SL_RT + off);
                    gba = __builtin_amdgcn_mfma_f32_16x16x32_bf16(fb, fa, gba, 0, 0, 0); gka = __builtin_amdgcn_mfma_f32_16x16x32_bf16(fk, fa, gka, 0, 0, 0);
                    gbr = __builtin_amdgcn_mfma_f32_16x16x32_bf16(fb, frt, gbr, 0, 0, 0); gkr = __builtin_amdgcn_mfma_f32_16x16x32_bf16(fk, frt, gkr, 0, 0, 0);
                }
                {
                    Frag8 am;
#pragma unroll
                    for (int i = 0; i < 4; ++i) { const int ii = 4 * fq + i; const bool st = ii < fr, le = ii <= fr;
                        *(LAS float*)(sc + SC_L + (ii * 16 + fr) * 4) = st ? gba[i] : 0.f;
                        *(LAS unsigned short*)(sc + SC_LKA + (ii * 24 + fr) * 2) = us_bf(st ? gka[i] : 0.f);
                        gbr[i] = le ? gbr[i] : 0.f; gkr[i] = le ? gkr[i] : 0.f; }
                    am.u[0] = pk2(gbr[0], gbr[1]); am.u[1] = pk2(gbr[2], gbr[3]); am.u[2] = pk2(gkr[0], gkr[1]); am.u[3] = pk2(gkr[2], gkr[3]);
                    pg8::u32x4 t4; t4[0] = am.u[0]; t4[1] = am.u[1]; t4[2] = am.u[2]; t4[3] = am.u[3];
                    *(LAS pg8::u32x4*)(sl + SL_AM + lane * 16) = t4;
                }
                LDS_FENCE();
                float n[16];
#pragma unroll
                for (int j = 0; j < 16; ++j) n[j] = (fr == j) ? 1.0f : 0.f;
#pragma unroll
                for (int i = 14; i >= 0; --i) {
                    if ((i & 1) == 0) asm volatile("" ::: "memory");
                    float Lr[16];
#pragma unroll
                    for (int q = 0; q < 4; ++q) { const f32x4 t4 = *(const LAS f32x4*)(sc + SC_L + (i * 16 + q * 4) * 4); Lr[q * 4] = t4[0]; Lr[q * 4 + 1] = t4[1]; Lr[q * 4 + 2] = t4[2]; Lr[q * 4 + 3] = t4[3]; }
                    float a0 = n[i], a1 = 0.f, a2 = 0.f, a3 = 0.f;
#pragma unroll
                    for (int j = i + 1; j < 16; ++j) { if (((j - i) & 3) == 1) a0 = fmaf(Lr[j], n[j], a0); else if (((j - i) & 3) == 2) a1 = fmaf(Lr[j], n[j], a1); else if (((j - i) & 3) == 3) a2 = fmaf(Lr[j], n[j], a2); else a3 = fmaf(Lr[j], n[j], a3); }
                    n[i] = (a0 + a1) + (a2 + a3);
                }
                {
                    pg8::u32x4 q0, q1;
#pragma unroll
                    for (int i = 0; i < 4; ++i) { q0[i] = pk2(n[2 * i], n[2 * i + 1]); q1[i] = pk2(n[8 + 2 * i], n[8 + 2 * i + 1]); }
                    if (fq == 0) { *(LAS pg8::u32x4*)(sc + SC_NT + fr * 48) = q0; *(LAS pg8::u32x4*)(sc + SC_NT + fr * 48 + 16) = q1; }
                }
                LDS_FENCE();
                const bf16x8 z8 = {0, 0, 0, 0, 0, 0, 0, 0};
                const bf16x8 fnt = fq < 2 ? *(const LAS bf16x8*)(sc + SC_NT + fr * 48 + fq * 16) : z8;
                const bf16x8 flk = fq < 2 ? *(const LAS bf16x8*)(sc + SC_LKA + fr * 48 + fq * 16) : z8;
                f32x4 z4 = {0.f, 0.f, 0.f, 0.f};
                const f32x4 d2 = __builtin_amdgcn_mfma_f32_16x16x32_bf16(flk, fnt, z4, 0, 0, 0);
                *(LAS u32x2*)(sl + SL_A2 + lane * 8) = (u32x2){pk2(d2[0], d2[1]), pk2(d2[2], d2[3])};
#pragma unroll
                for (int tl = 0; tl < 4; ++tl) {
                    const bf16x8 fat = fq < 2 ? *(const LAS bf16x8*)(sc + SC_ATT + (16 * tl + fr) * 32 + fq * 16) : z8;
                    const f32x4 d = __builtin_amdgcn_mfma_f32_16x16x32_bf16(fnt, fat, z4, 0, 0, 0);
#pragma unroll
                    for (int i = 0; i < 4; ++i) *(LAS unsigned short*)(sl + SL_P1T + ((4 * fq + i) * 72 + 16 * tl + fr) * 2) = us_bf(d[i]);
                }
                LDS_FENCE();
                if (lane == 0) flags[slot] = (unsigned)(c + 1);
            }
        }
    }
}

#undef RW2_LOAD
#undef RAWK
#undef RAWE
#undef RAWA
#undef RAWR
__device__ __forceinline__ void phase_rw_post(const P& p, const bf16_t* OUT, const float* CB, const bf16_t* V, const bf16_t* SZ, bf16_t* OF) {
    const size_t nth = (size_t)gridDim.x * 512;
    for (size_t it = (size_t)blockIdx.x * 512 + otid(); it < (size_t)MTOK * 128; it += nth) {
        const int c0 = (int)(it & 127) * 8; const size_t row = it >> 7, o = row * DM + c0;
        float ov[8], v[8], sz[8];
        unpack8(*(const uint4*)(OUT + o), ov); unpack8(*(const uint4*)(V + o), v); unpack8(*(const uint4*)(SZ + o), sz);
        const float dot = CB[row * 16 + (c0 >> 6)];
        float sm = 0.f;
#pragma unroll
        for (int i = 0; i < 8; ++i) sm += ov[i];
        const float mean = red8(sm) * (1.0f / 64.0f);
        float q = 0.f;
#pragma unroll
        for (int i = 0; i < 8; ++i) { ov[i] -= mean; q += ov[i] * ov[i]; }
        const float rs = rsqrtf(red8(q) * (1.0f / 64.0f) + 64e-5f);
        float y[8];
#pragma unroll
        for (int i = 0; i < 8; ++i) y[i] = (ov[i] * rs * p.in[28][c0 + i] + p.in[29][c0 + i] + dot * v[i]) * sz[i];
        *(uint4*)(OF + o) = make_uint4(pk2(y[0], y[1]), pk2(y[2], y[3]), pk2(y[4], y[5]), pk2(y[6], y[7]));
    }
}

__global__ void __launch_bounds__(512, 2) fwd_mega(P p) {
    extern __shared__ __attribute__((aligned(16))) unsigned char shm[];
    LAS unsigned char* lds = (LAS unsigned char*)shm;
    LAS float* tile = (LAS float*)shm;
    cg::grid_group grid = cg::this_grid();
    volatile LAS unsigned* xst = (volatile LAS unsigned*)(lds + LDS_XST);
    if (threadIdx.x == 0) { xst[0] = 0u; xst[1] = 0u; }
    __syncthreads();
    const XcdBarrier xb = xcd_barrier_post((unsigned*)(p.ws + BAR_OFF), xst);
    unsigned char* ws = p.ws; float* X = p.out;
    bf16_t* act = (bf16_t*)(ws + ACT); bf16_t* pb = (bf16_t*)(ws + PB);
    phase_prep(p, tile);
    grid.sync();
    for (int d = 0; d < DUP_PREP; ++d) { phase_prep(p, tile); xcd_barrier(xb); }
    for (int d = 0; d < DUP_SYNC; ++d) xcd_barrier(xb);
#define LAYER_TAIL(L, Aout, Wout, Wpe, Wpg, PEB) \
    { EpiWout E; E.X = X; E.RB = act; run_gemm(lds, Aout, Wout, 1024, 1024, E); } \
    { EpiBf16 E; E.O = PEB; E.ldo = 1024; E.split = 1 << 20; E.stride = 0; run_gemm(lds, pb, Wpe, 1024, 256, E); } \
    xcd_barrier(xb); \
    { EpiPle E; E.X = X; E.PE = PEB; run_gemm(lds, act, Wpg, 1024, 1024, E); } \
    xcd_barrier(xb); \
    phase_ln(X, act, p.in[33] + (L) * 1024, p.in[34] + (L) * 1024);
#define CONV_LAYER(L, j) { \
        bf16_t* U = (bf16_t*)(ws + T0); bf16_t* G = (bf16_t*)(ws + T0 + 32 * MiB); \
        { EpiConvIn E; E.U = U; E.G = G; run_gemm(lds, act, (const bf16_t*)(ws + W_CIN), 4096, 1024, E); } \
        xcd_barrier(xb); \
        phase_conv_ew(U, G, p.in[3] + (size_t)(j) * 3 * 1024); \
        if ((L) > 0) cvt_pb(p.in[1] + (size_t)(L) * MTOK * 256, pb); \
        xcd_barrier(xb); \
        LAYER_TAIL(L, G, (const bf16_t*)(ws + W_COUT), (const bf16_t*)(ws + W_PEC), (const bf16_t*)(ws + W_PGC), (bf16_t*)(ws + T0 + 64 * MiB)) }
    CONV_LAYER(0, 0)
    xcd_barrier(xb);
    {
        float* U = (float*)(ws + T0); bf16_t* SZ = (bf16_t*)(ws + T0 + 64 * MiB); bf16_t* YG = (bf16_t*)(ws + T0 + 96 * MiB); bf16_t* V = (bf16_t*)(ws + T0 + 128 * MiB);
        float* HL = (float*)(ws + T0 + 160 * MiB);
        { EpiSsmIn E; E.U = U; E.SZ = SZ; run_gemm(lds, act, (const bf16_t*)(ws + W_SIN), 2048, 1024, E); }
        xcd_barrier(xb);
        phase_s5<0>(p, lds, U, HL, YG);
        cvt_pb(p.in[1] + (size_t)1 * MTOK * 256, pb);
        xcd_barrier(xb);
        phase_s5<1>(p, lds, U, HL, YG);
        xcd_barrier(xb);
        for (int d = 0; d < DUP_S5; ++d) { phase_s5<0>(p, lds, U, HL, YG); xcd_barrier(xb); phase_s5<1>(p, lds, U, HL, YG); xcd_barrier(xb); }
        { EpiGlu E; E.YG = YG; E.SZ = SZ; E.bias = p.in[15]; E.V = V; run_gemm(lds, YG, (const bf16_t*)(ws + W_SGLU), 1024, 1024, E); }
        xcd_barrier(xb);
        LAYER_TAIL(1, V, (const bf16_t*)(ws + W_SOUT), (const bf16_t*)(ws + W_PE1), (const bf16_t*)(ws + W_PG1), (bf16_t*)(ws + T0))
    }
    xcd_barrier(xb);
    {
        bf16_t* XS = (bf16_t*)(ws + T0); bf16_t* RKV = (bf16_t*)(ws + T0 + 64 * MiB);
        bf16_t* Rb = RKV; bf16_t* Kb = RKV + (size_t)MTOK * DM; bf16_t* Vb = RKV + (size_t)2 * MTOK * DM;
        bf16_t* SZ = act; bf16_t* L1 = pb; bf16_t* DW = (bf16_t*)(ws + T0); bf16_t* DA = (bf16_t*)(ws + T0 + 32 * MiB);
        bf16_t* OUT = (bf16_t*)(ws + OUT_RW); bf16_t* OF = (bf16_t*)(ws + T0);
        const bf16_t* Wrk = (const bf16_t*)(ws + W_RK);
        phase_rw_prep(X, XS, p.in[17], p.in[17] + 1024);
        xcd_barrier(xb);
        { EpiBf16 E; E.O = Rb; E.ldo = 1024; E.split = 1 << 20; E.stride = 0; run_gemm(lds, XS, Wrk, 1024, 1024, E); }
        { EpiBf16 E; E.O = Kb; E.ldo = 1024; E.split = 1 << 20; E.stride = 0; run_gemm(lds, XS + (size_t)MTOK * DM, Wrk + (size_t)1024 * 1024, 1024, 1024, E); }
        phase_rw_lora1(lds, X, Wrk + (size_t)4096 * 1024, L1);
        xcd_barrier(xb);
        phase_rw_prep(X, XS, p.in[17] + 2 * 1024, p.in[17] + 3 * 1024);
        xcd_barrier(xb);
        { EpiBf16 E; E.O = Vb; E.ldo = 1024; E.split = 1 << 20; E.stride = 0; run_gemm(lds, XS, Wrk + (size_t)2 * 1024 * 1024, 1024, 1024, E); }
        { EpiBf16T<1> E; E.O = SZ; E.ldo = 1024; E.split = 1 << 20; E.stride = 0; run_gemm(lds, XS + (size_t)MTOK * DM, Wrk + (size_t)3 * 1024 * 1024, 1024, 1024, E); }
        xcd_barrier(xb);
        { EpiLora2 E; E.EW = DW; E.AA = DA; E.w0 = p.in[19]; E.a0 = p.in[22]; run_gemm(lds, L1, (const bf16_t*)(ws + W_L2), 2048, 256, E); }
        xcd_barrier(xb);
        float* GCb = (float*)(ws + T0 + 160 * MiB); float* CBb = (float*)(ws + T0 + 165 * MiB);
        phase_rw_tables(p, Rb, Kb, DW, DA, GCb, CBb);
        xcd_barrier(xb);
        phase_rw_scan2(p, lds, Rb, Kb, Vb, DW, DA, GCb, OUT);
        xcd_barrier(xb);
        for (int d = 0; d < DUP_RWSCAN; ++d) { phase_rw_scan<DUP_MODE>(p, lds, Rb, Kb, Vb, DW, DA, OUT); xcd_barrier(xb); }
        phase_rw_post(p, OUT, CBb, Vb, SZ, OF);
        cvt_pb(p.in[1] + (size_t)2 * MTOK * 256, pb);
        xcd_barrier(xb);
        LAYER_TAIL(2, OF, (const bf16_t*)(ws + W_ROUT), (const bf16_t*)(ws + W_PE2), (const bf16_t*)(ws + W_PG2), (bf16_t*)(ws + T0 + 32 * MiB))
        __syncthreads();
        conv_layer_weights(p, tile, 1, 3);
    }
    xcd_barrier(xb);
    CONV_LAYER(3, 1)
}

extern "C" void kernel_launch(void* const* d_in, const int* in_sizes, int n_in, void* d_out, int out_size, void* d_ws, size_t ws_size, hipStream_t stream) {
    static int grid_blocks = 0;
    if (!grid_blocks) {
        int dev = 0, cus = 0, per_cu = 0;
        hipGetDevice(&dev);
        hipDeviceGetAttribute(&cus, hipDeviceAttributeMultiprocessorCount, dev);
        hipFuncSetAttribute((const void*)fwd_mega, hipFuncAttributeMaxDynamicSharedMemorySize, LDS_BYTES);
        hipOccupancyMaxActiveBlocksPerMultiprocessor(&per_cu, (const void*)fwd_mega, 512, LDS_BYTES);
        if (per_cu < 1) { fprintf(stderr, "occupancy query returned %d\n", per_cu); per_cu = 1; }
        grid_blocks = cus;
        if (ws_size < 256 * MiB) fprintf(stderr, "workspace too small: %zu\n", ws_size);
    }
    P p{};
    for (int i = 0; i < 35; ++i) p.in[i] = (const float*)d_in[i];
    p.out = (float*)d_out; p.ws = (unsigned char*)d_ws;
    hipMemsetAsync((unsigned char*)d_ws + BAR_OFF, 0, XCD_BAR_WORDS * sizeof(unsigned), stream);
    void* args[] = {&p};
    hipError_t e = hipLaunchCooperativeKernel((const void*)fwd_mega, dim3(grid_blocks), dim3(512), args, LDS_BYTES, stream);
    if (e != hipSuccess) fprintf(stderr, "cooperative launch failed: %s (grid %d)\n", hipGetErrorString(e), grid_blocks);
}
```

```cpp
#include <hip/hip_runtime.h>
#include <hip/hip_cooperative_groups.h>
#include <cstdio>
namespace cg = cooperative_groups;
namespace pg8 {
#define PG8_LAS __attribute__((address_space(3)))
typedef unsigned short bf16_t;
typedef short bf16x8 __attribute__((ext_vector_type(8)));
typedef float f32x4 __attribute__((ext_vector_type(4)));
typedef unsigned u32x4 __attribute__((ext_vector_type(4)));
constexpr int BM = 256, BK = 64, HALF = 128, HTB = HALF * BK * 2  , STAGE_BYTES = 8 * HTB, NXCD = 8, WGM = 8;

__host__ __device__ __forceinline__ int lds_byte(int r, int c) { const int st = (r >> 4) * 2 + (c >> 5), rr = r & 15, cc = c & 31, ob = rr * 64 + cc * 2; return st * 1024 + (ob ^ (((ob >> 9) & 1) << 5)); }
__host__ __device__ __forceinline__ void stage_rc(int b, int& R, int& C) { const int st = b / 1024, sb = b % 1024, swz = sb ^ (((sb >> 9) & 1) << 5); R = (st >> 1) * 16 + swz / 64; C = (st & 1) * 32 + (swz % 64) / 2; }
__host__ __device__ __forceinline__ int perm32(int rho) { const int n = rho >> 4, i = rho & 15; return 8 * (i >> 2) + 4 * n + (i & 3); }

struct Unit { int pm, pn; };
struct Gemm { const bf16_t* A; const bf16_t* Bt; int M, N, K; };
struct StaticOrder {
    int nM, nN, nwg, G, c;
    __host__ __device__ void init(int M, int N, int G_, int c_) { nM = M / BM; nN = N / BM; nwg = nM * nN; G = G_; c = c_; }
    __host__ __device__ bool next(int i, Unit& u) const {
        const long L = (long)i * G + c; if (L >= nwg) return false;
        int wgid = (int)L; { const int q = nwg / NXCD, r = nwg % NXCD, xcd = wgid % NXCD, off = wgid / NXCD; wgid = (xcd < r ? xcd * (q + 1) : r * (q + 1) + (xcd - r) * q) + off; }
        const int nig = WGM * nN, gid = wgid / nig, fm = gid * WGM, gsz = (nM - fm) < WGM ? (nM - fm) : WGM;
        u.pm = fm + ((wgid % nig) % gsz); u.pn = (wgid % nig) / gsz; return true;
    }
    __device__ __forceinline__ void a_ready(const Unit&) const {}
    __device__ __forceinline__ void done(const Unit&) const {}
};
__device__ __forceinline__ unsigned cvt_pk_bf16(float lo, float hi) { unsigned r; asm volatile("v_cvt_pk_bf16_f32 %0, %1, %2" : "=v"(r) : "v"(lo), "v"(hi)); return r; }
template <class Epi, class Sched, bool STAMP = false>
__device__ __forceinline__ void gemm_phase(PG8_LAS unsigned char* lds, const Gemm g, const Sched& S, const Epi& E, unsigned long long* stamps) {
    int tid_o = threadIdx.x; asm volatile("" : "+v"(tid_o)); const int tid = tid_o, wid = __builtin_amdgcn_readfirstlane(tid >> 6), lane = tid & 63, wr = wid >> 2, wc = wid & 3, fr = lane & 15, fq = lane >> 4;
    const int K = g.K, nt = K / BK;
    int ts_lo = 0, ts_hi = 0, nts = 0; const unsigned long long rt_entry = STAMP ? (unsigned long long)wall_clock64() : 0ull;
#define PG8_STAMP() do { if (STAMP && wid == 0 && nts < 64) { const unsigned long long _c = (unsigned long long)clock64(); \
        ts_lo = (lane == nts) ? (int)(unsigned)_c : ts_lo; ts_hi = (lane == nts) ? (int)(unsigned)(_c >> 32) : ts_hi; ++nts; } } while (0)
    PG8_STAMP();
    unsigned voffA[2], voffB[2];
#pragma unroll
    for (int i = 0; i < 2; ++i) { int R, C; stage_rc(tid * 16 + i * 8192, R, C); const int Rb = Epi::PERM ? ((R & ~31) + perm32(R & 31)) : R;
        voffA[i] = (unsigned)(R * K + C) * 2u; voffB[i] = (unsigned)(Rb * K + C) * 2u; }
    const size_t kstep = (size_t)(BK * 2);
    const size_t hstep = (size_t)HALF * K * 2;
    const size_t tstep = 2 * hstep;
    const unsigned ldsw = (unsigned)wid * 1024u;
    const int aoff = lds_byte(wr * 64 + fr, fq * 8), boff = lds_byte(wc * 32 + fr, fq * 8);
#define PG8_SA(b, h) (((b) * 2 + (h)) * HTB)
#define PG8_SB(b, h) ((4 + (b) * 2 + (h)) * HTB)
#define PG8_STAGE(bufoff, gbase, voff) do { _Pragma("unroll") for (int _i = 0; _i < 2; ++_i) \
        __builtin_amdgcn_global_load_lds((const unsigned*)((const char*)(gbase) + (voff)[_i]), (PG8_LAS unsigned*)(lds + (bufoff) + ldsw + _i * 8192), 16, 0, 0); } while (0)
#define PG8_LDA(dst, b, h) do { _Pragma("unroll") for (int m = 0; m < 4; ++m) _Pragma("unroll") for (int k = 0; k < 2; ++k) dst[m][k] = *(const PG8_LAS bf16x8*)(lds + PG8_SA(b, h) + aoff + m * 2048 + k * 1024); } while (0)
#define PG8_LDB(dst, b, h) do { _Pragma("unroll") for (int n = 0; n < 2; ++n) _Pragma("unroll") for (int k = 0; k < 2; ++k) dst[n][k] = *(const PG8_LAS bf16x8*)(lds + PG8_SB(b, h) + boff + n * 2048 + k * 1024); } while (0)
#define PG8_MMA(ai, bj, At, Bt) do { __builtin_amdgcn_s_setprio(1); _Pragma("unroll") for (int m = 0; m < 4; ++m) _Pragma("unroll") for (int n = 0; n < 2; ++n) _Pragma("unroll") for (int k = 0; k < 2; ++k) \
        acc[ai][bj][m][n] = __builtin_amdgcn_mfma_f32_16x16x32_bf16(Bt[n][k], At[m][k], acc[ai][bj][m][n], 0, 0, 0); __builtin_amdgcn_s_setprio(0); } while (0)
#define PG8_WAIT_V(n) asm volatile("s_waitcnt vmcnt(" #n ")" ::: "memory")
#define PG8_WAIT_L(n) asm volatile("s_waitcnt lgkmcnt(" #n ")" ::: "memory")
#define PG8_BAR __builtin_amdgcn_s_barrier()
#define PG8_SCHED __builtin_amdgcn_sched_barrier(0)
    Unit cur, nxt; int ui = 0;
    if (!S.next(0, cur)) return;
    f32x4 acc[2][2][4][2];
#pragma unroll
    for (int a = 0; a < 2; ++a)
#pragma unroll
        for (int b = 0; b < 2; ++b)
#pragma unroll
            for (int m = 0; m < 4; ++m)
#pragma unroll
                for (int n = 0; n < 2; ++n) acc[a][b][m][n] = (f32x4){0.f, 0.f, 0.f, 0.f};
    bf16x8 At[4][2], B0[2][2], B1[2][2];
    const char* cA = (const char*)g.A + (size_t)cur.pm * tstep; const char* cB = (const char*)g.Bt + (size_t)cur.pn * tstep;
    S.a_ready(cur);
    PG8_STAGE(PG8_SB(0, 0), cB, voffB); PG8_STAGE(PG8_SA(0, 0), cA, voffA); PG8_STAGE(PG8_SB(0, 1), cB + hstep, voffB); PG8_STAGE(PG8_SA(0, 1), cA + hstep, voffA);
    if (wr == 1) PG8_BAR;
    PG8_WAIT_V(4); PG8_BAR;
    PG8_STAGE(PG8_SB(1, 0), cB + kstep, voffB); PG8_STAGE(PG8_SA(1, 0), cA + kstep, voffA); PG8_STAGE(PG8_SB(1, 1), cB + hstep + kstep, voffB);
    PG8_WAIT_V(6); PG8_BAR;
    PG8_STAMP();
    for (;;) {
        const bool has_next = S.next(ui + 1, nxt);
        const char* nA = has_next ? (const char*)g.A + (size_t)nxt.pm * tstep : cA; const char* nB = has_next ? (const char*)g.Bt + (size_t)nxt.pn * tstep : cB;
        for (int t = 0; t < nt; t += 2) {
            const bool last = (t == nt - 2);
            const char* a1 = cA + (size_t)(t + 1) * kstep;
            const char* a2 = last ? nA : cA + (size_t)(t + 2) * kstep; const char* b2 = last ? nB : cB + (size_t)(t + 2) * kstep;
            const char* a3 = a2 + kstep; const char* b3 = b2 + kstep;
            if (last && has_next) S.a_ready(nxt);
            PG8_LDB(B0, 0, 0); PG8_SCHED; PG8_LDA(At, 0, 0); PG8_STAGE(PG8_SA(1, 1), a1 + hstep, voffA);
            PG8_WAIT_L(8); PG8_BAR; PG8_WAIT_L(0); PG8_MMA(0, 0, At, B0); PG8_BAR; PG8_SCHED;
            PG8_LDB(B1, 0, 1); PG8_STAGE(PG8_SB(0, 0), b2, voffB);
            PG8_BAR; PG8_WAIT_L(0); PG8_MMA(0, 1, At, B1); PG8_BAR;
            PG8_LDA(At, 0, 1); PG8_STAGE(PG8_SA(0, 0), a2, voffA);
            PG8_BAR; PG8_WAIT_L(0); PG8_MMA(1, 0, At, B0); PG8_BAR; PG8_SCHED;
            PG8_STAGE(PG8_SB(0, 1), b2 + hstep, voffB);
            PG8_WAIT_V(6); PG8_BAR; PG8_MMA(1, 1, At, B1); PG8_BAR;
            PG8_LDB(B0, 1, 0); PG8_SCHED; PG8_LDA(At, 1, 0); PG8_STAGE(PG8_SA(0, 1), a2 + hstep, voffA);
            PG8_WAIT_L(8); PG8_BAR; PG8_WAIT_L(0); PG8_MMA(0, 0, At, B0); PG8_BAR; PG8_SCHED;
            PG8_LDB(B1, 1, 1); PG8_STAGE(PG8_SB(1, 0), b3, voffB);
            PG8_BAR; PG8_WAIT_L(0); PG8_MMA(0, 1, At, B1); PG8_BAR;
            PG8_LDA(At, 1, 1); PG8_STAGE(PG8_SA(1, 0), a3, voffA);
            PG8_BAR; PG8_WAIT_L(0); PG8_MMA(1, 0, At, B0); PG8_BAR; PG8_SCHED;
            PG8_STAGE(PG8_SB(1, 1), b3 + hstep, voffB);
            PG8_WAIT_V(6); PG8_BAR; PG8_MMA(1, 1, At, B1); PG8_BAR;
        }
        PG8_STAMP();
        if constexpr (!Epi::AFTER_DRAIN) { E(acc, cur, wr, wc, fr, fq); S.done(cur); }
        PG8_STAMP();
        if (!has_next) break;
#pragma unroll
        for (int a = 0; a < 2; ++a)
#pragma unroll
            for (int b = 0; b < 2; ++b)
#pragma unroll
                for (int m = 0; m < 4; ++m)
#pragma unroll
                    for (int n = 0; n < 2; ++n) acc[a][b][m][n] = (f32x4){0.f, 0.f, 0.f, 0.f};
        cur = nxt; cA = nA; cB = nB; ++ui;
    }
    PG8_WAIT_V(0);
    if (wr == 0) PG8_BAR;
    PG8_BAR;
    if constexpr (Epi::AFTER_DRAIN) { E.fused(acc, cur, wr, wc, fr, fq, lds, wid, lane); S.done(cur); }
    PG8_STAMP();
    if (STAMP && wid == 0) { stamps[lane] = lane < nts ? (((unsigned long long)(unsigned)ts_hi << 32) | (unsigned)ts_lo) : 0ull;
        if (lane == 62) stamps[62] = rt_entry; if (lane == 63) stamps[63] = (unsigned long long)wall_clock64(); }
#undef PG8_STAMP
#undef PG8_SA
#undef PG8_SB
#undef PG8_STAGE
#undef PG8_LDA
#undef PG8_LDB
#undef PG8_MMA
#undef PG8_WAIT_V
#undef PG8_WAIT_L
#undef PG8_BAR
#undef PG8_SCHED
}
}
using pg8::bf16_t; using pg8::bf16x8; using pg8::f32x4; using pg8::Unit; using pg8::Gemm; using pg8::StaticOrder;
#define LAS __attribute__((address_space(3)))
constexpr int MTOK = 16384, DM = 1024, SEQL = 4096;
constexpr size_t MiB = 1u << 20, KiB = 1u << 10;
constexpr float DN_ALPHA = 1.6817928305074290f;
constexpr size_t W_CIN = 0, W_COUT = 8 * MiB, W_PEC = 10 * MiB, W_PGC = 10 * MiB + 512 * KiB;
constexpr size_t W_SIN = 12 * MiB + 512 * KiB, W_SGLU = 16 * MiB + 512 * KiB, W_SOUT = 18 * MiB + 512 * KiB, W_PE1 = 20 * MiB + 512 * KiB, W_PG1 = 21 * MiB;
constexpr size_t W_RK = 23 * MiB, W_L2 = 40 * MiB, W_ROUT = 41 * MiB, W_PE2 = 43 * MiB, W_PG2 = 43 * MiB + 512 * KiB;
constexpr size_t OUT_RW = 0, PB = 46 * MiB, ACT = 54 * MiB, T0 = 86 * MiB;
constexpr int LDS_XST = 155648;
constexpr int LDS_BYTES = LDS_XST + 16;
#ifndef DUP_PREP
#define DUP_PREP 0
#define DUP_RWSCAN 0
#define DUP_S5 0
#define DUP_RK 0
#define DUP_SYNC 0
#define DUP_EW 0
#endif
#ifndef DUP_MODE
#define DUP_MODE 0
#endif

struct P { const float* in[35]; float* out; unsigned char* ws; };
#define XB_TMO      128
#define XB_XCNT(j)  (256  + 64 * (j))
#define XB_XSUB(j)  (1280 + 64 * (j))
#define XB_XGEN(j)  (2304 + 64 * (j))
#define XB_TOP      3328
#define XB_TOPGEN   3392
#define XCD_BAR_WORDS 3456
#define XB_SPIN_CAP (1u << 18)

__device__ __forceinline__ unsigned xb_ld(unsigned* p)              { return __hip_atomic_load(p, __ATOMIC_RELAXED, __HIP_MEMORY_SCOPE_AGENT); }
__device__ __forceinline__ unsigned xb_add(unsigned* p, unsigned v) { return __hip_atomic_fetch_add(p, v, __ATOMIC_RELAXED, __HIP_MEMORY_SCOPE_AGENT); }
__device__ __forceinline__ unsigned xb_xcc_id() { return (unsigned)__builtin_amdgcn_s_getreg((3 << 11) | 20) & 0xFu; }
#define XB_SPIN(cond, bar) do { unsigned _sp = 0; while (cond) { __builtin_amdgcn_s_sleep(1); \
    if ((++_sp & 255u) == 0u) { if (xb_ld(&(bar)[XB_TMO])) break; if (_sp > XB_SPIN_CAP) { atomicAdd(&(bar)[XB_TMO], 1u); break; } } } } while (0)

struct XcdBarrier {
    unsigned* bar; unsigned x;
    volatile LAS unsigned* st;
};

__device__ __forceinline__ XcdBarrier xcd_barrier_post(unsigned* bar, volatile LAS unsigned* st) {
    XcdBarrier b; b.bar = bar; b.x = xb_xcc_id(); b.st = st;
    if (threadIdx.x == 0) (void)xb_add(&bar[XB_XCNT(b.x)], 1u);
    return b;
}
__device__ __forceinline__ void xcd_barrier_complete(unsigned* bar, unsigned x, unsigned& nloc, unsigned& nx) {
    const unsigned G = gridDim.x * gridDim.y * gridDim.z;
    unsigned sum, cnt, mine, sp = 0u;
    for (;;) {
        sum = 0u; cnt = 0u; mine = 0u;
#pragma unroll
        for (unsigned j = 0; j < 16; ++j) { const unsigned c = xb_ld(&bar[XB_XCNT(j)]); sum += c; cnt += (c > 0u) ? 1u : 0u; mine = (j == x) ? c : mine; }
        if (sum == G) break;
        __builtin_amdgcn_s_sleep(1);
        if ((++sp & 255u) == 0u) { if (xb_ld(&bar[XB_TMO])) break; if (sp > XB_SPIN_CAP) { atomicAdd(&bar[XB_TMO], 1u); break; } }
    }
    nloc = mine > 0u ? mine : 1u; nx = cnt > 0u ? cnt : 1u;
}

__device__ __forceinline__ void xcd_barrier(const XcdBarrier& b) {
    asm volatile("s_waitcnt vmcnt(0)" ::: "memory");
    __syncthreads();
    if (threadIdx.x == 0) {
        unsigned* bar = b.bar;
        __builtin_amdgcn_s_waitcnt(0);
        unsigned nloc = b.st[0], nx = b.st[1];
        if (nloc == 0u) { xcd_barrier_complete(bar, b.x, nloc, nx); b.st[0] = nloc; b.st[1] = nx; }
        const unsigned old = xb_add(&bar[XB_XSUB(b.x)], 1u);
        const unsigned gen = old / nloc;
        if (old + 1u == (gen + 1u) * nloc) {
            __builtin_amdgcn_fence(__ATOMIC_RELEASE, "agent");
            asm volatile("s_waitcnt vmcnt(0)" ::: "memory");
            const unsigned og = xb_add(&bar[XB_TOP], 1u);
            const unsigned tg = og / nx;
            if (og + 1u == (tg + 1u) * nx) xb_add(&bar[XB_TOPGEN], 1u);
            else XB_SPIN(xb_ld(&bar[XB_TOPGEN]) == tg, bar);
            __builtin_amdgcn_fence(__ATOMIC_ACQUIRE, "agent");
            xb_add(&bar[XB_XGEN(b.x)], 1u);
            asm volatile("s_waitcnt vmcnt(0)" ::: "memory");
        } else {
            XB_SPIN(xb_ld(&bar[XB_XGEN(b.x)]) == gen, bar);
            __builtin_amdgcn_fence(__ATOMIC_ACQUIRE, "agent");
            asm volatile("s_waitcnt vmcnt(0)" ::: "memory");
        }
    }
    __syncthreads();
}

constexpr size_t BAR_OFF = 254 * MiB;


typedef __bf16 bf2_t __attribute__((ext_vector_type(2)));
typedef float f2_t __attribute__((ext_vector_type(2)));
__device__ __forceinline__ unsigned pk2(float lo, float hi) { f2_t v = {lo, hi}; bf2_t b = __builtin_convertvector(v, bf2_t); return __builtin_bit_cast(unsigned, b); }
__device__ __forceinline__ float bflo(unsigned u) { return __uint_as_float(u << 16); }
__device__ __forceinline__ float bfhi(unsigned u) { return __uint_as_float(u & 0xffff0000u); }
__device__ __forceinline__ float rcpf_(float x) { return __builtin_amdgcn_rcpf(x); }
__device__ __forceinline__ float sigmoidf_(float x) { return rcpf_(1.0f + __expf(-x)); }
__device__ __forceinline__ float siluf_(float x) { return x * rcpf_(1.0f + __expf(-x)); }
__device__ __forceinline__ float tanhf_(float x) { const float e = __expf(-2.0f * fabsf(x)); const float t = (1.0f - e) * rcpf_(1.0f + e); return x < 0.f ? -t : t; }
__device__ __forceinline__ float gelu_tanh(float x) { return 0.5f * x * (1.0f + tanhf_(0.7978845608028654f * (x + 0.044715f * x * x * x))); }
template <int CTRL> __device__ __forceinline__ float dppf(float x) { return __int_as_float(__builtin_amdgcn_update_dpp(0, __float_as_int(x), CTRL, 0xF, 0xF, true)); }
__device__ __forceinline__ float red8(float x) { x += dppf<0xB1>(x); x += dppf<0x4E>(x); x += dppf<0x141>(x); return x; }
__device__ __forceinline__ float red16(float x) { x = red8(x); x += dppf<0x140>(x); return x; }
__device__ __forceinline__ float wave_sum(float v) { for (int o = 32; o >= 1; o >>= 1) v += __shfl_xor(v, o); return v; }
__device__ __forceinline__ int otid() { int t = threadIdx.x; asm volatile("" : "+v"(t)); return t; }
typedef float f32x2 __attribute__((ext_vector_type(2)));
__device__ __forceinline__ float fma_s(float a, float b, float c) { float d; asm("v_fma_f32 %0, %1, %2, %3" : "=v"(d) : "v"(a), "v"(b), "v"(c)); return d; }
__device__ __forceinline__ float fnma_s(float a, float b, float c) { float d; asm("v_fma_f32 %0, -%1, %2, %3" : "=v"(d) : "v"(a), "v"(b), "v"(c)); return d; }
__device__ __forceinline__ float mul_s(float a, float b) { float d; asm("v_mul_f32 %0, %1, %2" : "=v"(d) : "v"(a), "v"(b)); return d; }
__device__ __forceinline__ float add_s(float a, float b) { float d; asm("v_add_f32 %0, %1, %2" : "=v"(d) : "v"(a), "v"(b)); return d; }
#define BAR_LDS() asm volatile("s_waitcnt lgkmcnt(0)\n\ts_barrier" ::: "memory")
#define LDS_FENCE() asm volatile("s_waitcnt lgkmcnt(0)" ::: "memory")

struct EpiConvIn {
    static constexpr bool PERM = false, AFTER_DRAIN = false;
    bf16_t* U; bf16_t* G;
    __device__ __forceinline__ void operator()(const f32x4 (&acc)[2][2][4][2], const Unit& u, int wr, int wc, int fr, int fq) const {
        const int row0 = u.pm * 256 + wr * 64 + fr, e0 = u.pn * 64 + wc * 16 + 4 * fq;
#pragma unroll
        for (int ai = 0; ai < 2; ++ai)
#pragma unroll
            for (int m = 0; m < 4; ++m) {
                const size_t o = (size_t)(row0 + ai * 128 + m * 16) * DM + e0;
                float uu[4], gg[4];
#pragma unroll
                for (int j = 0; j < 4; ++j) { uu[j] = acc[ai][0][m][1][j] * acc[ai][1][m][0][j]; gg[j] = acc[ai][0][m][0][j] * siluf_(acc[ai][1][m][1][j]); }
                *(uint2*)(U + o) = make_uint2(pk2(uu[0], uu[1]), pk2(uu[2], uu[3]));
                *(uint2*)(G + o) = make_uint2(pk2(gg[0], gg[1]), pk2(gg[2], gg[3]));
            }
    }
};
struct EpiWout {
    static constexpr bool PERM = false, AFTER_DRAIN = false;
    float* X; bf16_t* RB;
    __device__ __forceinline__ void operator()(const f32x4 (&acc)[2][2][4][2], const Unit& u, int wr, int wc, int fr, int fq) const {
        const int row0 = u.pm * 256 + wr * 64 + fr, col0 = u.pn * 256 + wc * 32 + 4 * fq;
#pragma unroll
        for (int ai = 0; ai < 2; ++ai)
#pragma unroll
            for (int m = 0; m < 4; ++m)
#pragma unroll
                for (int bj = 0; bj < 2; ++bj)
#pragma unroll
                    for (int n = 0; n < 2; ++n) {
                        const size_t o = (size_t)(row0 + ai * 128 + m * 16) * DM + col0 + bj * 128 + n * 16;
                        f32x4 x = *(const f32x4*)(X + o);
                        f32x4 r = x * DN_ALPHA + acc[ai][bj][m][n];
                        *(f32x4*)(X + o) = r;
                        *(uint2*)(RB + o) = make_uint2(pk2(r[0], r[1]), pk2(r[2], r[3]));
                    }
    }
};
template <int ACT> struct EpiBf16T {
    static constexpr bool PERM = false, AFTER_DRAIN = false;
    bf16_t* O; int ldo; int split; size_t stride;
    __device__ __forceinline__ void operator()(const f32x4 (&acc)[2][2][4][2], const Unit& u, int wr, int wc, int fr, int fq) const {
        const int row0 = u.pm * 256 + wr * 64 + fr; const int grp = u.pn / split; const int col0 = (u.pn - grp * split) * 256 + wc * 32 + 4 * fq;
        bf16_t* base = O + (size_t)grp * stride;
#pragma unroll
        for (int ai = 0; ai < 2; ++ai)
#pragma unroll
            for (int m = 0; m < 4; ++m)
#pragma unroll
                for (int bj = 0; bj < 2; ++bj)
#pragma unroll
                    for (int n = 0; n < 2; ++n) {
                        const size_t o = (size_t)(row0 + ai * 128 + m * 16) * ldo + col0 + bj * 128 + n * 16;
                        f32x4 a = acc[ai][bj][m][n];
                        if (ACT == 1) { a[0] = siluf_(a[0]); a[1] = siluf_(a[1]); a[2] = siluf_(a[2]); a[3] = siluf_(a[3]); }
                        *(uint2*)(base + o) = make_uint2(pk2(a[0], a[1]), pk2(a[2], a[3]));
                    }
    }
};
typedef EpiBf16T<0> EpiBf16;
struct EpiPle {
    static constexpr bool PERM = false, AFTER_DRAIN = false;
    float* X; const bf16_t* PE;
    __device__ __forceinline__ void operator()(const f32x4 (&acc)[2][2][4][2], const Unit& u, int wr, int wc, int fr, int fq) const {
        const int row0 = u.pm * 256 + wr * 64 + fr, col0 = u.pn * 256 + wc * 32 + 4 * fq;
#pragma unroll
        for (int ai = 0; ai < 2; ++ai)
#pragma unroll
            for (int m = 0; m < 4; ++m)
#pragma unroll
                for (int bj = 0; bj < 2; ++bj)
#pragma unroll
                    for (int n = 0; n < 2; ++n) {
                        const size_t o = (size_t)(row0 + ai * 128 + m * 16) * DM + col0 + bj * 128 + n * 16;
                        f32x4 x = *(const f32x4*)(X + o); const uint2 pe = *(const uint2*)(PE + o); const f32x4 a = acc[ai][bj][m][n];
                        x[0] += bflo(pe.x) * sigmoidf_(a[0]); x[1] += bfhi(pe.x) * sigmoidf_(a[1]); x[2] += bflo(pe.y) * sigmoidf_(a[2]); x[3] += bfhi(pe.y) * sigmoidf_(a[3]);
                        *(f32x4*)(X + o) = x;
                    }
    }
};
struct EpiSsmIn {
    static constexpr bool PERM = false, AFTER_DRAIN = false;
    float* U; bf16_t* SZ;
    __device__ __forceinline__ void operator()(const f32x4 (&acc)[2][2][4][2], const Unit& u, int wr, int wc, int fr, int fq) const {
        const int row0 = u.pm * 256 + wr * 64 + fr; const bool isz = u.pn >= 4; const int col0 = (u.pn & 3) * 256 + wc * 32 + 4 * fq;
#pragma unroll
        for (int ai = 0; ai < 2; ++ai)
#pragma unroll
            for (int m = 0; m < 4; ++m)
#pragma unroll
                for (int bj = 0; bj < 2; ++bj)
#pragma unroll
                    for (int n = 0; n < 2; ++n) {
                        const size_t o = (size_t)(row0 + ai * 128 + m * 16) * DM + col0 + bj * 128 + n * 16;
                        const f32x4 a = acc[ai][bj][m][n];
                        if (isz) *(uint2*)(SZ + o) = make_uint2(pk2(siluf_(a[0]), siluf_(a[1])), pk2(siluf_(a[2]), siluf_(a[3])));
                        else *(f32x4*)(U + o) = a;
                    }
    }
};
struct EpiGlu {
    static constexpr bool PERM = false, AFTER_DRAIN = false;
    const bf16_t* YG; const bf16_t* SZ; const float* bias; bf16_t* V;
    __device__ __forceinline__ void operator()(const f32x4 (&acc)[2][2][4][2], const Unit& u, int wr, int wc, int fr, int fq) const {
        const int row0 = u.pm * 256 + wr * 64 + fr, col0 = u.pn * 256 + wc * 32 + 4 * fq;
#pragma unroll
        for (int ai = 0; ai < 2; ++ai)
#pragma unroll
            for (int m = 0; m < 4; ++m)
#pragma unroll
                for (int bj = 0; bj < 2; ++bj)
#pragma unroll
                    for (int n = 0; n < 2; ++n) {
                        const int col = col0 + bj * 128 + n * 16;
                        const size_t o = (size_t)(row0 + ai * 128 + m * 16) * DM + col;
                        const f32x4 a = acc[ai][bj][m][n]; const f32x4 bb = *(const f32x4*)(bias + col);
                        const uint2 y = *(const uint2*)(YG + o), z = *(const uint2*)(SZ + o);
                        const float v0 = bflo(y.x) * sigmoidf_(a[0] + bb[0]) * bflo(z.x), v1 = bfhi(y.x) * sigmoidf_(a[1] + bb[1]) * bfhi(z.x);
                        const float v2 = bflo(y.y) * sigmoidf_(a[2] + bb[2]) * bflo(z.y), v3 = bfhi(y.y) * sigmoidf_(a[3] + bb[3]) * bfhi(z.y);
                        *(uint2*)(V + o) = make_uint2(pk2(v0, v1), pk2(v2, v3));
                    }
    }
};
struct EpiRk {
    static constexpr bool PERM = false, AFTER_DRAIN = false;
    bf16_t* RKV; bf16_t* SZ; bf16_t* L1;
    __device__ __forceinline__ void operator()(const f32x4 (&acc)[2][2][4][2], const Unit& u, int wr, int wc, int fr, int fq) const {
        const int row0 = u.pm * 256 + wr * 64 + fr; const int grp = u.pn >> 2; const int colt = (u.pn & 3) * 256 + wc * 32 + 4 * fq;
#pragma unroll
        for (int ai = 0; ai < 2; ++ai)
#pragma unroll
            for (int m = 0; m < 4; ++m)
#pragma unroll
                for (int bj = 0; bj < 2; ++bj)
#pragma unroll
                    for (int n = 0; n < 2; ++n) {
                        const int row = row0 + ai * 128 + m * 16, col = colt + bj * 128 + n * 16;
                        const f32x4 a = acc[ai][bj][m][n];
                        if (grp < 3) *(uint2*)(RKV + (size_t)grp * MTOK * DM + (size_t)row * DM + col) = make_uint2(pk2(a[0], a[1]), pk2(a[2], a[3]));
                        else if (grp == 3) *(uint2*)(SZ + (size_t)row * DM + col) = make_uint2(pk2(siluf_(a[0]), siluf_(a[1])), pk2(siluf_(a[2]), siluf_(a[3])));
                        else { const bool th = col < 64;
                            const float v0 = th ? tanhf_(a[0]) : a[0], v1 = th ? tanhf_(a[1]) : a[1], v2 = th ? tanhf_(a[2]) : a[2], v3 = th ? tanhf_(a[3]) : a[3];
                            *(uint2*)(L1 + (size_t)row * 256 + col) = make_uint2(pk2(v0, v1), pk2(v2, v3)); }
                    }
    }
};

struct EpiLora2 {
    static constexpr bool PERM = false, AFTER_DRAIN = false;
    bf16_t* EW; bf16_t* AA; const float* w0; const float* a0;
    template <int ISA> __device__ __forceinline__ void body(const f32x4 (&acc)[2][2][4][2], bf16_t* O, const float* bias, int row0, int col0) const {
#pragma unroll
        for (int ai = 0; ai < 2; ++ai)
#pragma unroll
            for (int m = 0; m < 4; ++m)
#pragma unroll
                for (int bj = 0; bj < 2; ++bj)
#pragma unroll
                    for (int n = 0; n < 2; ++n) {
                        const int col = col0 + bj * 128 + n * 16; const f32x4 bb = *(const f32x4*)(bias + col);
                        const f32x4 a = acc[ai][bj][m][n]; float v[4];
#pragma unroll
                        for (int j = 0; j < 4; ++j) { const float t = bb[j] + a[j];
                            if (ISA) v[j] = sigmoidf_(t);
                            else { const float sp = fmaxf(-t, 0.f) + __logf(1.0f + __expf(-fabsf(t))); v[j] = __expf(-sp - 0.5f); } }
                        *(uint2*)(O + (size_t)(row0 + ai * 128 + m * 16) * DM + col) = make_uint2(pk2(v[0], v[1]), pk2(v[2], v[3]));
                    }
    }
    __device__ __forceinline__ void operator()(const f32x4 (&acc)[2][2][4][2], const Unit& u, int wr, int wc, int fr, int fq) const {
        const int row0 = u.pm * 256 + wr * 64 + fr; const int col0 = (u.pn & 3) * 256 + wc * 32 + 4 * fq;
        if (u.pn >= 4) body<1>(acc, AA, a0, row0, col0); else body<0>(acc, EW, w0, row0, col0);
    }
};

template <class Epi> __device__ __forceinline__ void run_gemm(LAS unsigned char* lds, const bf16_t* A, const bf16_t* Bt, int N, int K, const Epi& E) {
    int Kv = K; asm volatile("" : "+s"(Kv));
    Gemm g; g.A = A; g.Bt = Bt; g.M = MTOK; g.N = N; g.K = Kv;
    StaticOrder S; S.init(MTOK, N, (int)gridDim.x, (int)blockIdx.x);
    pg8::gemm_phase<Epi, StaticOrder, false>(lds, g, S, E, nullptr);
}

__device__ __forceinline__ int conv_rowmap(int n) { const int s = n >> 10, e = n & 1023, q = e & 63; return 256 * (e >> 6) + 128 * (s >> 1) + 32 * (q >> 4) + 16 * (s & 1) + (q & 15); }
__device__ __forceinline__ void tr_job(LAS float* tile, const float* src, int ld_src, int K, int N, bf16_t* dst, int ldd, int koff, const float* kscale, int mode, int rot) {
    const int nblk = (int)gridDim.x, blk = ((int)blockIdx.x + rot) % nblk, tid = otid();
    const int tn_ = N >> 6, ntiles = (K >> 6) * tn_;
    const int tk0 = tid >> 4, tn4 = (tid & 15) * 4, nl = tid >> 3, kp = (tid & 7) * 8;
    f32x4 cur[2];
    if (blk < ntiles) { const int k0 = (blk / tn_) << 6, n0 = (blk % tn_) << 6;
#pragma unroll
        for (int i = 0; i < 2; ++i) cur[i] = *(const f32x4*)(src + (size_t)(k0 + tk0 + i * 32) * ld_src + n0 + tn4); }
    for (int t = blk; t < ntiles; t += nblk) {
        const int k0 = (t / tn_) << 6, n0 = (t % tn_) << 6;
        f32x4 nxt[2];
        const int t2 = t + nblk;
        if (t2 < ntiles) { const int k2 = (t2 / tn_) << 6, n2 = (t2 % tn_) << 6;
#pragma unroll
            for (int i = 0; i < 2; ++i) nxt[i] = *(const f32x4*)(src + (size_t)(k2 + tk0 + i * 32) * ld_src + n2 + tn4); }
        BAR_LDS();
#pragma unroll
        for (int i = 0; i < 2; ++i) *(LAS f32x4*)(tile + (tk0 + i * 32) * 68 + tn4) = cur[i];
        BAR_LDS();
        float v[8];
#pragma unroll
        for (int i = 0; i < 8; ++i) { v[i] = tile[(kp + i) * 68 + nl]; if (kscale) v[i] *= kscale[k0 + kp + i]; }
        const int n = n0 + nl; const int row = mode ? conv_rowmap(n) : n;
        *(uint4*)(dst + (size_t)row * ldd + koff + k0 + kp) = make_uint4(pk2(v[0], v[1]), pk2(v[2], v[3]), pk2(v[4], v[5]), pk2(v[6], v[7]));
        if (t2 < ntiles) { cur[0] = nxt[0]; cur[1] = nxt[1]; }
    }
}
__device__ __forceinline__ void cvt_pb(const float* src, bf16_t* dst) {
    const size_t n4 = (size_t)MTOK * 256 / 4, nth = (size_t)gridDim.x * 512;
    for (size_t i = (size_t)blockIdx.x * 512 + otid(); i < n4; i += nth) { const float4 v = ((const float4*)src)[i]; ((uint2*)dst)[i] = make_uint2(pk2(v.x, v.y), pk2(v.z, v.w)); }
}
__device__ __forceinline__ void conv_layer_weights(const P& p, LAS float* tile, int j, int L) {
    unsigned char* ws = p.ws;
    tr_job(tile, p.in[2] + (size_t)j * 1024 * 4096, 4096, 1024, 4096, (bf16_t*)(ws + W_CIN), 1024, 0, nullptr, 1, 0);
    tr_job(tile, p.in[4] + (size_t)j * 1024 * 1024, 1024, 1024, 1024, (bf16_t*)(ws + W_COUT), 1024, 0, nullptr, 0, 0);
    tr_job(tile, p.in[31] + (size_t)L * 256 * 1024, 1024, 256, 1024, (bf16_t*)(ws + W_PEC), 256, 0, nullptr, 0, 0);
    tr_job(tile, p.in[32] + (size_t)L * 1024 * 1024, 1024, 1024, 1024, (bf16_t*)(ws + W_PGC), 1024, 0, nullptr, 0, 64);
}

__device__ __forceinline__ void phase_prep(const P& p, LAS float* tile) {
    unsigned char* ws = p.ws; const size_t nth = (size_t)gridDim.x * 512, gt = (size_t)blockIdx.x * 512 + otid();
    {
        const float4* x = (const float4*)p.in[0]; float4* o = (float4*)p.out; uint2* a = (uint2*)(ws + ACT);
        for (size_t i = gt; i < (size_t)MTOK * DM / 4; i += nth) { const float4 v = x[i]; o[i] = v; a[i] = make_uint2(pk2(v.x, v.y), pk2(v.z, v.w)); }
    }
    cvt_pb(p.in[1], (bf16_t*)(ws + PB));
    conv_layer_weights(p, tile, 0, 0);
    tr_job(tile, p.in[5], 2048, 1024, 2048, (bf16_t*)(ws + W_SIN), 1024, 0, nullptr, 0, 128);
    tr_job(tile, p.in[14], 1024, 1024, 1024, (bf16_t*)(ws + W_SGLU), 1024, 0, nullptr, 0, 0);
    tr_job(tile, p.in[16], 1024, 1024, 1024, (bf16_t*)(ws + W_SOUT), 1024, 0, nullptr, 0, 0);
    tr_job(tile, p.in[31] + (size_t)1 * 256 * 1024, 1024, 256, 1024, (bf16_t*)(ws + W_PE1), 256, 0, nullptr, 0, 192);
    tr_job(tile, p.in[32] + (size_t)1 * 1024 * 1024, 1024, 1024, 1024, (bf16_t*)(ws + W_PG1), 1024, 0, nullptr, 0, 0);
    bf16_t* rk = (bf16_t*)(ws + W_RK);
    for (int g = 0; g < 4; ++g)
        tr_job(tile, p.in[18] + (size_t)g * 1024 * 1024, 1024, 1024, 1024, rk + (size_t)g * 1024 * 1024, 1024, 0, nullptr, 0, g * 64);
    bf16_t* wl = rk + (size_t)4096 * 1024;
    tr_job(tile, p.in[20], 64, 1024, 64, wl, 2048, 0, nullptr, 0, 0);
    tr_job(tile, p.in[20], 64, 1024, 64, wl, 2048, 1024, p.in[17] + 4 * 1024, 0, 16);
    tr_job(tile, p.in[23], 64, 1024, 64, wl + (size_t)64 * 2048, 2048, 0, nullptr, 0, 32);
    tr_job(tile, p.in[23], 64, 1024, 64, wl + (size_t)64 * 2048, 2048, 1024, p.in[17] + 5 * 1024, 0, 48);
    bf16_t* l2 = (bf16_t*)(ws + W_L2);
    tr_job(tile, p.in[21], 1024, 64, 1024, l2, 256, 0, nullptr, 0, 64);
    tr_job(tile, p.in[24], 1024, 64, 1024, l2 + (size_t)1024 * 256, 256, 64, nullptr, 0, 80);
    for (size_t i = gt; i < (size_t)2048 * 32; i += nth) { const int row = (int)(i >> 5), c8 = (int)(i & 31); const bool data = row < 1024 ? (c8 < 8) : (c8 >= 8 && c8 < 16);
        if (!data) *(uint4*)(l2 + (size_t)row * 256 + c8 * 8) = make_uint4(0, 0, 0, 0); }
    tr_job(tile, p.in[30], 1024, 1024, 1024, (bf16_t*)(ws + W_ROUT), 1024, 0, nullptr, 0, 96);
    tr_job(tile, p.in[31] + (size_t)2 * 256 * 1024, 1024, 256, 1024, (bf16_t*)(ws + W_PE2), 256, 0, nullptr, 0, 160);
    tr_job(tile, p.in[32] + (size_t)2 * 1024 * 1024, 1024, 1024, 1024, (bf16_t*)(ws + W_PG2), 1024, 0, nullptr, 0, 0);
}

__device__ __forceinline__ void phase_conv_ew(const bf16_t* U, bf16_t* G, const float* ck) {
    const size_t nth = (size_t)gridDim.x * 512;
    for (size_t i = (size_t)blockIdx.x * 512 + otid(); i < (size_t)MTOK * 128; i += nth) {
        const int row = (int)(i >> 7), c8 = (int)(i & 127) * 8, t = row & (SEQL - 1);
        const uint4 z4 = make_uint4(0, 0, 0, 0);
        const uint4 u0 = *(const uint4*)(U + (size_t)row * DM + c8);
        const uint4 u1 = t >= 1 ? *(const uint4*)(U + (size_t)(row - 1) * DM + c8) : z4;
        const uint4 u2 = t >= 2 ? *(const uint4*)(U + (size_t)(row - 2) * DM + c8) : z4;
        const uint4 g = *(const uint4*)(G + (size_t)row * DM + c8);
        const unsigned a0[4] = {u0.x, u0.y, u0.z, u0.w}, a1[4] = {u1.x, u1.y, u1.z, u1.w}, a2[4] = {u2.x, u2.y, u2.z, u2.w}, gg[4] = {g.x, g.y, g.z, g.w};
        unsigned o[4];
#pragma unroll
        for (int q = 0; q < 4; ++q) {
            const int c = c8 + 2 * q;
            const float lo = bflo(gg[q]) * (ck[c] * bflo(a2[q]) + ck[1024 + c] * bflo(a1[q]) + ck[2048 + c] * bflo(a0[q]));
            const float hi = bfhi(gg[q]) * (ck[c + 1] * bfhi(a2[q]) + ck[1024 + c + 1] * bfhi(a1[q]) + ck[2048 + c + 1] * bfhi(a0[q]));
            o[q] = pk2(lo, hi);
        }
        *(uint4*)(G + (size_t)row * DM + c8) = make_uint4(o[0], o[1], o[2], o[3]);
    }
}

__device__ __forceinline__ void phase_ln(float* X, bf16_t* XB, const float* g, const float* b) {
    const int lane = otid() & 63, gw = blockIdx.x * 8 + (otid() >> 6), nw = gridDim.x * 8;
    for (int row = gw; row < MTOK; row += nw) {
        float4 v[4]; float s = 0.f;
#pragma unroll
        for (int i = 0; i < 4; ++i) { v[i] = *(const float4*)(X + (size_t)row * DM + i * 256 + lane * 4); s += v[i].x + v[i].y + v[i].z + v[i].w; }
        const float mean = wave_sum(s) * (1.0f / 1024.0f);
        float q = 0.f;
#pragma unroll
        for (int i = 0; i < 4; ++i) { v[i].x -= mean; v[i].y -= mean; v[i].z -= mean; v[i].w -= mean; q += v[i].x * v[i].x + v[i].y * v[i].y + v[i].z * v[i].z + v[i].w * v[i].w; }
        const float rs = rsqrtf(wave_sum(q) * (1.0f / 1024.0f) + 1e-5f);
#pragma unroll
        for (int i = 0; i < 4; ++i) { const int c = i * 256 + lane * 4; const float4 gg = *(const float4*)(g + c), bb = *(const float4*)(b + c);
            float4 y; y.x = v[i].x * rs * gg.x + bb.x; y.y = v[i].y * rs * gg.y + bb.y; y.z = v[i].z * rs * gg.z + bb.z; y.w = v[i].w * rs * gg.w + bb.w;
            *(float4*)(X + (size_t)row * DM + c) = y; *(uint2*)(XB + (size_t)row * DM + c) = make_uint2(pk2(y.x, y.y), pk2(y.z, y.w)); }
    }
}

template <int FINAL> __device__ __forceinline__ void phase_s5(const P& p, LAS unsigned char* lds_, const float* U, float* HLOC, bf16_t* YG) {
    const int lane = otid() & 63, wid = otid() >> 6, nw = gridDim.x * 8;
    LAS float* ul = (LAS float*)(lds_ + wid * 8192);
    LAS unsigned* S = (LAS unsigned*)(lds_ + wid * 8192 + 2048);
    const int fr = lane & 15, fq = lane >> 4;
    for (int un = blockIdx.x * 8 + wid; un < 2048; un += nw) {
        const int g = un & 63, sc = (un >> 6) & 7, b = un >> 9;
        if (!FINAL && sc == 7) continue;
        const float dt = __expf(p.in[8][g]);
        const float lre = p.in[6][g * 64 + lane], lim = p.in[7][g * 64 + lane];
        const float mag = expf(lre * dt); float sn, cs; sincosf(lim * dt, &sn, &cs);
        const float are = mag * cs, aim = mag * sn;
        const float d2 = lre * lre + lim * lim, cfre = ((are - 1.0f) * lre + aim * lim) / d2, cfim = (aim * lre - (are - 1.0f) * lim) / d2;
        f32x2 Bp[16];
#pragma unroll
        for (int q = 0; q < 4; ++q) { const float4 br = *(const float4*)(p.in[9] + (size_t)(g * 64 + lane) * 16 + q * 4), bi = *(const float4*)(p.in[10] + (size_t)(g * 64 + lane) * 16 + q * 4);
            const float brr[4] = {br.x, br.y, br.z, br.w}, bii[4] = {bi.x, bi.y, bi.z, bi.w};
#pragma unroll
            for (int j = 0; j < 4; ++j) { Bp[q * 4 + j] = (f32x2){cfre * brr[j] - cfim * bii[j], cfre * bii[j] + cfim * brr[j]}; } }
        float hre = 0.f, him = 0.f;
        bf16x8 Cf[4]; float dsk = 0.f;
        if (FINAL) {
            float lr = are, li = aim;
#pragma unroll
            for (int i = 0; i < 9; ++i) { const float t = lr * lr - li * li; li = 2.0f * lr * li; lr = t; }
            for (int s2 = 0; s2 < sc; ++s2) { const float2 hv = *(const float2*)(HLOC + ((size_t)((b * 8 + s2) * 64 + g) * 64 + lane) * 2);
                const float t = lr * hre - li * him + hv.x; him = lr * him + li * hre + hv.y; hre = t; }
#pragma unroll
            for (int kk = 0; kk < 4; ++kk) {
                unsigned w[4];
#pragma unroll
                for (int i = 0; i < 4; ++i) { const int pi = 16 * kk + 4 * fq + i; const size_t o = (size_t)(g * 16 + fr) * 64 + pi; w[i] = pk2(p.in[11][o], -p.in[12][o]); }
                union { unsigned u[4]; bf16x8 v; } cv; cv.u[0] = w[0]; cv.u[1] = w[1]; cv.u[2] = w[2]; cv.u[3] = w[3]; Cf[kk] = cv.v;
            }
            dsk = p.in[13][g * 16 + fr];
        }
        const size_t tok0 = (size_t)b * SEQL + (size_t)sc * 512;
        const float* ug = U + tok0 * DM + g * 16 + (lane & 3) * 4 + (size_t)(lane >> 2) * DM;
        f32x4 nxt = *(const f32x4*)ug;
        LDS_FENCE();
        *(LAS f32x4*)(ul + lane * 4) = nxt;
        for (int blk = 0; blk < 32; ++blk) {
            const int cur = blk & 1;
            if (blk + 1 < 32) nxt = *(const f32x4*)(ug + (size_t)(blk + 1) * 16 * DM);
            LDS_FENCE();
#pragma unroll 4
            for (int tt = 0; tt < 16; ++tt) {
                float uu[16];
#pragma unroll
                for (int q = 0; q < 4; ++q) { const f32x4 t4 = *(const LAS f32x4*)(ul + cur * 256 + tt * 16 + q * 4); uu[q * 4] = t4[0]; uu[q * 4 + 1] = t4[1]; uu[q * 4 + 2] = t4[2]; uu[q * 4 + 3] = t4[3]; }
                f32x2 b0 = {0.f, 0.f}, b1 = {0.f, 0.f};
#pragma unroll
                for (int h = 0; h < 16; h += 2) { b0 = Bp[h] * (f32x2){uu[h], uu[h]} + b0; b1 = Bp[h + 1] * (f32x2){uu[h + 1], uu[h + 1]} + b1; }
                const f32x2 bs = b0 + b1; const float bre = bs[0], bim = bs[1];
                const float t = are * hre - aim * him + bre; him = are * him + aim * hre + bim; hre = t;
                if (FINAL) S[tt * 68 + lane] = pk2(hre, him);
            }
            if (FINAL) {
                LDS_FENCE();
                f32x4 acc = {0.f, 0.f, 0.f, 0.f};
#pragma unroll
                for (int kk = 0; kk < 4; ++kk) { const bf16x8 af = *(const LAS bf16x8*)(S + fr * 68 + 16 * kk + 4 * fq); acc = __builtin_amdgcn_mfma_f32_16x16x32_bf16(af, Cf[kk], acc, 0, 0, 0); }
#pragma unroll
                for (int i = 0; i < 4; ++i) { const int tl = 4 * fq + i; const float y = acc[i] + dsk * ul[cur * 256 + tl * 16 + fr];
                    const unsigned short hb = (unsigned short)(pk2(gelu_tanh(y), 0.f) & 0xffffu);
                    YG[(tok0 + blk * 16 + tl) * DM + g * 16 + fr] = hb; }
            }
            LDS_FENCE();
            if (blk + 1 < 32) *(LAS f32x4*)(ul + (cur ^ 1) * 256 + lane * 4) = nxt;
        }
        if (!FINAL) *(float2*)(HLOC + ((size_t)un * 64 + lane) * 2) = make_float2(hre, him);
    }
}

constexpr int L1_BROW = 72;
__device__ __forceinline__ void phase_rw_lora1(LAS unsigned char* lds_, const float* X, const bf16_t* Wl, bf16_t* L1) {
    LAS bf16_t* Bs = (LAS bf16_t*)lds_;
    const int tid = otid(), lane = tid & 63, wid = tid >> 6, fr = lane & 15, fq = lane >> 4, mt = wid >> 1, ch = wid & 1;
    const int sn = tid >> 2, sq = tid & 3;
    for (int item = blockIdx.x; item < MTOK / 64; item += gridDim.x) {
        const int row = item * 64 + mt * 16 + fr, t = row & (SEQL - 1);
        const float* xr = X + (size_t)row * DM + fq * 8; const float* xpr = xr - DM;
        f32x4 acc[4];
#pragma unroll
        for (int n = 0; n < 4; ++n) acc[n] = (f32x4){0.f, 0.f, 0.f, 0.f};
        __syncthreads();
        pg8::u32x4 sb[2][2];
#pragma unroll
        for (int pt = 0; pt < 2; ++pt)
#pragma unroll
            for (int h = 0; h < 2; ++h) sb[pt][h] = *(const pg8::u32x4*)(Wl + (size_t)sn * 2048 + pt * 1024 + sq * 16 + h * 8);
        for (int ks = 0; ks < 16; ++ks) {
            const int st = ks & 1;
#pragma unroll
            for (int pt = 0; pt < 2; ++pt)
#pragma unroll
                for (int h = 0; h < 2; ++h) *(LAS pg8::u32x4*)(Bs + ((st * 2 + pt) * 128 + sn) * L1_BROW + sq * 16 + h * 8) = sb[pt][h];
            if (ks + 1 < 16) {
#pragma unroll
                for (int pt = 0; pt < 2; ++pt)
#pragma unroll
                    for (int h = 0; h < 2; ++h) sb[pt][h] = *(const pg8::u32x4*)(Wl + (size_t)sn * 2048 + pt * 1024 + (ks + 1) * 64 + sq * 16 + h * 8);
            }
            BAR_LDS();
#pragma unroll
            for (int k2 = 0; k2 < 2; ++k2) {
                const int k = ks * 64 + k2 * 32;
                const float4 x0 = *(const float4*)(xr + k), x1 = *(const float4*)(xr + k + 4);
                float4 p0 = make_float4(0.f, 0.f, 0.f, 0.f), p1 = p0;
                if (t >= 1) { p0 = *(const float4*)(xpr + k); p1 = *(const float4*)(xpr + k + 4); }
                union { unsigned u[4]; bf16x8 v; } ax, ad;
                ax.u[0] = pk2(x0.x, x0.y); ax.u[1] = pk2(x0.z, x0.w); ax.u[2] = pk2(x1.x, x1.y); ax.u[3] = pk2(x1.z, x1.w);
                ad.u[0] = pk2(p0.x - x0.x, p0.y - x0.y); ad.u[1] = pk2(p0.z - x0.z, p0.w - x0.w); ad.u[2] = pk2(p1.x - x1.x, p1.y - x1.y); ad.u[3] = pk2(p1.z - x1.z, p1.w - x1.w);
#pragma unroll
                for (int n = 0; n < 4; ++n) {
                    const bf16x8 b0 = *(const LAS bf16x8*)(Bs + ((st * 2 + 0) * 128 + ch * 64 + n * 16 + fr) * L1_BROW + k2 * 32 + fq * 8);
                    const bf16x8 b1 = *(const LAS bf16x8*)(Bs + ((st * 2 + 1) * 128 + ch * 64 + n * 16 + fr) * L1_BROW + k2 * 32 + fq * 8);
                    acc[n] = __builtin_amdgcn_mfma_f32_16x16x32_bf16(ax.v, b0, acc[n], 0, 0, 0);
                    acc[n] = __builtin_amdgcn_mfma_f32_16x16x32_bf16(ad.v, b1, acc[n], 0, 0, 0);
                }
            }
        }
        const int row0 = item * 64 + mt * 16;
#pragma unroll
        for (int n = 0; n < 4; ++n)
#pragma unroll
            for (int i = 0; i < 4; ++i) { const int r = row0 + fq * 4 + i, col = ch * 64 + n * 16 + fr;
                const float v = ch == 0 ? tanhf_(acc[n][i]) : acc[n][i];
                L1[(size_t)r * 256 + col] = (bf16_t)(pk2(v, 0.f) & 0xffffu); }
#pragma unroll
        for (int q = 0; q < 2; ++q) { const int idx = q * 64 + lane, r = idx >> 3, c8 = idx & 7;
            *(uint4*)(L1 + (size_t)(row0 + r) * 256 + 128 + ch * 64 + c8 * 8) = make_uint4(0, 0, 0, 0); }
    }
}
__device__ __forceinline__ void phase_rw_prep(const float* X, bf16_t* XS, const float* mua, const float* mub) {
    const size_t nth = (size_t)gridDim.x * 512;
    for (size_t i = (size_t)blockIdx.x * 512 + otid(); i < (size_t)MTOK * 256; i += nth) {
        const int row = (int)(i >> 8), c4 = (int)(i & 255) * 4, t = row & (SEQL - 1);
        const float4 x = *(const float4*)(X + (size_t)row * DM + c4);
        float4 xp = make_float4(0.f, 0.f, 0.f, 0.f); if (t >= 1) xp = *(const float4*)(X + (size_t)(row - 1) * DM + c4);
        const float4 ma = *(const float4*)(mua + c4), mb = *(const float4*)(mub + c4);
        const float d0 = xp.x - x.x, d1 = xp.y - x.y, d2 = xp.z - x.z, d3 = xp.w - x.w;
        *(uint2*)(XS + (size_t)row * DM + c4) = make_uint2(pk2(x.x + d0 * ma.x, x.y + d1 * ma.y), pk2(x.z + d2 * ma.z, x.w + d3 * ma.w));
        *(uint2*)(XS + (size_t)MTOK * DM + (size_t)row * DM + c4) = make_uint2(pk2(x.x + d0 * mb.x, x.y + d1 * mb.y), pk2(x.z + d2 * mb.z, x.w + d3 * mb.w));
    }
}
__device__ __forceinline__ void unpack8(const uint4 v, float* f) { f[0] = bflo(v.x); f[1] = bfhi(v.x); f[2] = bflo(v.y); f[3] = bfhi(v.y); f[4] = bflo(v.z); f[5] = bfhi(v.z); f[6] = bflo(v.w); f[7] = bfhi(v.w); }

constexpr int RW_T = 32, RW_STEP = 336;
constexpr int RW_BUF = RW_T * RW_STEP, RW_OB = RW_T * 16 * 16;
struct RwOp { f32x4 r, w, kp, kk, ka; float v; };
__device__ __forceinline__ void rw_load(RwOp& o, const LAS float* sb, int j0, int rr) {
    o.r = *(const LAS f32x4*)(sb + j0); o.w = *(const LAS f32x4*)(sb + 64 + j0); o.kp = *(const LAS f32x4*)(sb + 128 + j0);
    o.kk = *(const LAS f32x4*)(sb + 192 + j0); o.ka = *(const LAS f32x4*)(sb + 256 + j0); o.v = sb[320 + rr];
}
template <int MODE> __device__ __forceinline__ float rw_step(const RwOp& o, float& s0, float& s1, float& s2, float& s3) {
    const float dsum = fmaf(s0, o.kk[0], s1 * o.kk[1]) + fmaf(s2, o.kk[2], s3 * o.kk[3]);
    const float sa = MODE == 3 ? -dsum : -red16(dsum);
    s0 = fmaf(s0, o.w[0], fmaf(sa, o.ka[0], o.v * o.kp[0])); s1 = fmaf(s1, o.w[1], fmaf(sa, o.ka[1], o.v * o.kp[1]));
    s2 = fmaf(s2, o.w[2], fmaf(sa, o.ka[2], o.v * o.kp[2])); s3 = fmaf(s3, o.w[3], fmaf(sa, o.ka[3], o.v * o.kp[3]));
    return fmaf(s0, o.r[0], s1 * o.r[1]) + fmaf(s2, o.r[2], s3 * o.r[3]);
}
__device__ __forceinline__ void rw_flush(const LAS float* ob, bf16_t* dst) {
    float o2[2];
#pragma unroll
    for (int q = 0; q < 2; ++q) { float a = 0.f;
#pragma unroll
        for (int i = 0; i < 4; ++i) { const f32x4 t = *(const LAS f32x4*)(ob + q * 16 + i * 4); a += (t[0] + t[1]) + (t[2] + t[3]); }
        o2[q] = a; }
    *(unsigned*)dst = pk2(o2[0], o2[1]);
}
template <int MODE> __device__ __forceinline__ void phase_rw_scan(const P& p, LAS unsigned char* lds_, const bf16_t* R, const bf16_t* K, const bf16_t* V, const bf16_t* DW, const bf16_t* DA, bf16_t* OUT) {
    LAS float* buf = (LAS float*)lds_;
    LAS float* obuf = buf + 2 * RW_BUF;
    const int tid = otid(), lane = tid & 63, wid = __builtin_amdgcn_readfirstlane(tid >> 6);
    for (int un = blockIdx.x; un < 256; un += gridDim.x) {
        const int bh = un >> 2, rg = un & 3, b = bh >> 4, h = bh & 15;
        __syncthreads();
        if (wid < 4) {
            const int rr = wid * 4 + (lane >> 4), jl = lane & 15, j0 = jl * 4;
            float s0 = 0.f, s1 = 0.f, s2 = 0.f, s3 = 0.f;
            __builtin_amdgcn_s_setprio(3);
            BAR_LDS();
            for (int c = 0; c < SEQL / RW_T; ++c) {
                const LAS float* cb = buf + (c & 1) * RW_BUF; LAS float* ob = obuf + (c & 1) * RW_OB + rr * 16 + jl;
                if (MODE != 1) {
                RwOp ops[3];
                rw_load(ops[0], cb, j0, rr); rw_load(ops[1], cb + RW_STEP, j0, rr);
#pragma unroll
                for (int s = 0; s < RW_T; ++s) {
                    if (s + 2 < RW_T) rw_load(ops[(s + 2) % 3], cb + (s + 2) * RW_STEP, j0, rr);
                    ob[s * 256] = rw_step<MODE>(ops[s % 3], s0, s1, s2, s3);
                }
                }
                BAR_LDS();
            }
            __builtin_amdgcn_s_setprio(0);
        } else {
            const int pt = tid - 256, s = pt >> 3, part = pt & 7, c0 = part * 8, ch = h * 64 + c0;
            float kk_[8], ka_[8];
#pragma unroll
            for (int i = 0; i < 8; ++i) { kk_[i] = p.in[25][ch + i]; ka_[i] = p.in[26][ch + i]; }
            const size_t rowb = (size_t)b * SEQL + s;
            uint4 qr, qk, qw, qa, qv = make_uint4(0, 0, 0, 0);
            { const size_t o = rowb * DM + ch; qr = *(const uint4*)(R + o); qk = *(const uint4*)(K + o); qw = *(const uint4*)(DW + o); qa = *(const uint4*)(DA + o);
              if (part < 2) qv = *(const uint4*)(V + rowb * DM + h * 64 + rg * 16 + part * 8); }
            for (int c = 0; c <= SEQL / RW_T; ++c) {
                uint4 nr = qr, nk = qk, nw = qw, na = qa, nv = qv;
                if (MODE != 2 && c + 1 < SEQL / RW_T) { const size_t row = rowb + (size_t)(c + 1) * RW_T; const size_t o = row * DM + ch;
                    nr = *(const uint4*)(R + o); nk = *(const uint4*)(K + o); nw = *(const uint4*)(DW + o); na = *(const uint4*)(DA + o);
                    if (part < 2) nv = *(const uint4*)(V + row * DM + h * 64 + rg * 16 + part * 8); }
                if (MODE != 2 && c < SEQL / RW_T) {
                    float r[8], k[8], ew[8], aa[8];
                    unpack8(qr, r); unpack8(qk, k); unpack8(qw, ew); unpack8(qa, aa);
                    float wv[8], kp[8], kk[8], ka[8]; float ss = 0.f;
#pragma unroll
                    for (int i = 0; i < 8; ++i) {
                        wv[i] = __expf(-ew[i]);
                        kk[i] = k[i] * kk_[i]; ss = fmaf(kk[i], kk[i], ss);
                        kp[i] = k[i] * fmaf(aa[i] - 1.0f, ka_[i], 1.0f);
                    }
                    ss = red8(ss); const float inv = rcpf_(fmaxf(__builtin_amdgcn_sqrtf(ss), 1e-12f));
#pragma unroll
                    for (int i = 0; i < 8; ++i) { kk[i] *= inv; ka[i] = kk[i] * aa[i]; }
                    LAS float* sb = buf + (c & 1) * RW_BUF + s * RW_STEP + c0;
                    *(LAS f32x4*)(sb) = (f32x4){r[0], r[1], r[2], r[3]}; *(LAS f32x4*)(sb + 4) = (f32x4){r[4], r[5], r[6], r[7]};
                    *(LAS f32x4*)(sb + 64) = (f32x4){wv[0], wv[1], wv[2], wv[3]}; *(LAS f32x4*)(sb + 68) = (f32x4){wv[4], wv[5], wv[6], wv[7]};
                    *(LAS f32x4*)(sb + 128) = (f32x4){kp[0], kp[1], kp[2], kp[3]}; *(LAS f32x4*)(sb + 132) = (f32x4){kp[4], kp[5], kp[6], kp[7]};
                    *(LAS f32x4*)(sb + 192) = (f32x4){kk[0], kk[1], kk[2], kk[3]}; *(LAS f32x4*)(sb + 196) = (f32x4){kk[4], kk[5], kk[6], kk[7]};
                    *(LAS f32x4*)(sb + 256) = (f32x4){ka[0], ka[1], ka[2], ka[3]}; *(LAS f32x4*)(sb + 260) = (f32x4){ka[4], ka[5], ka[6], ka[7]};
                    if (part < 2) { float v[8]; unpack8(qv, v);
                        LAS float* vb = buf + (c & 1) * RW_BUF + s * RW_STEP + 320 + part * 8;
                        *(LAS f32x4*)(vb) = (f32x4){v[0], v[1], v[2], v[3]}; *(LAS f32x4*)(vb + 4) = (f32x4){v[4], v[5], v[6], v[7]}; }
                }
                if (MODE == 0 && c >= 2) {
                    const int cc = c - 2; const size_t row = (size_t)b * SEQL + (size_t)cc * RW_T + s;
                    rw_flush(obuf + (cc & 1) * RW_OB + s * 256 + part * 32, OUT + row * DM + h * 64 + rg * 16 + part * 2);
                }
                BAR_LDS();
                qr = nr; qk = nk; qw = nw; qa = na; qv = nv;
            }
            if (MODE == 0) {
                const int cc = SEQL / RW_T - 1; const size_t row = (size_t)b * SEQL + (size_t)cc * RW_T + s;
                rw_flush(obuf + (cc & 1) * RW_OB + s * 256 + part * 32, OUT + row * DM + h * 64 + rg * 16 + part * 2);
            }
        }
    }
}


constexpr int RW2_NP = 7, RW2_NS = 8, RW2_SLOT = 11264, RW2_SCR = 9216;
constexpr int SL_P1T = 0, SL_RT = 2304, SL_BPT = 4608, SL_KPT = 6656, SL_AM = 8704, SL_A2 = 9728, SL_VP = 10240, SL_GC = 10752;
constexpr int SC_BT = 0, SC_KT = 2304, SC_ATT = 4608, SC_L = 6656, SC_NT = 7680, SC_LKA = 8448;
constexpr int RW2_FLG = RW2_NS * RW2_SLOT + RW2_NP * RW2_SCR;
__device__ __forceinline__ float bf_us(unsigned short x) { return __uint_as_float(((unsigned)x) << 16); }
__device__ __forceinline__ unsigned short us_bf(float v) { return (unsigned short)(pk2(v, 0.f) & 0xffffu); }
typedef unsigned u32x2 __attribute__((ext_vector_type(2)));
union Frag8 { unsigned u[4]; bf16x8 v; };

__device__ __forceinline__ float wave_total(float x) {
    float y = red16(x);
    y += __int_as_float(__builtin_amdgcn_update_dpp(0, __float_as_int(y), 0x142, 0xA, 0xF, false));
    y += __int_as_float(__builtin_amdgcn_update_dpp(0, __float_as_int(y), 0x143, 0xC, 0xF, false));
    return __int_as_float(__builtin_amdgcn_readlane(__float_as_int(y), 63));
}
__device__ __forceinline__ void phase_rw_tables(const P& p, bf16_t* R, bf16_t* K, bf16_t* EW, bf16_t* AA, float* GC, float* CB) {
    const int tid = otid(), lane = tid & 63, wid = tid >> 6, nw = gridDim.x * 8;
    for (int task = blockIdx.x * 8 + wid; task < 16384; task += nw) {
        const int h = task & 15, c = (task >> 4) & 255, b = task >> 12, ch = h * 64 + lane;
        const size_t row0 = (size_t)b * SEQL + (size_t)c * 16;
        const float kkm = p.in[25][ch], kam = p.in[26][ch], rkm = p.in[27][ch];
        unsigned short xr[16], xk[16], xe[16], xa[16];
#pragma unroll
        for (int t = 0; t < 16; ++t) { const size_t o = (row0 + t) * DM + ch; xr[t] = R[o]; xk[t] = K[o]; xe[t] = EW[o]; xa[t] = AA[o]; }
        float n2[16];
#pragma unroll
        for (int t = 0; t < 16; ++t) { const float x = bf_us(xk[t]) * kkm; n2[t] = wave_total(x * x); }
        float g = 1.0f;
#pragma unroll
        for (int t = 0; t < 16; ++t) {
            const float w = __expf(-bf_us(xe[t])), a = bf_us(xa[t]), kft = bf_us(xk[t]), rft = bf_us(xr[t]);
            const float kk = kft * kkm * __builtin_amdgcn_rsqf(fmaxf(n2[t], 1e-24f));
            const float kp = kft * (1.0f + (a - 1.0f) * kam), kka = kk * a;
            const float cb = wave_total(rft * kp * rkm);
            const float gp = g; g *= w; const float ig = rcpf_(g);
            const size_t o = (row0 + t) * DM + ch;
            AA[o] = us_bf(-kk * gp); EW[o] = us_bf(kka * ig); K[o] = us_bf(kp * ig); R[o] = us_bf(rft * g);
            if (lane == 0) CB[(row0 + t) * 16 + h] = cb;
        }
        GC[((size_t)b * 256 + c) * DM + ch] = g;
    }
}

__device__ __forceinline__ void phase_rw_scan2(const P& p, LAS unsigned char* lds_, const bf16_t* R, const bf16_t* K, const bf16_t* V, const bf16_t* EW, const bf16_t* AA, const float* GC, bf16_t* OUT) {
    const int tid = otid(), lane = tid & 63, wid = __builtin_amdgcn_readfirstlane(tid >> 6), fr = lane & 15, fq = lane >> 4;
    volatile LAS unsigned* flags = (volatile LAS unsigned*)(lds_ + RW2_FLG);
    for (int un = blockIdx.x; un < 256; un += gridDim.x) {
        const int bh = un >> 2, rg = un & 3, b = bh >> 4, h = bh & 15;
        __syncthreads();
        if (tid < RW2_NS + 1) flags[tid] = 0u;
        __syncthreads();
        if (wid == 0) {
            f32x4 accS[4];
#pragma unroll
            for (int m = 0; m < 4; ++m) accS[m] = (f32x4){0.f, 0.f, 0.f, 0.f};
            __builtin_amdgcn_s_setprio(3);
            for (int c = 0; c < SEQL / 16; ++c) {
                const int slot = c & (RW2_NS - 1); LAS unsigned char* sl = lds_ + slot * RW2_SLOT;
                while (flags[slot] != (unsigned)(c + 1)) __builtin_amdgcn_s_sleep(1);
                LDS_FENCE();
                Frag8 Bs[2];
#pragma unroll
                for (int k2 = 0; k2 < 2; ++k2) { Bs[k2].u[0] = pk2(accS[2 * k2][0], accS[2 * k2][1]); Bs[k2].u[1] = pk2(accS[2 * k2][2], accS[2 * k2][3]);
                    Bs[k2].u[2] = pk2(accS[2 * k2 + 1][0], accS[2 * k2 + 1][1]); Bs[k2].u[3] = pk2(accS[2 * k2 + 1][2], accS[2 * k2 + 1][3]); }
                Frag8 A1[2], AR[2];
#pragma unroll
                for (int k2 = 0; k2 < 2; ++k2) {
                    const u32x2 x0 = *(const LAS u32x2*)(sl + SL_P1T + (fr * 72 + 32 * k2 + 4 * fq) * 2), x1 = *(const LAS u32x2*)(sl + SL_P1T + (fr * 72 + 32 * k2 + 16 + 4 * fq) * 2);
                    A1[k2].u[0] = x0[0]; A1[k2].u[1] = x0[1]; A1[k2].u[2] = x1[0]; A1[k2].u[3] = x1[1];
                    const u32x2 y0 = *(const LAS u32x2*)(sl + SL_RT + (fr * 72 + 32 * k2 + 4 * fq) * 2), y1 = *(const LAS u32x2*)(sl + SL_RT + (fr * 72 + 32 * k2 + 16 + 4 * fq) * 2);
                    AR[k2].u[0] = y0[0]; AR[k2].u[1] = y0[1]; AR[k2].u[2] = y1[0]; AR[k2].u[3] = y1[1];
                }
                const u32x2 a2 = *(const LAS u32x2*)(sl + SL_A2 + lane * 8), vp = *(const LAS u32x2*)(sl + SL_VP + lane * 8);
                Frag8 AM; { const pg8::u32x4 t4 = *(const LAS pg8::u32x4*)(sl + SL_AM + lane * 16); AM.u[0] = t4[0]; AM.u[1] = t4[1]; AM.u[2] = t4[2]; AM.u[3] = t4[3]; }
                Frag8 A2f, Bv; A2f.u[0] = 0u; A2f.u[1] = 0u; A2f.u[2] = a2[0]; A2f.u[3] = a2[1]; Bv.u[0] = 0u; Bv.u[1] = 0u; Bv.u[2] = vp[0]; Bv.u[3] = vp[1];
                f32x4 accU = {0.f, 0.f, 0.f, 0.f};
                accU = __builtin_amdgcn_mfma_f32_16x16x32_bf16(A1[0].v, Bs[0].v, accU, 0, 0, 0);
                accU = __builtin_amdgcn_mfma_f32_16x16x32_bf16(A1[1].v, Bs[1].v, accU, 0, 0, 0);
                accU = __builtin_amdgcn_mfma_f32_16x16x32_bf16(A2f.v, Bv.v, accU, 0, 0, 0);
                f32x4 accO = {0.f, 0.f, 0.f, 0.f};
                accO = __builtin_amdgcn_mfma_f32_16x16x32_bf16(AR[0].v, Bs[0].v, accO, 0, 0, 0);
                accO = __builtin_amdgcn_mfma_f32_16x16x32_bf16(AR[1].v, Bs[1].v, accO, 0, 0, 0);
                Frag8 Buv; Buv.u[0] = pk2(accU[0], accU[1]); Buv.u[1] = pk2(accU[2], accU[3]); Buv.u[2] = vp[0]; Buv.u[3] = vp[1];
                accO = __builtin_amdgcn_mfma_f32_16x16x32_bf16(AM.v, Buv.v, accO, 0, 0, 0);
#pragma unroll
                for (int m = 0; m < 4; ++m) {
                    const f32x4 gc = *(const LAS f32x4*)(sl + SL_GC + (16 * m + 4 * fq) * 4);
                    const u32x2 bp = *(const LAS u32x2*)(sl + SL_BPT + ((16 * m + fr) * 16 + 4 * fq) * 2), kp = *(const LAS u32x2*)(sl + SL_KPT + ((16 * m + fr) * 16 + 4 * fq) * 2);
                    Frag8 AS; AS.u[0] = bp[0]; AS.u[1] = bp[1]; AS.u[2] = kp[0]; AS.u[3] = kp[1];
                    f32x4 s = accS[m]; s[0] *= gc[0]; s[1] *= gc[1]; s[2] *= gc[2]; s[3] *= gc[3];
                    accS[m] = __builtin_amdgcn_mfma_f32_16x16x32_bf16(AS.v, Buv.v, s, 0, 0, 0);
                }
                LDS_FENCE();
                if (lane == 0) flags[RW2_NS] = (unsigned)(c + 1);
                const size_t row0 = (size_t)b * SEQL + (size_t)c * 16 + 4 * fq;
#pragma unroll
                for (int i = 0; i < 4; ++i) OUT[(row0 + i) * DM + h * 64 + rg * 16 + fr] = us_bf(accO[i]);
            }
            __builtin_amdgcn_s_setprio(0);
        } else if (wid <= RW2_NP) {
            const int pj = wid - 1; LAS unsigned char* sc = lds_ + RW2_NS * RW2_SLOT + pj * RW2_SCR;
            const int ch = h * 64 + lane; const float kkm = p.in[25][ch], kam = p.in[26][ch];
            const int ss = lane >> 3, sp8 = (lane & 7) * 8;
            pg8::u32x4 qR[2], qK[2], qE[2], qA[2]; unsigned qV[2]; float qG;
#define RW2_LOAD(ROW) do { _Pragma("unroll") for (int j2 = 0; j2 < 2; ++j2) { const size_t o_ = ((ROW) + ss + 8 * j2) * DM + h * 64 + sp8; \
                    qR[j2] = *(const pg8::u32x4*)(R + o_); qK[j2] = *(const pg8::u32x4*)(K + o_); qE[j2] = *(const pg8::u32x4*)(EW + o_); qA[j2] = *(const pg8::u32x4*)(AA + o_); } \
                    _Pragma("unroll") for (int i2 = 0; i2 < 2; ++i2) { const size_t ov = ((ROW) + 4 * fq + 2 * i2) * DM + h * 64 + rg * 16 + fr; qV[i2] = (unsigned)V[ov] | ((unsigned)V[ov + DM] << 16); } \
                    qG = GC[((ROW) >> 4) * DM + h * 64 + lane]; } while (0)
#define RAWK(t) bf_us(*(const LAS unsigned short*)(sc + SC_KT + ((t) * 72 + lane) * 2))
#define RAWE(t) bf_us(*(const LAS unsigned short*)(sc + SC_BT + ((t) * 72 + lane) * 2))
#define RAWA(t) bf_us(*(const LAS unsigned short*)(sl + SL_P1T + ((t) * 72 + lane) * 2))
#define RAWR(t) bf_us(*(const LAS unsigned short*)(sl + SL_RT + ((t) * 72 + lane) * 2))
            RW2_LOAD((size_t)b * SEQL + (size_t)pj * 16);
            for (int c = pj; c < SEQL / 16; c += RW2_NP) {
                const int slot = c & (RW2_NS - 1); LAS unsigned char* sl = lds_ + slot * RW2_SLOT;
                const size_t row0 = (size_t)b * SEQL + (size_t)c * 16;
                while ((int)flags[RW2_NS] < c - (RW2_NS - 1)) __builtin_amdgcn_s_sleep(2);
                LDS_FENCE();
#pragma unroll
                for (int j2 = 0; j2 < 2; ++j2) { const int so = ((ss + 8 * j2) * 72 + sp8) * 2;
                    *(LAS pg8::u32x4*)(sl + SL_RT + so) = qR[j2]; *(LAS pg8::u32x4*)(sc + SC_KT + so) = qK[j2]; *(LAS pg8::u32x4*)(sc + SC_BT + so) = qE[j2]; *(LAS pg8::u32x4*)(sl + SL_P1T + so) = qA[j2]; }
                *(LAS u32x2*)(sl + SL_VP + lane * 8) = (u32x2){qV[0], qV[1]};
                const float gCv = qG;
                LDS_FENCE();
                if (c + RW2_NP < SEQL / 16) RW2_LOAD(row0 + (size_t)RW2_NP * 16);
                {
                    pg8::u32x4 q0, q1;
#pragma unroll
                    for (int i = 0; i < 4; ++i) { q0[i] = pk2(RAWA(2 * i), RAWA(2 * i + 1)); q1[i] = pk2(RAWA(8 + 2 * i), RAWA(8 + 2 * i + 1)); }
                    *(LAS pg8::u32x4*)(sc + SC_ATT + lane * 32) = q0; *(LAS pg8::u32x4*)(sc + SC_ATT + lane * 32 + 16) = q1;
#pragma unroll
                    for (int i = 0; i < 4; ++i) { q0[i] = pk2(RAWE(2 * i) * gCv, RAWE(2 * i + 1) * gCv); q1[i] = pk2(RAWE(8 + 2 * i) * gCv, RAWE(8 + 2 * i + 1) * gCv); }
                    *(LAS pg8::u32x4*)(sl + SL_BPT + lane * 32) = q0; *(LAS pg8::u32x4*)(sl + SL_BPT + lane * 32 + 16) = q1;
#pragma unroll
                    for (int i = 0; i < 4; ++i) { q0[i] = pk2(RAWK(2 * i) * gCv, RAWK(2 * i + 1) * gCv); q1[i] = pk2(RAWK(8 + 2 * i) * gCv, RAWK(8 + 2 * i + 1) * gCv); }
                    *(LAS pg8::u32x4*)(sl + SL_KPT + lane * 32) = q0; *(LAS pg8::u32x4*)(sl + SL_KPT + lane * 32 + 16) = q1;
                    *(LAS float*)(sl + SL_GC + lane * 4) = gCv;
                }
                LDS_FENCE();
                f32x4 gba = {0.f, 0.f, 0.f, 0.f}, gka = gba, gbr = gba, gkr = gba;
#pragma unroll
                for (int k2 = 0; k2 < 2; ++k2) {
                    const int off = (fr * 72 + 32 * k2 + 8 * fq) * 2;
                    const bf16x8 fb = *(const LAS bf16x8*)(sc + SC_BT + off), fk = *(const LAS bf16x8*)(sc + SC_KT + off), fa = *(const LAS bf16x8*)(sl + SL_P1T + off), frt = *(const LAS bf16x8*)(sl + SL_RT + off);
                    gba = __builtin_amdgcn_mfma_f32_16x16x32_bf16(fb, fa, gba, 0, 0, 0); gka = __builtin_amdgcn_mfma_f32_16x16x32_bf16(fk, fa, gka, 0, 0, 0);
                    gbr = __builtin_amdgcn_mfma_f32_16x16x32_bf16(fb, frt, gbr, 0, 0, 0); gkr = __builtin_amdgcn_mfma_f32_16x16x32_bf16(fk, frt, gkr, 0, 0, 0);
                }
                {
                    Frag8 am;
#pragma unroll
                    for (int i = 0; i < 4; ++i) { const int ii = 4 * fq + i; const bool st = ii < fr, le = ii <= fr;
                        *(LAS float*)(sc + SC_L + (ii * 16 + fr) * 4) = st ? gba[i] : 0.f;
                        *(LAS unsigned short*)(sc + SC_LKA + (ii * 24 + fr) * 2) = us_bf(st ? gka[i] : 0.f);
                        gbr[i] = le ? gbr[i] : 0.f; gkr[i] = le ? gkr[i] : 0.f; }
                    am.u[0] = pk2(gbr[0], gbr[1]); am.u[1] = pk2(gbr[2], gbr[3]); am.u[2] = pk2(gkr[0], gkr[1]); am.u[3] = pk2(gkr[2], gkr[3]);
                    pg8::u32x4 t4; t4[0] = am.u[0]; t4[1] = am.u[1]; t4[2] = am.u[2]; t4[3] = am.u[3];
                    *(LAS pg8::u32x4*)(sl + SL_AM + lane * 16) = t4;
                }
                LDS_FENCE();
                float n[16];
#pragma unroll
                for (int j = 0; j < 16; ++j) n[j] = (fr == j) ? 1.0f : 0.f;
#pragma unroll
                for (int i = 14; i >= 0; --i) {
                    if ((i & 1) == 0) asm volatile("" ::: "memory");
                    float Lr[16];
#pragma unroll
                    for (int q = 0; q < 4; ++q) { const f32x4 t4 = *(const LAS f32x4*)(sc + SC_L + (i * 16 + q * 4) * 4); Lr[q * 4] = t4[0]; Lr[q * 4 + 1] = t4[1]; Lr[q * 4 + 2] = t4[2]; Lr[q * 4 + 3] = t4[3]; }
                    float a0 = n[i], a1 = 0.f, a2 = 0.f, a3 = 0.f;
#pragma unroll
                    for (int j = i + 1; j < 16; ++j) { if (((j - i) & 3) == 1) a0 = fmaf(Lr[j], n[j], a0); else if (((j - i) & 3) == 2) a1 = fmaf(Lr[j], n[j], a1); else if (((j - i) & 3) == 3) a2 = fmaf(Lr[j], n[j], a2); else a3 = fmaf(Lr[j], n[j], a3); }
                    n[i] = (a0 + a1) + (a2 + a3);
                }
                {
                    pg8::u32x4 q0, q1;
#pragma unroll
                    for (int i = 0; i < 4; ++i) { q0[i] = pk2(n[2 * i], n[2 * i + 1]); q1[i] = pk2(n[8 + 2 * i], n[8 + 2 * i + 1]); }
                    if (fq == 0) { *(LAS pg8::u32x4*)(sc + SC_NT + fr * 48) = q0; *(LAS pg8::u32x4*)(sc + SC_NT + fr * 48 + 16) = q1; }
                }
                LDS_FENCE();
                const bf16x8 z8 = {0, 0, 0, 0, 0, 0, 0, 0};
                const bf16x8 fnt = fq < 2 ? *(const LAS bf16x8*)(sc + SC_NT + fr * 48 + fq * 16) : z8;
                const bf16x8 flk = fq < 2 ? *(const LAS bf16x8*)(sc + SC_LKA + fr * 48 + fq * 16) : z8;
                f32x4 z4 = {0.f, 0.f, 0.f, 0.f};
                const f32x4 d2 = __builtin_amdgcn_mfma_f32_16x16x32_bf16(flk, fnt, z4, 0, 0, 0);
                *(LAS u32x2*)(sl + SL_A2 + lane * 8) = (u32x2){pk2(d2[0], d2[1]), pk2(d2[2], d2[3])};
#pragma unroll
                for (int tl = 0; tl < 4; ++tl) {
                    const bf16x8 fat = fq < 2 ? *(const LAS bf16x8*)(sc + SC_ATT + (16 * tl + fr) * 32 + fq * 16) : z8;
                    const f32x4 d = __builtin_amdgcn_mfma_f32_16x16x32_bf16(fnt, fat, z4, 0, 0, 0);
#pragma unroll
                    for (int i = 0; i < 4; ++i) *(LAS unsigned short*)(sl + SL_P1T + ((4 * fq + i) * 72 + 16 * tl + fr) * 2) = us_bf(d[i]);
                }
                LDS_FENCE();
                if (lane == 0) flags[slot] = (unsigned)(c + 1);
            }
        }
    }
}

#undef RW2_LOAD
#undef RAWK
#undef RAWE
#undef RAWA
#undef RAWR
__device__ __forceinline__ void phase_rw_post(const P& p, const bf16_t* OUT, const float* CB, const bf16_t* V, const bf16_t* SZ, bf16_t* OF) {
    const size_t nth = (size_t)gridDim.x * 512;
    for (size_t it = (size_t)blockIdx.x * 512 + otid(); it < (size_t)MTOK * 128; it += nth) {
        const int c0 = (int)(it & 127) * 8; const size_t row = it >> 7, o = row * DM + c0;
        float ov[8], v[8], sz[8];
        unpack8(*(const uint4*)(OUT + o), ov); unpack8(*(const uint4*)(V + o), v); unpack8(*(const uint4*)(SZ + o), sz);
        const float dot = CB[row * 16 + (c0 >> 6)];
        float sm = 0.f;
#pragma unroll
        for (int i = 0; i < 8; ++i) sm += ov[i];
        const float mean = red8(sm) * (1.0f / 64.0f);
        float q = 0.f;
#pragma unroll
        for (int i = 0; i < 8; ++i) { ov[i] -= mean; q += ov[i] * ov[i]; }
        const float rs = rsqrtf(red8(q) * (1.0f / 64.0f) + 64e-5f);
        float y[8];
#pragma unroll
        for (int i = 0; i < 8; ++i) y[i] = (ov[i] * rs * p.in[28][c0 + i] + p.in[29][c0 + i] + dot * v[i]) * sz[i];
        *(uint4*)(OF + o) = make_uint4(pk2(y[0], y[1]), pk2(y[2], y[3]), pk2(y[4], y[5]), pk2(y[6], y[7]));
    }
}

__global__ void __launch_bounds__(512, 2) fwd_mega(P p) {
    extern __shared__ __attribute__((aligned(16))) unsigned char shm[];
    LAS unsigned char* lds = (LAS unsigned char*)shm;
    LAS float* tile = (LAS float*)shm;
    volatile LAS unsigned* xst = (volatile LAS unsigned*)(lds + LDS_XST);
    if (threadIdx.x == 0) { xst[0] = 0u; xst[1] = 0u; }
    __syncthreads();
    const XcdBarrier xb = xcd_barrier_post((unsigned*)(p.ws + BAR_OFF), xst);
    unsigned char* ws = p.ws; float* X = p.out;
    bf16_t* act = (bf16_t*)(ws + ACT); bf16_t* pb = (bf16_t*)(ws + PB);
    phase_prep(p, tile);
    xcd_barrier(xb);
    for (int d = 0; d < DUP_PREP; ++d) { phase_prep(p, tile); xcd_barrier(xb); }
    for (int d = 0; d < DUP_SYNC; ++d) xcd_barrier(xb);
#define LAYER_TAIL(L, Aout, Wout, Wpe, Wpg, PEB) \
    { EpiWout E; E.X = X; E.RB = act; run_gemm(lds, Aout, Wout, 1024, 1024, E); } \
    { EpiBf16 E; E.O = PEB; E.ldo = 1024; E.split = 1 << 20; E.stride = 0; run_gemm(lds, pb, Wpe, 1024, 256, E); } \
    xcd_barrier(xb); \
    { EpiPle E; E.X = X; E.PE = PEB; run_gemm(lds, act, Wpg, 1024, 1024, E); } \
    xcd_barrier(xb); \
    phase_ln(X, act, p.in[33] + (L) * 1024, p.in[34] + (L) * 1024);
#define CONV_LAYER(L, j) { \
        bf16_t* U = (bf16_t*)(ws + T0); bf16_t* G = (bf16_t*)(ws + T0 + 32 * MiB); \
        { EpiConvIn E; E.U = U; E.G = G; run_gemm(lds, act, (const bf16_t*)(ws + W_CIN), 4096, 1024, E); } \
        xcd_barrier(xb); \
        phase_conv_ew(U, G, p.in[3] + (size_t)(j) * 3 * 1024); \
        if ((L) > 0) cvt_pb(p.in[1] + (size_t)(L) * MTOK * 256, pb); \
        xcd_barrier(xb); \
        LAYER_TAIL(L, G, (const bf16_t*)(ws + W_COUT), (const bf16_t*)(ws + W_PEC), (const bf16_t*)(ws + W_PGC), (bf16_t*)(ws + T0 + 64 * MiB)) }
    CONV_LAYER(0, 0)
    xcd_barrier(xb);
    {
        float* U = (float*)(ws + T0); bf16_t* SZ = (bf16_t*)(ws + T0 + 64 * MiB); bf16_t* YG = (bf16_t*)(ws + T0 + 96 * MiB); bf16_t* V = (bf16_t*)(ws + T0 + 128 * MiB);
        float* HL = (float*)(ws + T0 + 160 * MiB);
        { EpiSsmIn E; E.U = U; E.SZ = SZ; run_gemm(lds, act, (const bf16_t*)(ws + W_SIN), 2048, 1024, E); }
        xcd_barrier(xb);
        phase_s5<0>(p, lds, U, HL, YG);
        cvt_pb(p.in[1] + (size_t)1 * MTOK * 256, pb);
        xcd_barrier(xb);
        phase_s5<1>(p, lds, U, HL, YG);
        xcd_barrier(xb);
        for (int d = 0; d < DUP_S5; ++d) { phase_s5<0>(p, lds, U, HL, YG); xcd_barrier(xb); phase_s5<1>(p, lds, U, HL, YG); xcd_barrier(xb); }
        { EpiGlu E; E.YG = YG; E.SZ = SZ; E.bias = p.in[15]; E.V = V; run_gemm(lds, YG, (const bf16_t*)(ws + W_SGLU), 1024, 1024, E); }
        xcd_barrier(xb);
        LAYER_TAIL(1, V, (const bf16_t*)(ws + W_SOUT), (const bf16_t*)(ws + W_PE1), (const bf16_t*)(ws + W_PG1), (bf16_t*)(ws + T0))
    }
    xcd_barrier(xb);
    {
        bf16_t* XS = (bf16_t*)(ws + T0); bf16_t* RKV = (bf16_t*)(ws + T0 + 64 * MiB);
        bf16_t* Rb = RKV; bf16_t* Kb = RKV + (size_t)MTOK * DM; bf16_t* Vb = RKV + (size_t)2 * MTOK * DM;
        bf16_t* SZ = act; bf16_t* L1 = pb; bf16_t* DW = (bf16_t*)(ws + T0); bf16_t* DA = (bf16_t*)(ws + T0 + 32 * MiB);
        bf16_t* OUT = (bf16_t*)(ws + OUT_RW); bf16_t* OF = (bf16_t*)(ws + T0);
        const bf16_t* Wrk = (const bf16_t*)(ws + W_RK);
        phase_rw_prep(X, XS, p.in[17], p.in[17] + 1024);
        xcd_barrier(xb);
        { EpiBf16 E; E.O = Rb; E.ldo = 1024; E.split = 1 << 20; E.stride = 0; run_gemm(lds, XS, Wrk, 1024, 1024, E); }
        { EpiBf16 E; E.O = Kb; E.ldo = 1024; E.split = 1 << 20; E.stride = 0; run_gemm(lds, XS + (size_t)MTOK * DM, Wrk + (size_t)1024 * 1024, 1024, 1024, E); }
        phase_rw_lora1(lds, X, Wrk + (size_t)4096 * 1024, L1);
        xcd_barrier(xb);
        phase_rw_prep(X, XS, p.in[17] + 2 * 1024, p.in[17] + 3 * 1024);
        xcd_barrier(xb);
        { EpiBf16 E; E.O = Vb; E.ldo = 1024; E.split = 1 << 20; E.stride = 0; run_gemm(lds, XS, Wrk + (size_t)2 * 1024 * 1024, 1024, 1024, E); }
        { EpiBf16T<1> E; E.O = SZ; E.ldo = 1024; E.split = 1 << 20; E.stride = 0; run_gemm(lds, XS + (size_t)MTOK * DM, Wrk + (size_t)3 * 1024 * 1024, 1024, 1024, E); }
        xcd_barrier(xb);
        { EpiLora2 E; E.EW = DW; E.AA = DA; E.w0 = p.in[19]; E.a0 = p.in[22]; run_gemm(lds, L1, (const bf16_t*)(ws + W_L2), 2048, 256, E); }
        xcd_barrier(xb);
        float* GCb = (float*)(ws + T0 + 160 * MiB); float* CBb = (float*)(ws + T0 + 165 * MiB);
        phase_rw_tables(p, Rb, Kb, DW, DA, GCb, CBb);
        xcd_barrier(xb);
        phase_rw_scan2(p, lds, Rb, Kb, Vb, DW, DA, GCb, OUT);
        xcd_barrier(xb);
        for (int d = 0; d < DUP_RWSCAN; ++d) { phase_rw_scan<DUP_MODE>(p, lds, Rb, Kb, Vb, DW, DA, OUT); xcd_barrier(xb); }
        phase_rw_post(p, OUT, CBb, Vb, SZ, OF);
        cvt_pb(p.in[1] + (size_t)2 * MTOK * 256, pb);
        xcd_barrier(xb);
        LAYER_TAIL(2, OF, (const bf16_t*)(ws + W_ROUT), (const bf16_t*)(ws + W_PE2), (const bf16_t*)(ws + W_PG2), (bf16_t*)(ws + T0 + 32 * MiB))
        __syncthreads();
        conv_layer_weights(p, tile, 1, 3);
    }
    xcd_barrier(xb);
    CONV_LAYER(3, 1)
}

extern "C" void kernel_launch(void* const* d_in, const int* in_sizes, int n_in, void* d_out, int out_size, void* d_ws, size_t ws_size, hipStream_t stream) {
    static int grid_blocks = 0;
    if (!grid_blocks) {
        int dev = 0, cus = 0, per_cu = 0;
        hipGetDevice(&dev);
        hipDeviceGetAttribute(&cus, hipDeviceAttributeMultiprocessorCount, dev);
        hipFuncSetAttribute((const void*)fwd_mega, hipFuncAttributeMaxDynamicSharedMemorySize, LDS_BYTES);
        hipOccupancyMaxActiveBlocksPerMultiprocessor(&per_cu, (const void*)fwd_mega, 512, LDS_BYTES);
        if (per_cu < 1) { fprintf(stderr, "occupancy query returned %d\n", per_cu); per_cu = 1; }
        grid_blocks = cus;
        if (ws_size < 256 * MiB) fprintf(stderr, "workspace too small: %zu\n", ws_size);
    }
    P p{};
    for (int i = 0; i < 35; ++i) p.in[i] = (const float*)d_in[i];
    p.out = (float*)d_out; p.ws = (unsigned char*)d_ws;
    hipMemsetAsync((unsigned char*)d_ws + BAR_OFF, 0, XCD_BAR_WORDS * sizeof(unsigned), stream);
    void* args[] = {&p};
    hipError_t e = hipLaunchCooperativeKernel((const void*)fwd_mega, dim3(grid_blocks), dim3(512), args, LDS_BYTES, stream);
    if (e != hipSuccess) fprintf(stderr, "cooperative launch failed: %s (grid %d)\n", hipGetErrorString(e), grid_blocks);
}
```

```cpp
#include <hip/hip_runtime.h>
#include <hip/hip_cooperative_groups.h>
#include <cstdio>
namespace cg = cooperative_groups;
namespace pg8 {
#define PG8_LAS __attribute__((address_space(3)))
typedef unsigned short bf16_t;
typedef short bf16x8 __attribute__((ext_vector_type(8)));
typedef float f32x4 __attribute__((ext_vector_type(4)));
typedef unsigned u32x4 __attribute__((ext_vector_type(4)));
constexpr int BM = 256, BK = 64, HALF = 128, HTB = HALF * BK * 2  , STAGE_BYTES = 8 * HTB, NXCD = 8, WGM = 8;

__host__ __device__ __forceinline__ int lds_byte(int r, int c) { const int st = (r >> 4) * 2 + (c >> 5), rr = r & 15, cc = c & 31, ob = rr * 64 + cc * 2; return st * 1024 + (ob ^ (((ob >> 9) & 1) << 5)); }
__host__ __device__ __forceinline__ void stage_rc(int b, int& R, int& C) { const int st = b / 1024, sb = b % 1024, swz = sb ^ (((sb >> 9) & 1) << 5); R = (st >> 1) * 16 + swz / 64; C = (st & 1) * 32 + (swz % 64) / 2; }
__host__ __device__ __forceinline__ int perm32(int rho) { const int n = rho >> 4, i = rho & 15; return 8 * (i >> 2) + 4 * n + (i & 3); }

struct Unit { int pm, pn; };
struct Gemm { const bf16_t* A; const bf16_t* Bt; int M, N, K; };
struct StaticOrder {
    int nM, nN, nwg, G, c;
    __host__ __device__ void init(int M, int N, int G_, int c_) { nM = M / BM; nN = N / BM; nwg = nM * nN; G = G_; c = c_; }
    __host__ __device__ bool next(int i, Unit& u) const {
        const long L = (long)i * G + c; if (L >= nwg) return false;
        int wgid = (int)L; { const int q = nwg / NXCD, r = nwg % NXCD, xcd = wgid % NXCD, off = wgid / NXCD; wgid = (xcd < r ? xcd * (q + 1) : r * (q + 1) + (xcd - r) * q) + off; }
        const int nig = WGM * nN, gid = wgid / nig, fm = gid * WGM, gsz = (nM - fm) < WGM ? (nM - fm) : WGM;
        u.pm = fm + ((wgid % nig) % gsz); u.pn = (wgid % nig) / gsz; return true;
    }
    __device__ __forceinline__ void a_ready(const Unit&) const {}
    __device__ __forceinline__ void done(const Unit&) const {}
};
__device__ __forceinline__ unsigned cvt_pk_bf16(float lo, float hi) { unsigned r; asm volatile("v_cvt_pk_bf16_f32 %0, %1, %2" : "=v"(r) : "v"(lo), "v"(hi)); return r; }
template <class Epi, class Sched, bool STAMP = false>
__device__ __forceinline__ void gemm_phase(PG8_LAS unsigned char* lds, const Gemm g, const Sched& S, const Epi& E, unsigned long long* stamps) {
    int tid_o = threadIdx.x; asm volatile("" : "+v"(tid_o)); const int tid = tid_o, wid = __builtin_amdgcn_readfirstlane(tid >> 6), lane = tid & 63, wr = wid >> 2, wc = wid & 3, fr = lane & 15, fq = lane >> 4;
    const int K = g.K, nt = K / BK;
    int ts_lo = 0, ts_hi = 0, nts = 0; const unsigned long long rt_entry = STAMP ? (unsigned long long)wall_clock64() : 0ull;
#define PG8_STAMP() do { if (STAMP && wid == 0 && nts < 64) { const unsigned long long _c = (unsigned long long)clock64(); \
        ts_lo = (lane == nts) ? (int)(unsigned)_c : ts_lo; ts_hi = (lane == nts) ? (int)(unsigned)(_c >> 32) : ts_hi; ++nts; } } while (0)
    PG8_STAMP();
    unsigned voffA[2], voffB[2];
#pragma unroll
    for (int i = 0; i < 2; ++i) { int R, C; stage_rc(tid * 16 + i * 8192, R, C); const int Rb = Epi::PERM ? ((R & ~31) + perm32(R & 31)) : R;
        voffA[i] = (unsigned)(R * K + C) * 2u; voffB[i] = (unsigned)(Rb * K + C) * 2u; }
    const size_t kstep = (size_t)(BK * 2);
    const size_t hstep = (size_t)HALF * K * 2;
    const size_t tstep = 2 * hstep;
    const unsigned ldsw = (unsigned)wid * 1024u;
    const int aoff = lds_byte(wr * 64 + fr, fq * 8), boff = lds_byte(wc * 32 + fr, fq * 8);
#define PG8_SA(b, h) (((b) * 2 + (h)) * HTB)
#define PG8_SB(b, h) ((4 + (b) * 2 + (h)) * HTB)
#define PG8_STAGE(bufoff, gbase, voff) do { _Pragma("unroll") for (int _i = 0; _i < 2; ++_i) \
        __builtin_amdgcn_global_load_lds((const unsigned*)((const char*)(gbase) + (voff)[_i]), (PG8_LAS unsigned*)(lds + (bufoff) + ldsw + _i * 8192), 16, 0, 0); } while (0)
#define PG8_LDA(dst, b, h) do { _Pragma("unroll") for (int m = 0; m < 4; ++m) _Pragma("unroll") for (int k = 0; k < 2; ++k) dst[m][k] = *(const PG8_LAS bf16x8*)(lds + PG8_SA(b, h) + aoff + m * 2048 + k * 1024); } while (0)
#define PG8_LDB(dst, b, h) do { _Pragma("unroll") for (int n = 0; n < 2; ++n) _Pragma("unroll") for (int k = 0; k < 2; ++k) dst[n][k] = *(const PG8_LAS bf16x8*)(lds + PG8_SB(b, h) + boff + n * 2048 + k * 1024); } while (0)
#define PG8_MMA(ai, bj, At, Bt) do { __builtin_amdgcn_s_setprio(1); _Pragma("unroll") for (int m = 0; m < 4; ++m) _Pragma("unroll") for (int n = 0; n < 2; ++n) _Pragma("unroll") for (int k = 0; k < 2; ++k) \
        acc[ai][bj][m][n] = __builtin_amdgcn_mfma_f32_16x16x32_bf16(Bt[n][k], At[m][k], acc[ai][bj][m][n], 0, 0, 0); __builtin_amdgcn_s_setprio(0); } while (0)
#define PG8_WAIT_V(n) asm volatile("s_waitcnt vmcnt(" #n ")" ::: "memory")
#define PG8_WAIT_L(n) asm volatile("s_waitcnt lgkmcnt(" #n ")" ::: "memory")
#define PG8_BAR __builtin_amdgcn_s_barrier()
#define PG8_SCHED __builtin_amdgcn_sched_barrier(0)
    Unit cur, nxt; int ui = 0;
    if (!S.next(0, cur)) return;
    f32x4 acc[2][2][4][2];
#pragma unroll
    for (int a = 0; a < 2; ++a)
#pragma unroll
        for (int b = 0; b < 2; ++b)
#pragma unroll
            for (int m = 0; m < 4; ++m)
#pragma unroll
                for (int n = 0; n < 2; ++n) acc[a][b][m][n] = (f32x4){0.f, 0.f, 0.f, 0.f};
    bf16x8 At[4][2], B0[2][2], B1[2][2];
    const char* cA = (const char*)g.A + (size_t)cur.pm * tstep; const char* cB = (const char*)g.Bt + (size_t)cur.pn * tstep;
    S.a_ready(cur);
    PG8_STAGE(PG8_SB(0, 0), cB, voffB); PG8_STAGE(PG8_SA(0, 0), cA, voffA); PG8_STAGE(PG8_SB(0, 1), cB + hstep, voffB); PG8_STAGE(PG8_SA(0, 1), cA + hstep, voffA);
    if (wr == 1) PG8_BAR;
    PG8_WAIT_V(4); PG8_BAR;
    PG8_STAGE(PG8_SB(1, 0), cB + kstep, voffB); PG8_STAGE(PG8_SA(1, 0), cA + kstep, voffA); PG8_STAGE(PG8_SB(1, 1), cB + hstep + kstep, voffB);
    PG8_WAIT_V(6); PG8_BAR;
    PG8_STAMP();
    for (;;) {
        const bool has_next = S.next(ui + 1, nxt);
        const char* nA = has_next ? (const char*)g.A + (size_t)nxt.pm * tstep : cA; const char* nB = has_next ? (const char*)g.Bt + (size_t)nxt.pn * tstep : cB;
        for (int t = 0; t < nt; t += 2) {
            const bool last = (t == nt - 2);
            const char* a1 = cA + (size_t)(t + 1) * kstep;
            const char* a2 = last ? nA : cA + (size_t)(t + 2) * kstep; const char* b2 = last ? nB : cB + (size_t)(t + 2) * kstep;
            const char* a3 = a2 + kstep; const char* b3 = b2 + kstep;
            if (last && has_next) S.a_ready(nxt);
            PG8_LDB(B0, 0, 0); PG8_SCHED; PG8_LDA(At, 0, 0); PG8_STAGE(PG8_SA(1, 1), a1 + hstep, voffA);
            PG8_WAIT_L(8); PG8_BAR; PG8_WAIT_L(0); PG8_MMA(0, 0, At, B0); PG8_BAR; PG8_SCHED;
            PG8_LDB(B1, 0, 1); PG8_STAGE(PG8_SB(0, 0), b2, voffB);
            PG8_BAR; PG8_WAIT_L(0); PG8_MMA(0, 1, At, B1); PG8_BAR;
            PG8_LDA(At, 0, 1); PG8_STAGE(PG8_SA(0, 0), a2, voffA);
            PG8_BAR; PG8_WAIT_L(0); PG8_MMA(1, 0, At, B0); PG8_BAR; PG8_SCHED;
            PG8_STAGE(PG8_SB(0, 1), b2 + hstep, voffB);
            PG8_WAIT_V(6); PG8_BAR; PG8_MMA(1, 1, At, B1); PG8_BAR;
            PG8_LDB(B0, 1, 0); PG8_SCHED; PG8_LDA(At, 1, 0); PG8_STAGE(PG8_SA(0, 1), a2 + hstep, voffA);
            PG8_WAIT_L(8); PG8_BAR; PG8_WAIT_L(0); PG8_MMA(0, 0, At, B0); PG8_BAR; PG8_SCHED;
            PG8_LDB(B1, 1, 1); PG8_STAGE(PG8_SB(1, 0), b3, voffB);
            PG8_BAR; PG8_WAIT_L(0); PG8_MMA(0, 1, At, B1); PG8_BAR;
            PG8_LDA(At, 1, 1); PG8_STAGE(PG8_SA(1, 0), a3, voffA);
            PG8_BAR; PG8_WAIT_L(0); PG8_MMA(1, 0, At, B0); PG8_BAR; PG8_SCHED;
            PG8_STAGE(PG8_SB(1, 1), b3 + hstep, voffB);
            PG8_WAIT_V(6); PG8_BAR; PG8_MMA(1, 1, At, B1); PG8_BAR;
        }
        PG8_STAMP();
        if constexpr (!Epi::AFTER_DRAIN) { E(acc, cur, wr, wc, fr, fq); S.done(cur); }
        PG8_STAMP();
        if (!has_next) break;
#pragma unroll
        for (int a = 0; a < 2; ++a)
#pragma unroll
            for (int b = 0; b < 2; ++b)
#pragma unroll
                for (int m = 0; m < 4; ++m)
#pragma unroll
                    for (int n = 0; n < 2; ++n) acc[a][b][m][n] = (f32x4){0.f, 0.f, 0.f, 0.f};
        cur = nxt; cA = nA; cB = nB; ++ui;
    }
    PG8_WAIT_V(0);
    if (wr == 0) PG8_BAR;
    PG8_BAR;
    if constexpr (Epi::AFTER_DRAIN) { E.fused(acc, cur, wr, wc, fr, fq, lds, wid, lane); S.done(cur); }
    PG8_STAMP();
    if (STAMP && wid == 0) { stamps[lane] = lane < nts ? (((unsigned long long)(unsigned)ts_hi << 32) | (unsigned)ts_lo) : 0ull;
        if (lane == 62) stamps[62] = rt_entry; if (lane == 63) stamps[63] = (unsigned long long)wall_clock64(); }
#undef PG8_STAMP
#undef PG8_SA
#undef PG8_SB
#undef PG8_STAGE
#undef PG8_LDA
#undef PG8_LDB
#undef PG8_MMA
#undef PG8_WAIT_V
#undef PG8_WAIT_L
#undef PG8_BAR
#undef PG8_SCHED
}
}
using pg8::bf16_t; using pg8::bf16x8; using pg8::f32x4; using pg8::Unit; using pg8::Gemm; using pg8::StaticOrder;
#define LAS __attribute__((address_space(3)))
constexpr int MTOK = 16384, DM = 1024, SEQL = 4096;
constexpr size_t MiB = 1u << 20, KiB = 1u << 10;
constexpr float DN_ALPHA = 1.6817928305074290f;
constexpr size_t W_CIN = 0, W_COUT = 8 * MiB, W_PEC = 10 * MiB, W_PGC = 10 * MiB + 512 * KiB;
constexpr size_t W_SIN = 12 * MiB + 512 * KiB, W_SGLU = 16 * MiB + 512 * KiB, W_SOUT = 18 * MiB + 512 * KiB, W_PE1 = 20 * MiB + 512 * KiB, W_PG1 = 21 * MiB;
constexpr size_t W_RK = 23 * MiB, W_L2 = 40 * MiB, W_ROUT = 41 * MiB, W_PE2 = 43 * MiB, W_PG2 = 43 * MiB + 512 * KiB;
constexpr size_t OUT_RW = 0, PB = 46 * MiB, ACT = 54 * MiB, T0 = 86 * MiB;
constexpr int LDS_XST = 155648;
constexpr int LDS_BYTES = LDS_XST + 16;
#ifndef DUP_PREP
#define DUP_PREP 0
#define DUP_RWSCAN 0
#define DUP_S5 0
#define DUP_RK 0
#define DUP_SYNC 0
#define DUP_EW 0
#endif
#ifndef DUP_MODE
#define DUP_MODE 0
#endif

struct P { const float* in[35]; float* out; unsigned char* ws; };
#define XB_TMO      128
#define XB_XCNT(j)  (256  + 64 * (j))
#define XB_XSUB(j)  (1280 + 64 * (j))
#define XB_XGEN(j)  (2304 + 64 * (j))
#define XB_TOP      3328
#define XB_TOPGEN   3392
#define XCD_BAR_WORDS 3456
#define XB_SPIN_CAP (1u << 18)

__device__ __forceinline__ unsigned xb_ld(unsigned* p)              { return __hip_atomic_load(p, __ATOMIC_RELAXED, __HIP_MEMORY_SCOPE_AGENT); }
__device__ __forceinline__ unsigned xb_add(unsigned* p, unsigned v) { return __hip_atomic_fetch_add(p, v, __ATOMIC_RELAXED, __HIP_MEMORY_SCOPE_AGENT); }
__device__ __forceinline__ unsigned xb_xcc_id() { return (unsigned)__builtin_amdgcn_s_getreg((3 << 11) | 20) & 0xFu; }
#define XB_SPIN(cond, bar) do { unsigned _sp = 0; while (cond) { __builtin_amdgcn_s_sleep(1); \
    if ((++_sp & 255u) == 0u) { if (xb_ld(&(bar)[XB_TMO])) break; if (_sp > XB_SPIN_CAP) { atomicAdd(&(bar)[XB_TMO], 1u); break; } } } } while (0)

struct XcdBarrier {
    unsigned* bar; unsigned x;
    volatile LAS unsigned* st;
};

__device__ __forceinline__ XcdBarrier xcd_barrier_post(unsigned* bar, volatile LAS unsigned* st) {
    XcdBarrier b; b.bar = bar; b.x = xb_xcc_id(); b.st = st;
    if (threadIdx.x == 0) (void)xb_add(&bar[XB_XCNT(b.x)], 1u);
    return b;
}
__device__ __forceinline__ void xcd_barrier_complete(unsigned* bar, unsigned x, unsigned& nloc, unsigned& nx) {
    const unsigned G = gridDim.x * gridDim.y * gridDim.z;
    unsigned sum, cnt, mine, sp = 0u;
    for (;;) {
        sum = 0u; cnt = 0u; mine = 0u;
#pragma unroll
        for (unsigned j = 0; j < 16; ++j) { const unsigned c = xb_ld(&bar[XB_XCNT(j)]); sum += c; cnt += (c > 0u) ? 1u : 0u; mine = (j == x) ? c : mine; }
        if (sum == G) break;
        __builtin_amdgcn_s_sleep(1);
        if ((++sp & 255u) == 0u) { if (xb_ld(&bar[XB_TMO])) break; if (sp > XB_SPIN_CAP) { atomicAdd(&bar[XB_TMO], 1u); break; } }
    }
    nloc = mine > 0u ? mine : 1u; nx = cnt > 0u ? cnt : 1u;
}

__device__ __forceinline__ void xcd_barrier(const XcdBarrier& b) {
    asm volatile("s_waitcnt vmcnt(0)" ::: "memory");
    __syncthreads();
    if (threadIdx.x == 0) {
        unsigned* bar = b.bar;
        __builtin_amdgcn_s_waitcnt(0);
        unsigned nloc = b.st[0], nx = b.st[1];
        if (nloc == 0u) { xcd_barrier_complete(bar, b.x, nloc, nx); b.st[0] = nloc; b.st[1] = nx; }
        const unsigned old = xb_add(&bar[XB_XSUB(b.x)], 1u);
        const unsigned gen = old / nloc;
        if (old + 1u == (gen + 1u) * nloc) {
            __builtin_amdgcn_fence(__ATOMIC_RELEASE, "agent");
            asm volatile("s_waitcnt vmcnt(0)" ::: "memory");
            const unsigned og = xb_add(&bar[XB_TOP], 1u);
            const unsigned tg = og / nx;
            if (og + 1u == (tg + 1u) * nx) xb_add(&bar[XB_TOPGEN], 1u);
            else XB_SPIN(xb_ld(&bar[XB_TOPGEN]) == tg, bar);
            __builtin_amdgcn_fence(__ATOMIC_ACQUIRE, "agent");
            xb_add(&bar[XB_XGEN(b.x)], 1u);
            asm volatile("s_waitcnt vmcnt(0)" ::: "memory");
        } else {
            XB_SPIN(xb_ld(&bar[XB_XGEN(b.x)]) == gen, bar);
            __builtin_amdgcn_fence(__ATOMIC_ACQUIRE, "agent");
            asm volatile("s_waitcnt vmcnt(0)" ::: "memory");
        }
    }
    __syncthreads();
}

constexpr size_t BAR_OFF = 254 * MiB;


typedef __bf16 bf2_t __attribute__((ext_vector_type(2)));
typedef float f2_t __attribute__((ext_vector_type(2)));
__device__ __forceinline__ unsigned pk2(float lo, float hi) { f2_t v = {lo, hi}; bf2_t b = __builtin_convertvector(v, bf2_t); return __builtin_bit_cast(unsigned, b); }
__device__ __forceinline__ float bflo(unsigned u) { return __uint_as_float(u << 16); }
__device__ __forceinline__ float bfhi(unsigned u) { return __uint_as_float(u & 0xffff0000u); }
__device__ __forceinline__ float rcpf_(float x) { return __builtin_amdgcn_rcpf(x); }
__device__ __forceinline__ float sigmoidf_(float x) { return rcpf_(1.0f + __expf(-x)); }
__device__ __forceinline__ float siluf_(float x) { return x * rcpf_(1.0f + __expf(-x)); }
__device__ __forceinline__ float tanhf_(float x) { const float e = __expf(-2.0f * fabsf(x)); const float t = (1.0f - e) * rcpf_(1.0f + e); return x < 0.f ? -t : t; }
__device__ __forceinline__ float gelu_tanh(float x) { return 0.5f * x * (1.0f + tanhf_(0.7978845608028654f * (x + 0.044715f * x * x * x))); }
template <int CTRL> __device__ __forceinline__ float dppf(float x) { return __int_as_float(__builtin_amdgcn_update_dpp(0, __float_as_int(x), CTRL, 0xF, 0xF, true)); }
__device__ __forceinline__ float red8(float x) { x += dppf<0xB1>(x); x += dppf<0x4E>(x); x += dppf<0x141>(x); return x; }
__device__ __forceinline__ float red16(float x) { x = red8(x); x += dppf<0x140>(x); return x; }
__device__ __forceinline__ float wave_sum(float v) { for (int o = 32; o >= 1; o >>= 1) v += __shfl_xor(v, o); return v; }
__device__ __forceinline__ int otid() { int t = threadIdx.x; asm volatile("" : "+v"(t)); return t; }
typedef float f32x2 __attribute__((ext_vector_type(2)));
__device__ __forceinline__ float fma_s(float a, float b, float c) { float d; asm("v_fma_f32 %0, %1, %2, %3" : "=v"(d) : "v"(a), "v"(b), "v"(c)); return d; }
__device__ __forceinline__ float fnma_s(float a, float b, float c) { float d; asm("v_fma_f32 %0, -%1, %2, %3" : "=v"(d) : "v"(a), "v"(b), "v"(c)); return d; }
__device__ __forceinline__ float mul_s(float a, float b) { float d; asm("v_mul_f32 %0, %1, %2" : "=v"(d) : "v"(a), "v"(b)); return d; }
__device__ __forceinline__ float add_s(float a, float b) { float d; asm("v_add_f32 %0, %1, %2" : "=v"(d) : "v"(a), "v"(b)); return d; }
#define BAR_LDS() asm volatile("s_waitcnt lgkmcnt(0)\n\ts_barrier" ::: "memory")
#define LDS_FENCE() asm volatile("s_waitcnt lgkmcnt(0)" ::: "memory")

struct EpiConvIn {
    static constexpr bool PERM = false, AFTER_DRAIN = false;
    bf16_t* U; bf16_t* G;
    __device__ __forceinline__ void operator()(const f32x4 (&acc)[2][2][4][2], const Unit& u, int wr, int wc, int fr, int fq) const {
        const int row0 = u.pm * 256 + wr * 64 + fr, e0 = u.pn * 64 + wc * 16 + 4 * fq;
#pragma unroll
        for (int ai = 0; ai < 2; ++ai)
#pragma unroll
            for (int m = 0; m < 4; ++m) {
                const size_t o = (size_t)(row0 + ai * 128 + m * 16) * DM + e0;
                float uu[4], gg[4];
#pragma unroll
                for (int j = 0; j < 4; ++j) { uu[j] = acc[ai][0][m][1][j] * acc[ai][1][m][0][j]; gg[j] = acc[ai][0][m][0][j] * siluf_(acc[ai][1][m][1][j]); }
                *(uint2*)(U + o) = make_uint2(pk2(uu[0], uu[1]), pk2(uu[2], uu[3]));
                *(uint2*)(G + o) = make_uint2(pk2(gg[0], gg[1]), pk2(gg[2], gg[3]));
            }
    }
};
struct EpiWout {
    static constexpr bool PERM = false, AFTER_DRAIN = false;
    float* X; bf16_t* RB;
    __device__ __forceinline__ void operator()(const f32x4 (&acc)[2][2][4][2], const Unit& u, int wr, int wc, int fr, int fq) const {
        const int row0 = u.pm * 256 + wr * 64 + fr, col0 = u.pn * 256 + wc * 32 + 4 * fq;
#pragma unroll
        for (int ai = 0; ai < 2; ++ai)
#pragma unroll
            for (int m = 0; m < 4; ++m)
#pragma unroll
                for (int bj = 0; bj < 2; ++bj)
#pragma unroll
                    for (int n = 0; n < 2; ++n) {
                        const size_t o = (size_t)(row0 + ai * 128 + m * 16) * DM + col0 + bj * 128 + n * 16;
                        f32x4 x = *(const f32x4*)(X + o);
                        f32x4 r = x * DN_ALPHA + acc[ai][bj][m][n];
                        *(f32x4*)(X + o) = r;
                        *(uint2*)(RB + o) = make_uint2(pk2(r[0], r[1]), pk2(r[2], r[3]));
                    }
    }
};
template <int ACT> struct EpiBf16T {
    static constexpr bool PERM = false, AFTER_DRAIN = false;
    bf16_t* O; int ldo; int split; size_t stride;
    __device__ __forceinline__ void operator()(const f32x4 (&acc)[2][2][4][2], const Unit& u, int wr, int wc, int fr, int fq) const {
        const int row0 = u.pm * 256 + wr * 64 + fr; const int grp = u.pn / split; const int col0 = (u.pn - grp * split) * 256 + wc * 32 + 4 * fq;
        bf16_t* base = O + (size_t)grp * stride;
#pragma unroll
        for (int ai = 0; ai < 2; ++ai)
#pragma unroll
            for (int m = 0; m < 4; ++m)
#pragma unroll
                for (int bj = 0; bj < 2; ++bj)
#pragma unroll
                    for (int n = 0; n < 2; ++n) {
                        const size_t o = (size_t)(row0 + ai * 128 + m * 16) * ldo + col0 + bj * 128 + n * 16;
                        f32x4 a = acc[ai][bj][m][n];
                        if (ACT == 1) { a[0] = siluf_(a[0]); a[1] = siluf_(a[1]); a[2] = siluf_(a[2]); a[3] = siluf_(a[3]); }
                        *(uint2*)(base + o) = make_uint2(pk2(a[0], a[1]), pk2(a[2], a[3]));
                    }
    }
};
typedef EpiBf16T<0> EpiBf16;
struct EpiPle {
    static constexpr bool PERM = false, AFTER_DRAIN = false;
    float* X; const bf16_t* PE;
    __device__ __forceinline__ void operator()(const f32x4 (&acc)[2][2][4][2], const Unit& u, int wr, int wc, int fr, int fq) const {
        const int row0 = u.pm * 256 + wr * 64 + fr, col0 = u.pn * 256 + wc * 32 + 4 * fq;
#pragma unroll
        for (int ai = 0; ai < 2; ++ai)
#pragma unroll
            for (int m = 0; m < 4; ++m)
#pragma unroll
                for (int bj = 0; bj < 2; ++bj)
#pragma unroll
                    for (int n = 0; n < 2; ++n) {
                        const size_t o = (size_t)(row0 + ai * 128 + m * 16) * DM + col0 + bj * 128 + n * 16;
                        f32x4 x = *(const f32x4*)(X + o); const uint2 pe = *(const uint2*)(PE + o); const f32x4 a = acc[ai][bj][m][n];
                        x[0] += bflo(pe.x) * sigmoidf_(a[0]); x[1] += bfhi(pe.x) * sigmoidf_(a[1]); x[2] += bflo(pe.y) * sigmoidf_(a[2]); x[3] += bfhi(pe.y) * sigmoidf_(a[3]);
                        *(f32x4*)(X + o) = x;
                    }
    }
};
struct EpiSsmIn {
    static constexpr bool PERM = false, AFTER_DRAIN = false;
    float* U; bf16_t* SZ;
    __device__ __forceinline__ void operator()(const f32x4 (&acc)[2][2][4][2], const Unit& u, int wr, int wc, int fr, int fq) const {
        const int row0 = u.pm * 256 + wr * 64 + fr; const bool isz = u.pn >= 4; const int col0 = (u.pn & 3) * 256 + wc * 32 + 4 * fq;
#pragma unroll
        for (int ai = 0; ai < 2; ++ai)
#pragma unroll
            for (int m = 0; m < 4; ++m)
#pragma unroll
                for (int bj = 0; bj < 2; ++bj)
#pragma unroll
                    for (int n = 0; n < 2; ++n) {
                        const size_t o = (size_t)(row0 + ai * 128 + m * 16) * DM + col0 + bj * 128 + n * 16;
                        const f32x4 a = acc[ai][bj][m][n];
                        if (isz) *(uint2*)(SZ + o) = make_uint2(pk2(siluf_(a[0]), siluf_(a[1])), pk2(siluf_(a[2]), siluf_(a[3])));
                        else *(f32x4*)(U + o) = a;
                    }
    }
};
struct EpiGlu {
    static constexpr bool PERM = false, AFTER_DRAIN = false;
    const bf16_t* YG; const bf16_t* SZ; const float* bias; bf16_t* V;
    __device__ __forceinline__ void operator()(const f32x4 (&acc)[2][2][4][2], const Unit& u, int wr, int wc, int fr, int fq) const {
        const int row0 = u.pm * 256 + wr * 64 + fr, col0 = u.pn * 256 + wc * 32 + 4 * fq;
#pragma unroll
        for (int ai = 0; ai < 2; ++ai)
#pragma unroll
            for (int m = 0; m < 4; ++m)
#pragma unroll
                for (int bj = 0; bj < 2; ++bj)
#pragma unroll
                    for (int n = 0; n < 2; ++n) {
                        const int col = col0 + bj * 128 + n * 16;
                        const size_t o = (size_t)(row0 + ai * 128 + m * 16) * DM + col;
                        const f32x4 a = acc[ai][bj][m][n]; const f32x4 bb = *(const f32x4*)(bias + col);
                        const uint2 y = *(const uint2*)(YG + o), z = *(const uint2*)(SZ + o);
                        const float v0 = bflo(y.x) * sigmoidf_(a[0] + bb[0]) * bflo(z.x), v1 = bfhi(y.x) * sigmoidf_(a[1] + bb[1]) * bfhi(z.x);
                        const float v2 = bflo(y.y) * sigmoidf_(a[2] + bb[2]) * bflo(z.y), v3 = bfhi(y.y) * sigmoidf_(a[3] + bb[3]) * bfhi(z.y);
                        *(uint2*)(V + o) = make_uint2(pk2(v0, v1), pk2(v2, v3));
                    }
    }
};
struct EpiRk {
    static constexpr bool PERM = false, AFTER_DRAIN = false;
    bf16_t* RKV; bf16_t* SZ; bf16_t* L1;
    __device__ __forceinline__ void operator()(const f32x4 (&acc)[2][2][4][2], const Unit& u, int wr, int wc, int fr, int fq) const {
        const int row0 = u.pm * 256 + wr * 64 + fr; const int grp = u.pn >> 2; const int colt = (u.pn & 3) * 256 + wc * 32 + 4 * fq;
#pragma unroll
        for (int ai = 0; ai < 2; ++ai)
#pragma unroll
            for (int m = 0; m < 4; ++m)
#pragma unroll
                for (int bj = 0; bj < 2; ++bj)
#pragma unroll
                    for (int n = 0; n < 2; ++n) {
                        const int row = row0 + ai * 128 + m * 16, col = colt + bj * 128 + n * 16;
                        const f32x4 a = acc[ai][bj][m][n];
                        if (grp < 3) *(uint2*)(RKV + (size_t)grp * MTOK * DM + (size_t)row * DM + col) = make_uint2(pk2(a[0], a[1]), pk2(a[2], a[3]));
                        else if (grp == 3) *(uint2*)(SZ + (size_t)row * DM + col) = make_uint2(pk2(siluf_(a[0]), siluf_(a[1])), pk2(siluf_(a[2]), siluf_(a[3])));
                        else { const bool th = col < 64;
                            const float v0 = th ? tanhf_(a[0]) : a[0], v1 = th ? tanhf_(a[1]) : a[1], v2 = th ? tanhf_(a[2]) : a[2], v3 = th ? tanhf_(a[3]) : a[3];
                            *(uint2*)(L1 + (size_t)row * 256 + col) = make_uint2(pk2(v0, v1), pk2(v2, v3)); }
                    }
    }
};

struct EpiLora2 {
    static constexpr bool PERM = false, AFTER_DRAIN = false;
    bf16_t* EW; bf16_t* AA; const float* w0; const float* a0;
    template <int ISA> __device__ __forceinline__ void body(const f32x4 (&acc)[2][2][4][2], bf16_t* O, const float* bias, int row0, int col0) const {
#pragma unroll
        for (int ai = 0; ai < 2; ++ai)
#pragma unroll
            for (int m = 0; m < 4; ++m)
#pragma unroll
                for (int bj = 0; bj < 2; ++bj)
#pragma unroll
                    for (int n = 0; n < 2; ++n) {
                        const int col = col0 + bj * 128 + n * 16; const f32x4 bb = *(const f32x4*)(bias + col);
                        const f32x4 a = acc[ai][bj][m][n]; float v[4];
#pragma unroll
                        for (int j = 0; j < 4; ++j) { const float t = bb[j] + a[j];
                            if (ISA) v[j] = sigmoidf_(t);
                            else { const float sp = fmaxf(-t, 0.f) + __logf(1.0f + __expf(-fabsf(t))); v[j] = __expf(-sp - 0.5f); } }
                        *(uint2*)(O + (size_t)(row0 + ai * 128 + m * 16) * DM + col) = make_uint2(pk2(v[0], v[1]), pk2(v[2], v[3]));
                    }
    }
    __device__ __forceinline__ void operator()(const f32x4 (&acc)[2][2][4][2], const Unit& u, int wr, int wc, int fr, int fq) const {
        const int row0 = u.pm * 256 + wr * 64 + fr; const int col0 = (u.pn & 3) * 256 + wc * 32 + 4 * fq;
        if (u.pn >= 4) body<1>(acc, AA, a0, row0, col0); else body<0>(acc, EW, w0, row0, col0);
    }
};

template <class Epi> __device__ __forceinline__ void run_gemm(LAS unsigned char* lds, const bf16_t* A, const bf16_t* Bt, int N, int K, const Epi& E) {
    int Kv = K; asm volatile("" : "+s"(Kv));
    Gemm g; g.A = A; g.Bt = Bt; g.M = MTOK; g.N = N; g.K = Kv;
    StaticOrder S; S.init(MTOK, N, (int)gridDim.x, (int)blockIdx.x);
    pg8::gemm_phase<Epi, StaticOrder, false>(lds, g, S, E, nullptr);
}

__device__ __forceinline__ int conv_rowmap(int n) { const int s = n >> 10, e = n & 1023, q = e & 63; return 256 * (e >> 6) + 128 * (s >> 1) + 32 * (q >> 4) + 16 * (s & 1) + (q & 15); }
__device__ __forceinline__ void tr_job(LAS float* tile, const float* src, int ld_src, int K, int N, bf16_t* dst, int ldd, int koff, const float* kscale, int mode, int rot) {
    const int nblk = (int)gridDim.x, blk = ((int)blockIdx.x + rot) % nblk, tid = otid();
    const int tn_ = N >> 6, ntiles = (K >> 6) * tn_;
    const int tk0 = tid >> 4, tn4 = (tid & 15) * 4, nl = tid >> 3, kp = (tid & 7) * 8;
    f32x4 cur[2];
    if (blk < ntiles) { const int k0 = (blk / tn_) << 6, n0 = (blk % tn_) << 6;
#pragma unroll
        for (int i = 0; i < 2; ++i) cur[i] = *(const f32x4*)(src + (size_t)(k0 + tk0 + i * 32) * ld_src + n0 + tn4); }
    for (int t = blk; t < ntiles; t += nblk) {
        const int k0 = (t / tn_) << 6, n0 = (t % tn_) << 6;
        f32x4 nxt[2];
        const int t2 = t + nblk;
        if (t2 < ntiles) { const int k2 = (t2 / tn_) << 6, n2 = (t2 % tn_) << 6;
#pragma unroll
            for (int i = 0; i < 2; ++i) nxt[i] = *(const f32x4*)(src + (size_t)(k2 + tk0 + i * 32) * ld_src + n2 + tn4); }
        BAR_LDS();
#pragma unroll
        for (int i = 0; i < 2; ++i) *(LAS f32x4*)(tile + (tk0 + i * 32) * 68 + tn4) = cur[i];
        BAR_LDS();
        float v[8];
#pragma unroll
        for (int i = 0; i < 8; ++i) { v[i] = tile[(kp + i) * 68 + nl]; if (kscale) v[i] *= kscale[k0 + kp + i]; }
        const int n = n0 + nl; const int row = mode ? conv_rowmap(n) : n;
        *(uint4*)(dst + (size_t)row * ldd + koff + k0 + kp) = make_uint4(pk2(v[0], v[1]), pk2(v[2], v[3]), pk2(v[4], v[5]), pk2(v[6], v[7]));
        if (t2 < ntiles) { cur[0] = nxt[0]; cur[1] = nxt[1]; }
    }
}
__device__ __forceinline__ void cvt_pb(const float* src, bf16_t* dst) {
    const size_t n4 = (size_t)MTOK * 256 / 4, nth = (size_t)gridDim.x * 512;
    for (size_t i = (size_t)blockIdx.x * 512 + otid(); i < n4; i += nth) { const float4 v = ((const float4*)src)[i]; ((uint2*)dst)[i] = make_uint2(pk2(v.x, v.y), pk2(v.z, v.w)); }
}
__device__ __forceinline__ void conv_layer_weights(const P& p, LAS float* tile, int j, int L) {
    unsigned char* ws = p.ws;
    tr_job(tile, p.in[2] + (size_t)j * 1024 * 4096, 4096, 1024, 4096, (bf16_t*)(ws + W_CIN), 1024, 0, nullptr, 1, 0);
    tr_job(tile, p.in[4] + (size_t)j * 1024 * 1024, 1024, 1024, 1024, (bf16_t*)(ws + W_COUT), 1024, 0, nullptr, 0, 0);
    tr_job(tile, p.in[31] + (size_t)L * 256 * 1024, 1024, 256, 1024, (bf16_t*)(ws + W_PEC), 256, 0, nullptr, 0, 0);
    tr_job(tile, p.in[32] + (size_t)L * 1024 * 1024, 1024, 1024, 1024, (bf16_t*)(ws + W_PGC), 1024, 0, nullptr, 0, 64);
}

__device__ __forceinline__ void phase_prep(const P& p, LAS float* tile) {
    unsigned char* ws = p.ws; const size_t nth = (size_t)gridDim.x * 512, gt = (size_t)blockIdx.x * 512 + otid();
    {
        const float4* x = (const float4*)p.in[0]; float4* o = (float4*)p.out; uint2* a = (uint2*)(ws + ACT);
        for (size_t i = gt; i < (size_t)MTOK * DM / 4; i += nth) { const float4 v = x[i]; o[i] = v; a[i] = make_uint2(pk2(v.x, v.y), pk2(v.z, v.w)); }
    }
    cvt_pb(p.in[1], (bf16_t*)(ws + PB));
    conv_layer_weights(p, tile, 0, 0);
    tr_job(tile, p.in[5], 2048, 1024, 2048, (bf16_t*)(ws + W_SIN), 1024, 0, nullptr, 0, 128);
    tr_job(tile, p.in[14], 1024, 1024, 1024, (bf16_t*)(ws + W_SGLU), 1024, 0, nullptr, 0, 0);
    tr_job(tile, p.in[16], 1024, 1024, 1024, (bf16_t*)(ws + W_SOUT), 1024, 0, nullptr, 0, 0);
    tr_job(tile, p.in[31] + (size_t)1 * 256 * 1024, 1024, 256, 1024, (bf16_t*)(ws + W_PE1), 256, 0, nullptr, 0, 192);
    tr_job(tile, p.in[32] + (size_t)1 * 1024 * 1024, 1024, 1024, 1024, (bf16_t*)(ws + W_PG1), 1024, 0, nullptr, 0, 0);
    bf16_t* rk = (bf16_t*)(ws + W_RK);
    for (int g = 0; g < 4; ++g)
        tr_job(tile, p.in[18] + (size_t)g * 1024 * 1024, 1024, 1024, 1024, rk + (size_t)g * 1024 * 1024, 1024, 0, nullptr, 0, g * 64);
    bf16_t* wl = rk + (size_t)4096 * 1024;
    tr_job(tile, p.in[20], 64, 1024, 64, wl, 2048, 0, nullptr, 0, 0);
    tr_job(tile, p.in[20], 64, 1024, 64, wl, 2048, 1024, p.in[17] + 4 * 1024, 0, 16);
    tr_job(tile, p.in[23], 64, 1024, 64, wl + (size_t)64 * 2048, 2048, 0, nullptr, 0, 32);
    tr_job(tile, p.in[23], 64, 1024, 64, wl + (size_t)64 * 2048, 2048, 1024, p.in[17] + 5 * 1024, 0, 48);
    bf16_t* l2 = (bf16_t*)(ws + W_L2);
    tr_job(tile, p.in[21], 1024, 64, 1024, l2, 256, 0, nullptr, 0, 64);
    tr_job(tile, p.in[24], 1024, 64, 1024, l2 + (size_t)1024 * 256, 256, 64, nullptr, 0, 80);
    for (size_t i = gt; i < (size_t)2048 * 32; i += nth) { const int row = (int)(i >> 5), c8 = (int)(i & 31); const bool data = row < 1024 ? (c8 < 8) : (c8 >= 8 && c8 < 16);
        if (!data) *(uint4*)(l2 + (size_t)row * 256 + c8 * 8) = make_uint4(0, 0, 0, 0); }
    tr_job(tile, p.in[30], 1024, 1024, 1024, (bf16_t*)(ws + W_ROUT), 1024, 0, nullptr, 0, 96);
    tr_job(tile, p.in[31] + (size_t)2 * 256 * 1024, 1024, 256, 1024, (bf16_t*)(ws + W_PE2), 256, 0, nullptr, 0, 160);
    tr_job(tile, p.in[32] + (size_t)2 * 1024 * 1024, 1024, 1024, 1024, (bf16_t*)(ws + W_PG2), 1024, 0, nullptr, 0, 0);
}

__device__ __forceinline__ void phase_conv_ew(const bf16_t* U, bf16_t* G, const float* ck) {
    const size_t nth = (size_t)gridDim.x * 512;
    for (size_t i = (size_t)blockIdx.x * 512 + otid(); i < (size_t)MTOK * 128; i += nth) {
        const int row = (int)(i >> 7), c8 = (int)(i & 127) * 8, t = row & (SEQL - 1);
        const uint4 z4 = make_uint4(0, 0, 0, 0);
        const uint4 u0 = *(const uint4*)(U + (size_t)row * DM + c8);
        const uint4 u1 = t >= 1 ? *(const uint4*)(U + (size_t)(row - 1) * DM + c8) : z4;
        const uint4 u2 = t >= 2 ? *(const uint4*)(U + (size_t)(row - 2) * DM + c8) : z4;
        const uint4 g = *(const uint4*)(G + (size_t)row * DM + c8);
        const unsigned a0[4] = {u0.x, u0.y, u0.z, u0.w}, a1[4] = {u1.x, u1.y, u1.z, u1.w}, a2[4] = {u2.x, u2.y, u2.z, u2.w}, gg[4] = {g.x, g.y, g.z, g.w};
        unsigned o[4];
#pragma unroll
        for (int q = 0; q < 4; ++q) {
            const int c = c8 + 2 * q;
            const float lo = bflo(gg[q]) * (ck[c] * bflo(a2[q]) + ck[1024 + c] * bflo(a1[q]) + ck[2048 + c] * bflo(a0[q]));
            const float hi = bfhi(gg[q]) * (ck[c + 1] * bfhi(a2[q]) + ck[1024 + c + 1] * bfhi(a1[q]) + ck[2048 + c + 1] * bfhi(a0[q]));
            o[q] = pk2(lo, hi);
        }
        *(uint4*)(G + (size_t)row * DM + c8) = make_uint4(o[0], o[1], o[2], o[3]);
    }
}

__device__ __forceinline__ void phase_ln(float* X, bf16_t* XB, const float* g, const float* b) {
    const int lane = otid() & 63, gw = blockIdx.x * 8 + (otid() >> 6), nw = gridDim.x * 8;
    for (int row = gw; row < MTOK; row += nw) {
        float4 v[4]; float s = 0.f;
#pragma unroll
        for (int i = 0; i < 4; ++i) { v[i] = *(const float4*)(X + (size_t)row * DM + i * 256 + lane * 4); s += v[i].x + v[i].y + v[i].z + v[i].w; }
        const float mean = wave_sum(s) * (1.0f / 1024.0f);
        float q = 0.f;
#pragma unroll
        for (int i = 0; i < 4; ++i) { v[i].x -= mean; v[i].y -= mean; v[i].z -= mean; v[i].w -= mean; q += v[i].x * v[i].x + v[i].y * v[i].y + v[i].z * v[i].z + v[i].w * v[i].w; }
        const float rs = rsqrtf(wave_sum(q) * (1.0f / 1024.0f) + 1e-5f);
#pragma unroll
        for (int i = 0; i < 4; ++i) { const int c = i * 256 + lane * 4; const float4 gg = *(const float4*)(g + c), bb = *(const float4*)(b + c);
            float4 y; y.x = v[i].x * rs * gg.x + bb.x; y.y = v[i].y * rs * gg.y + bb.y; y.z = v[i].z * rs * gg.z + bb.z; y.w = v[i].w * rs * gg.w + bb.w;
            *(float4*)(X + (size_t)row * DM + c) = y; *(uint2*)(XB + (size_t)row * DM + c) = make_uint2(pk2(y.x, y.y), pk2(y.z, y.w)); }
    }
}

template <int MODE> __device__ __forceinline__ void phase_s5(const P& p, LAS unsigned char* lds_, float* U, float* HLOC, bf16_t* YG) {
    const int lane = otid() & 63, wid = otid() >> 6, nw = gridDim.x * 8;
    LAS float* ul = (LAS float*)(lds_ + wid * 8192);
    LAS unsigned* S = (LAS unsigned*)(lds_ + wid * 8192 + 2048);
    const int fr = lane & 15, fq = lane >> 4;
    for (int un = blockIdx.x * 8 + wid; un < 2048; un += nw) {
        const int g = un & 63, sc = (un >> 6) & 7, b = un >> 9;
        const float dt = __expf(p.in[8][g]);
        const float lre = p.in[6][g * 64 + lane], lim = p.in[7][g * 64 + lane];
        const float mag = expf(lre * dt); float sn, cs; sincosf(lim * dt, &sn, &cs);
        const float are = mag * cs, aim = mag * sn;
        f32x2 Bp[16];
        if (MODE == 0) {
            const float d2 = lre * lre + lim * lim, cfre = ((are - 1.0f) * lre + aim * lim) / d2, cfim = (aim * lre - (are - 1.0f) * lim) / d2;
#pragma unroll
            for (int q = 0; q < 4; ++q) { const float4 br = *(const float4*)(p.in[9] + (size_t)(g * 64 + lane) * 16 + q * 4), bi = *(const float4*)(p.in[10] + (size_t)(g * 64 + lane) * 16 + q * 4);
                const float brr[4] = {br.x, br.y, br.z, br.w}, bii[4] = {bi.x, bi.y, bi.z, bi.w};
#pragma unroll
                for (int j = 0; j < 4; ++j) { Bp[q * 4 + j] = (f32x2){cfre * brr[j] - cfim * bii[j], cfre * bii[j] + cfim * brr[j]}; } }
        }
        float hre = 0.f, him = 0.f;
        bf16x8 Cf[4]; float dsk = 0.f;
        if (MODE == 1) {
            float lr = are, li = aim;
#pragma unroll
            for (int i = 0; i < 9; ++i) { const float t = lr * lr - li * li; li = 2.0f * lr * li; lr = t; }
            for (int s2 = 0; s2 < sc; ++s2) { const float2 hv = *(const float2*)(HLOC + ((size_t)((b * 8 + s2) * 64 + g) * 64 + lane) * 2);
                const float t = lr * hre - li * him + hv.x; him = lr * him + li * hre + hv.y; hre = t; }
        }
#pragma unroll
        for (int kk = 0; kk < 4; ++kk) {
            unsigned w[4];
#pragma unroll
            for (int i = 0; i < 4; ++i) { const int pi = 16 * kk + 4 * fq + i; const size_t o = (size_t)(g * 16 + fr) * 64 + pi; w[i] = pk2(p.in[11][o], -p.in[12][o]); }
            union { unsigned u[4]; bf16x8 v; } cv; cv.u[0] = w[0]; cv.u[1] = w[1]; cv.u[2] = w[2]; cv.u[3] = w[3]; Cf[kk] = cv.v;
        }
        if (MODE == 0) dsk = p.in[13][g * 16 + fr];
        const size_t tok0 = (size_t)b * SEQL + (size_t)sc * 512;
        const float* ug = U + tok0 * DM + g * 16 + (lane & 3) * 4 + (size_t)(lane >> 2) * DM;
        f32x4 nxt = *(const f32x4*)ug;
        LDS_FENCE();
        *(LAS f32x4*)(ul + lane * 4) = nxt;
        for (int blk = 0; blk < 32; ++blk) {
            const int cur = blk & 1;
            if (blk + 1 < 32) nxt = *(const f32x4*)(ug + (size_t)(blk + 1) * 16 * DM);
            LDS_FENCE();
            if (MODE == 0) {
#pragma unroll 4
                for (int tt = 0; tt < 16; ++tt) {
                    float uu[16];
#pragma unroll
                    for (int q = 0; q < 4; ++q) { const f32x4 t4 = *(const LAS f32x4*)(ul + cur * 256 + tt * 16 + q * 4); uu[q * 4] = t4[0]; uu[q * 4 + 1] = t4[1]; uu[q * 4 + 2] = t4[2]; uu[q * 4 + 3] = t4[3]; }
                    f32x2 b0 = {0.f, 0.f}, b1 = {0.f, 0.f};
#pragma unroll
                    for (int h = 0; h < 16; h += 2) { b0 = Bp[h] * (f32x2){uu[h], uu[h]} + b0; b1 = Bp[h + 1] * (f32x2){uu[h + 1], uu[h + 1]} + b1; }
                    const f32x2 bs = b0 + b1; const float bre = bs[0], bim = bs[1];
                    const float t = are * hre - aim * him + bre; him = are * him + aim * hre + bim; hre = t;
                    S[tt * 68 + lane] = pk2(hre, him);
                }
            } else {
#pragma unroll
                for (int tt = 0; tt < 16; ++tt) { const float t = are * hre - aim * him; him = are * him + aim * hre; hre = t; S[tt * 68 + lane] = pk2(hre, him); }
            }
            LDS_FENCE();
            f32x4 acc = {0.f, 0.f, 0.f, 0.f};
#pragma unroll
            for (int kk = 0; kk < 4; ++kk) { const bf16x8 af = *(const LAS bf16x8*)(S + fr * 68 + 16 * kk + 4 * fq); acc = __builtin_amdgcn_mfma_f32_16x16x32_bf16(af, Cf[kk], acc, 0, 0, 0); }
#pragma unroll
            for (int i = 0; i < 4; ++i) { const int tl = 4 * fq + i; const size_t o = (tok0 + blk * 16 + tl) * DM + g * 16 + fr;
                if (MODE == 0) U[o] = acc[i] + dsk * ul[cur * 256 + tl * 16 + fr];
                else YG[o] = (unsigned short)(pk2(gelu_tanh(acc[i] + ul[cur * 256 + tl * 16 + fr]), 0.f) & 0xffffu); }
            LDS_FENCE();
            if (blk + 1 < 32) *(LAS f32x4*)(ul + (cur ^ 1) * 256 + lane * 4) = nxt;
        }
        if (MODE == 0) *(float2*)(HLOC + ((size_t)un * 64 + lane) * 2) = make_float2(hre, him);
    }
}

constexpr int L1_BROW = 72;
__device__ __forceinline__ void phase_rw_lora1(LAS unsigned char* lds_, const float* X, const bf16_t* Wl, bf16_t* L1) {
    LAS bf16_t* Bs = (LAS bf16_t*)lds_;
    const int tid = otid(), lane = tid & 63, wid = tid >> 6, fr = lane & 15, fq = lane >> 4, mt = wid >> 1, ch = wid & 1;
    const int sn = tid >> 2, sq = tid & 3;
    for (int item = blockIdx.x; item < MTOK / 64; item += gridDim.x) {
        const int row = item * 64 + mt * 16 + fr, t = row & (SEQL - 1);
        const float* xr = X + (size_t)row * DM + fq * 8; const float* xpr = xr - DM;
        f32x4 acc[4];
#pragma unroll
        for (int n = 0; n < 4; ++n) acc[n] = (f32x4){0.f, 0.f, 0.f, 0.f};
        __syncthreads();
        pg8::u32x4 sb[2][2];
#pragma unroll
        for (int pt = 0; pt < 2; ++pt)
#pragma unroll
            for (int h = 0; h < 2; ++h) sb[pt][h] = *(const pg8::u32x4*)(Wl + (size_t)sn * 2048 + pt * 1024 + sq * 16 + h * 8);
        for (int ks = 0; ks < 16; ++ks) {
            const int st = ks & 1;
#pragma unroll
            for (int pt = 0; pt < 2; ++pt)
#pragma unroll
                for (int h = 0; h < 2; ++h) *(LAS pg8::u32x4*)(Bs + ((st * 2 + pt) * 128 + sn) * L1_BROW + sq * 16 + h * 8) = sb[pt][h];
            if (ks + 1 < 16) {
#pragma unroll
                for (int pt = 0; pt < 2; ++pt)
#pragma unroll
                    for (int h = 0; h < 2; ++h) sb[pt][h] = *(const pg8::u32x4*)(Wl + (size_t)sn * 2048 + pt * 1024 + (ks + 1) * 64 + sq * 16 + h * 8);
            }
            BAR_LDS();
#pragma unroll
            for (int k2 = 0; k2 < 2; ++k2) {
                const int k = ks * 64 + k2 * 32;
                const float4 x0 = *(const float4*)(xr + k), x1 = *(const float4*)(xr + k + 4);
                float4 p0 = make_float4(0.f, 0.f, 0.f, 0.f), p1 = p0;
                if (t >= 1) { p0 = *(const float4*)(xpr + k); p1 = *(const float4*)(xpr + k + 4); }
                union { unsigned u[4]; bf16x8 v; } ax, ad;
                ax.u[0] = pk2(x0.x, x0.y); ax.u[1] = pk2(x0.z, x0.w); ax.u[2] = pk2(x1.x, x1.y); ax.u[3] = pk2(x1.z, x1.w);
                ad.u[0] = pk2(p0.x - x0.x, p0.y - x0.y); ad.u[1] = pk2(p0.z - x0.z, p0.w - x0.w); ad.u[2] = pk2(p1.x - x1.x, p1.y - x1.y); ad.u[3] = pk2(p1.z - x1.z, p1.w - x1.w);
#pragma unroll
                for (int n = 0; n < 4; ++n) {
                    const bf16x8 b0 = *(const LAS bf16x8*)(Bs + ((st * 2 + 0) * 128 + ch * 64 + n * 16 + fr) * L1_BROW + k2 * 32 + fq * 8);
                    const bf16x8 b1 = *(const LAS bf16x8*)(Bs + ((st * 2 + 1) * 128 + ch * 64 + n * 16 + fr) * L1_BROW + k2 * 32 + fq * 8);
                    acc[n] = __builtin_amdgcn_mfma_f32_16x16x32_bf16(ax.v, b0, acc[n], 0, 0, 0);
                    acc[n] = __builtin_amdgcn_mfma_f32_16x16x32_bf16(ad.v, b1, acc[n], 0, 0, 0);
                }
            }
        }
        const int row0 = item * 64 + mt * 16;
#pragma unroll
        for (int n = 0; n < 4; ++n)
#pragma unroll
            for (int i = 0; i < 4; ++i) { const int r = row0 + fq * 4 + i, col = ch * 64 + n * 16 + fr;
                const float v = ch == 0 ? tanhf_(acc[n][i]) : acc[n][i];
                L1[(size_t)r * 256 + col] = (bf16_t)(pk2(v, 0.f) & 0xffffu); }
#pragma unroll
        for (int q = 0; q < 2; ++q) { const int idx = q * 64 + lane, r = idx >> 3, c8 = idx & 7;
            *(uint4*)(L1 + (size_t)(row0 + r) * 256 + 128 + ch * 64 + c8 * 8) = make_uint4(0, 0, 0, 0); }
    }
}
__device__ __forceinline__ void phase_rw_prep(const float* X, bf16_t* XS, const float* mua, const float* mub) {
    const size_t nth = (size_t)gridDim.x * 512;
    for (size_t i = (size_t)blockIdx.x * 512 + otid(); i < (size_t)MTOK * 256; i += nth) {
        const int row = (int)(i >> 8), c4 = (int)(i & 255) * 4, t = row & (SEQL - 1);
        const float4 x = *(const float4*)(X + (size_t)row * DM + c4);
        float4 xp = make_float4(0.f, 0.f, 0.f, 0.f); if (t >= 1) xp = *(const float4*)(X + (size_t)(row - 1) * DM + c4);
        const float4 ma = *(const float4*)(mua + c4), mb = *(const float4*)(mub + c4);
        const float d0 = xp.x - x.x, d1 = xp.y - x.y, d2 = xp.z - x.z, d3 = xp.w - x.w;
        *(uint2*)(XS + (size_t)row * DM + c4) = make_uint2(pk2(x.x + d0 * ma.x, x.y + d1 * ma.y), pk2(x.z + d2 * ma.z, x.w + d3 * ma.w));
        *(uint2*)(XS + (size_t)MTOK * DM + (size_t)row * DM + c4) = make_uint2(pk2(x.x + d0 * mb.x, x.y + d1 * mb.y), pk2(x.z + d2 * mb.z, x.w + d3 * mb.w));
    }
}
__device__ __forceinline__ void unpack8(const uint4 v, float* f) { f[0] = bflo(v.x); f[1] = bfhi(v.x); f[2] = bflo(v.y); f[3] = bfhi(v.y); f[4] = bflo(v.z); f[5] = bfhi(v.z); f[6] = bflo(v.w); f[7] = bfhi(v.w); }

constexpr int RW_T = 32, RW_STEP = 336;
constexpr int RW_BUF = RW_T * RW_STEP, RW_OB = RW_T * 16 * 16;
struct RwOp { f32x4 r, w, kp, kk, ka; float v; };
__device__ __forceinline__ void rw_load(RwOp& o, const LAS float* sb, int j0, int rr) {
    o.r = *(const LAS f32x4*)(sb + j0); o.w = *(const LAS f32x4*)(sb + 64 + j0); o.kp = *(const LAS f32x4*)(sb + 128 + j0);
    o.kk = *(const LAS f32x4*)(sb + 192 + j0); o.ka = *(const LAS f32x4*)(sb + 256 + j0); o.v = sb[320 + rr];
}
template <int MODE> __device__ __forceinline__ float rw_step(const RwOp& o, float& s0, float& s1, float& s2, float& s3) {
    const float dsum = fmaf(s0, o.kk[0], s1 * o.kk[1]) + fmaf(s2, o.kk[2], s3 * o.kk[3]);
    const float sa = MODE == 3 ? -dsum : -red16(dsum);
    s0 = fmaf(s0, o.w[0], fmaf(sa, o.ka[0], o.v * o.kp[0])); s1 = fmaf(s1, o.w[1], fmaf(sa, o.ka[1], o.v * o.kp[1]));
    s2 = fmaf(s2, o.w[2], fmaf(sa, o.ka[2], o.v * o.kp[2])); s3 = fmaf(s3, o.w[3], fmaf(sa, o.ka[3], o.v * o.kp[3]));
    return fmaf(s0, o.r[0], s1 * o.r[1]) + fmaf(s2, o.r[2], s3 * o.r[3]);
}
__device__ __forceinline__ void rw_flush(const LAS float* ob, bf16_t* dst) {
    float o2[2];
#pragma unroll
    for (int q = 0; q < 2; ++q) { float a = 0.f;
#pragma unroll
        for (int i = 0; i < 4; ++i) { const f32x4 t = *(const LAS f32x4*)(ob + q * 16 + i * 4); a += (t[0] + t[1]) + (t[2] + t[3]); }
        o2[q] = a; }
    *(unsigned*)dst = pk2(o2[0], o2[1]);
}
template <int MODE> __device__ __forceinline__ void phase_rw_scan(const P& p, LAS unsigned char* lds_, const bf16_t* R, const bf16_t* K, const bf16_t* V, const bf16_t* DW, const bf16_t* DA, bf16_t* OUT) {
    LAS float* buf = (LAS float*)lds_;
    LAS float* obuf = buf + 2 * RW_BUF;
    const int tid = otid(), lane = tid & 63, wid = __builtin_amdgcn_readfirstlane(tid >> 6);
    for (int un = blockIdx.x; un < 256; un += gridDim.x) {
        const int bh = un >> 2, rg = un & 3, b = bh >> 4, h = bh & 15;
        __syncthreads();
        if (wid < 4) {
            const int rr = wid * 4 + (lane >> 4), jl = lane & 15, j0 = jl * 4;
            float s0 = 0.f, s1 = 0.f, s2 = 0.f, s3 = 0.f;
            __builtin_amdgcn_s_setprio(3);
            BAR_LDS();
            for (int c = 0; c < SEQL / RW_T; ++c) {
                const LAS float* cb = buf + (c & 1) * RW_BUF; LAS float* ob = obuf + (c & 1) * RW_OB + rr * 16 + jl;
                if (MODE != 1) {
                RwOp ops[3];
                rw_load(ops[0], cb, j0, rr); rw_load(ops[1], cb + RW_STEP, j0, rr);
#pragma unroll
                for (int s = 0; s < RW_T; ++s) {
                    if (s + 2 < RW_T) rw_load(ops[(s + 2) % 3], cb + (s + 2) * RW_STEP, j0, rr);
                    ob[s * 256] = rw_step<MODE>(ops[s % 3], s0, s1, s2, s3);
                }
                }
                BAR_LDS();
            }
            __builtin_amdgcn_s_setprio(0);
        } else {
            const int pt = tid - 256, s = pt >> 3, part = pt & 7, c0 = part * 8, ch = h * 64 + c0;
            float kk_[8], ka_[8];
#pragma unroll
            for (int i = 0; i < 8; ++i) { kk_[i] = p.in[25][ch + i]; ka_[i] = p.in[26][ch + i]; }
            const size_t rowb = (size_t)b * SEQL + s;
            uint4 qr, qk, qw, qa, qv = make_uint4(0, 0, 0, 0);
            { const size_t o = rowb * DM + ch; qr = *(const uint4*)(R + o); qk = *(const uint4*)(K + o); qw = *(const uint4*)(DW + o); qa = *(const uint4*)(DA + o);
              if (part < 2) qv = *(const uint4*)(V + rowb * DM + h * 64 + rg * 16 + part * 8); }
            for (int c = 0; c <= SEQL / RW_T; ++c) {
                uint4 nr = qr, nk = qk, nw = qw, na = qa, nv = qv;
                if (MODE != 2 && c + 1 < SEQL / RW_T) { const size_t row = rowb + (size_t)(c + 1) * RW_T; const size_t o = row * DM + ch;
                    nr = *(const uint4*)(R + o); nk = *(const uint4*)(K + o); nw = *(const uint4*)(DW + o); na = *(const uint4*)(DA + o);
                    if (part < 2) nv = *(const uint4*)(V + row * DM + h * 64 + rg * 16 + part * 8); }
                if (MODE != 2 && c < SEQL / RW_T) {
                    float r[8], k[8], ew[8], aa[8];
                    unpack8(qr, r); unpack8(qk, k); unpack8(qw, ew); unpack8(qa, aa);
                    float wv[8], kp[8], kk[8], ka[8]; float ss = 0.f;
#pragma unroll
                    for (int i = 0; i < 8; ++i) {
                        wv[i] = __expf(-ew[i]);
                        kk[i] = k[i] * kk_[i]; ss = fmaf(kk[i], kk[i], ss);
                        kp[i] = k[i] * fmaf(aa[i] - 1.0f, ka_[i], 1.0f);
                    }
                    ss = red8(ss); const float inv = rcpf_(fmaxf(__builtin_amdgcn_sqrtf(ss), 1e-12f));
#pragma unroll
                    for (int i = 0; i < 8; ++i) { kk[i] *= inv; ka[i] = kk[i] * aa[i]; }
                    LAS float* sb = buf + (c & 1) * RW_BUF + s * RW_STEP + c0;
                    *(LAS f32x4*)(sb) = (f32x4){r[0], r[1], r[2], r[3]}; *(LAS f32x4*)(sb + 4) = (f32x4){r[4], r[5], r[6], r[7]};
                    *(LAS f32x4*)(sb + 64) = (f32x4){wv[0], wv[1], wv[2], wv[3]}; *(LAS f32x4*)(sb + 68) = (f32x4){wv[4], wv[5], wv[6], wv[7]};
                    *(LAS f32x4*)(sb + 128) = (f32x4){kp[0], kp[1], kp[2], kp[3]}; *(LAS f32x4*)(sb + 132) = (f32x4){kp[4], kp[5], kp[6], kp[7]};
                    *(LAS f32x4*)(sb + 192) = (f32x4){kk[0], kk[1], kk[2], kk[3]}; *(LAS f32x4*)(sb + 196) = (f32x4){kk[4], kk[5], kk[6], kk[7]};
                    *(LAS f32x4*)(sb + 256) = (f32x4){ka[0], ka[1], ka[2], ka[3]}; *(LAS f32x4*)(sb + 260) = (f32x4){ka[4], ka[5], ka[6], ka[7]};
                    if (part < 2) { float v[8]; unpack8(qv, v);
                        LAS float* vb = buf + (c & 1) * RW_BUF + s * RW_STEP + 320 + part * 8;
                        *(LAS f32x4*)(vb) = (f32x4){v[0], v[1], v[2], v[3]}; *(LAS f32x4*)(vb + 4) = (f32x4){v[4], v[5], v[6], v[7]}; }
                }
                if (MODE == 0 && c >= 2) {
                    const int cc = c - 2; const size_t row = (size_t)b * SEQL + (size_t)cc * RW_T + s;
                    rw_flush(obuf + (cc & 1) * RW_OB + s * 256 + part * 32, OUT + row * DM + h * 64 + rg * 16 + part * 2);
                }
                BAR_LDS();
                qr = nr; qk = nk; qw = nw; qa = na; qv = nv;
            }
            if (MODE == 0) {
                const int cc = SEQL / RW_T - 1; const size_t row = (size_t)b * SEQL + (size_t)cc * RW_T + s;
                rw_flush(obuf + (cc & 1) * RW_OB + s * 256 + part * 32, OUT + row * DM + h * 64 + rg * 16 + part * 2);
            }
        }
    }
}


constexpr int RW2_NP = 7, RW2_NS = 8, RW2_SLOT = 11264, RW2_SCR = 9216;
constexpr int SL_P1T = 0, SL_RT = 2304, SL_BPT = 4608, SL_KPT = 6656, SL_AM = 8704, SL_A2 = 9728, SL_VP = 10240, SL_GC = 10752;
constexpr int SC_BT = 0, SC_KT = 2304, SC_ATT = 4608, SC_L = 6656, SC_NT = 7680, SC_LKA = 8448;
constexpr int RW2_FLG = RW2_NS * RW2_SLOT + RW2_NP * RW2_SCR;
__device__ __forceinline__ float bf_us(unsigned short x) { return __uint_as_float(((unsigned)x) << 16); }
__device__ __forceinline__ unsigned short us_bf(float v) { return (unsigned short)(pk2(v, 0.f) & 0xffffu); }
typedef unsigned u32x2 __attribute__((ext_vector_type(2)));
union Frag8 { unsigned u[4]; bf16x8 v; };

__device__ __forceinline__ float wave_total(float x) {
    float y = red16(x);
    y += __int_as_float(__builtin_amdgcn_update_dpp(0, __float_as_int(y), 0x142, 0xA, 0xF, false));
    y += __int_as_float(__builtin_amdgcn_update_dpp(0, __float_as_int(y), 0x143, 0xC, 0xF, false));
    return __int_as_float(__builtin_amdgcn_readlane(__float_as_int(y), 63));
}
__device__ __forceinline__ void phase_rw_tables(const P& p, bf16_t* R, bf16_t* K, bf16_t* EW, bf16_t* AA, float* GC, float* CB) {
    const int tid = otid(), lane = tid & 63, wid = tid >> 6, nw = gridDim.x * 8;
    for (int task = blockIdx.x * 8 + wid; task < 16384; task += nw) {
        const int h = task & 15, c = (task >> 4) & 255, b = task >> 12, ch = h * 64 + lane;
        const size_t row0 = (size_t)b * SEQL + (size_t)c * 16;
        const float kkm = p.in[25][ch], kam = p.in[26][ch], rkm = p.in[27][ch];
        unsigned short xr[16], xk[16], xe[16], xa[16];
#pragma unroll
        for (int t = 0; t < 16; ++t) { const size_t o = (row0 + t) * DM + ch; xr[t] = R[o]; xk[t] = K[o]; xe[t] = EW[o]; xa[t] = AA[o]; }
        float n2[16];
#pragma unroll
        for (int t = 0; t < 16; ++t) { const float x = bf_us(xk[t]) * kkm; n2[t] = wave_total(x * x); }
        float g = 1.0f;
#pragma unroll
        for (int t = 0; t < 16; ++t) {
            const float w = __expf(-bf_us(xe[t])), a = bf_us(xa[t]), kft = bf_us(xk[t]), rft = bf_us(xr[t]);
            const float kk = kft * kkm * __builtin_amdgcn_rsqf(fmaxf(n2[t], 1e-24f));
            const float kp = kft * (1.0f + (a - 1.0f) * kam), kka = kk * a;
            const float cb = wave_total(rft * kp * rkm);
            const float gp = g; g *= w; const float ig = rcpf_(g);
            const size_t o = (row0 + t) * DM + ch;
            AA[o] = us_bf(-kk * gp); EW[o] = us_bf(kka * ig); K[o] = us_bf(kp * ig); R[o] = us_bf(rft * g);
            if (lane == 0) CB[(row0 + t) * 16 + h] = cb;
        }
        GC[((size_t)b * 256 + c) * DM + ch] = g;
    }
}

__device__ __forceinline__ void phase_rw_scan2(const P& p, LAS unsigned char* lds_, const bf16_t* R, const bf16_t* K, const bf16_t* V, const bf16_t* EW, const bf16_t* AA, const float* GC, bf16_t* OUT) {
    const int tid = otid(), lane = tid & 63, wid = __builtin_amdgcn_readfirstlane(tid >> 6), fr = lane & 15, fq = lane >> 4;
    volatile LAS unsigned* flags = (volatile LAS unsigned*)(lds_ + RW2_FLG);
    for (int un = blockIdx.x; un < 256; un += gridDim.x) {
        const int bh = un >> 2, rg = un & 3, b = bh >> 4, h = bh & 15;
        __syncthreads();
        if (tid < RW2_NS + 1) flags[tid] = 0u;
        __syncthreads();
        if (wid == 0) {
            f32x4 accS[4];
#pragma unroll
            for (int m = 0; m < 4; ++m) accS[m] = (f32x4){0.f, 0.f, 0.f, 0.f};
            __builtin_amdgcn_s_setprio(3);
            for (int c = 0; c < SEQL / 16; ++c) {
                const int slot = c & (RW2_NS - 1); LAS unsigned char* sl = lds_ + slot * RW2_SLOT;
                while (flags[slot] != (unsigned)(c + 1)) __builtin_amdgcn_s_sleep(1);
                LDS_FENCE();
                Frag8 Bs[2];
#pragma unroll
                for (int k2 = 0; k2 < 2; ++k2) { Bs[k2].u[0] = pk2(accS[2 * k2][0], accS[2 * k2][1]); Bs[k2].u[1] = pk2(accS[2 * k2][2], accS[2 * k2][3]);
                    Bs[k2].u[2] = pk2(accS[2 * k2 + 1][0], accS[2 * k2 + 1][1]); Bs[k2].u[3] = pk2(accS[2 * k2 + 1][2], accS[2 * k2 + 1][3]); }
                Frag8 A1[2], AR[2];
#pragma unroll
                for (int k2 = 0; k2 < 2; ++k2) {
                    const u32x2 x0 = *(const LAS u32x2*)(sl + SL_P1T + (fr * 72 + 32 * k2 + 4 * fq) * 2), x1 = *(const LAS u32x2*)(sl + SL_P1T + (fr * 72 + 32 * k2 + 16 + 4 * fq) * 2);
                    A1[k2].u[0] = x0[0]; A1[k2].u[1] = x0[1]; A1[k2].u[2] = x1[0]; A1[k2].u[3] = x1[1];
                    const u32x2 y0 = *(const LAS u32x2*)(sl + SL_RT + (fr * 72 + 32 * k2 + 4 * fq) * 2), y1 = *(const LAS u32x2*)(sl + SL_RT + (fr * 72 + 32 * k2 + 16 + 4 * fq) * 2);
                    AR[k2].u[0] = y0[0]; AR[k2].u[1] = y0[1]; AR[k2].u[2] = y1[0]; AR[k2].u[3] = y1[1];
                }
                const u32x2 a2 = *(const LAS u32x2*)(sl + SL_A2 + lane * 8), vp = *(const LAS u32x2*)(sl + SL_VP + lane * 8);
                Frag8 AM; { const pg8::u32x4 t4 = *(const LAS pg8::u32x4*)(sl + SL_AM + lane * 16); AM.u[0] = t4[0]; AM.u[1] = t4[1]; AM.u[2] = t4[2]; AM.u[3] = t4[3]; }
                Frag8 A2f, Bv; A2f.u[0] = 0u; A2f.u[1] = 0u; A2f.u[2] = a2[0]; A2f.u[3] = a2[1]; Bv.u[0] = 0u; Bv.u[1] = 0u; Bv.u[2] = vp[0]; Bv.u[3] = vp[1];
                f32x4 accU = {0.f, 0.f, 0.f, 0.f};
                accU = __builtin_amdgcn_mfma_f32_16x16x32_bf16(A1[0].v, Bs[0].v, accU, 0, 0, 0);
                accU = __builtin_amdgcn_mfma_f32_16x16x32_bf16(A1[1].v, Bs[1].v, accU, 0, 0, 0);
                accU = __builtin_amdgcn_mfma_f32_16x16x32_bf16(A2f.v, Bv.v, accU, 0, 0, 0);
                f32x4 accO = {0.f, 0.f, 0.f, 0.f};
                accO = __builtin_amdgcn_mfma_f32_16x16x32_bf16(AR[0].v, Bs[0].v, accO, 0, 0, 0);
                accO = __builtin_amdgcn_mfma_f32_16x16x32_bf16(AR[1].v, Bs[1].v, accO, 0, 0, 0);
                Frag8 Buv; Buv.u[0] = pk2(accU[0], accU[1]); Buv.u[1] = pk2(accU[2], accU[3]); Buv.u[2] = vp[0]; Buv.u[3] = vp[1];
                accO = __builtin_amdgcn_mfma_f32_16x16x32_bf16(AM.v, Buv.v, accO, 0, 0, 0);
#pragma unroll
                for (int m = 0; m < 4; ++m) {
                    const f32x4 gc = *(const LAS f32x4*)(sl + SL_GC + (16 * m + 4 * fq) * 4);
                    const u32x2 bp = *(const LAS u32x2*)(sl + SL_BPT + ((16 * m + fr) * 16 + 4 * fq) * 2), kp = *(const LAS u32x2*)(sl + SL_KPT + ((16 * m + fr) * 16 + 4 * fq) * 2);
                    Frag8 AS; AS.u[0] = bp[0]; AS.u[1] = bp[1]; AS.u[2] = kp[0]; AS.u[3] = kp[1];
                    f32x4 s = accS[m]; s[0] *= gc[0]; s[1] *= gc[1]; s[2] *= gc[2]; s[3] *= gc[3];
                    accS[m] = __builtin_amdgcn_mfma_f32_16x16x32_bf16(AS.v, Buv.v, s, 0, 0, 0);
                }
                LDS_FENCE();
                if (lane == 0) flags[RW2_NS] = (unsigned)(c + 1);
                const size_t row0 = (size_t)b * SEQL + (size_t)c * 16 + 4 * fq;
#pragma unroll
                for (int i = 0; i < 4; ++i) OUT[(row0 + i) * DM + h * 64 + rg * 16 + fr] = us_bf(accO[i]);
            }
            __builtin_amdgcn_s_setprio(0);
        } else if (wid <= RW2_NP) {
            const int pj = wid - 1; LAS unsigned char* sc = lds_ + RW2_NS * RW2_SLOT + pj * RW2_SCR;
            const int ch = h * 64 + lane; const float kkm = p.in[25][ch], kam = p.in[26][ch];
            const int ss = lane >> 3, sp8 = (lane & 7) * 8;
            pg8::u32x4 qR[2], qK[2], qE[2], qA[2]; unsigned qV[2]; float qG;
#define RW2_LOAD(ROW) do { _Pragma("unroll") for (int j2 = 0; j2 < 2; ++j2) { const size_t o_ = ((ROW) + ss + 8 * j2) * DM + h * 64 + sp8; \
                    qR[j2] = *(const pg8::u32x4*)(R + o_); qK[j2] = *(const pg8::u32x4*)(K + o_); qE[j2] = *(const pg8::u32x4*)(EW + o_); qA[j2] = *(const pg8::u32x4*)(AA + o_); } \
                    _Pragma("unroll") for (int i2 = 0; i2 < 2; ++i2) { const size_t ov = ((ROW) + 4 * fq + 2 * i2) * DM + h * 64 + rg * 16 + fr; qV[i2] = (unsigned)V[ov] | ((unsigned)V[ov + DM] << 16); } \
                    qG = GC[((ROW) >> 4) * DM + h * 64 + lane]; } while (0)
#define RAWK(t) bf_us(*(const LAS unsigned short*)(sc + SC_KT + ((t) * 72 + lane) * 2))
#define RAWE(t) bf_us(*(const LAS unsigned short*)(sc + SC_BT + ((t) * 72 + lane) * 2))
#define RAWA(t) bf_us(*(const LAS unsigned short*)(sl + SL_P1T + ((t) * 72 + lane) * 2))
#define RAWR(t) bf_us(*(const LAS unsigned short*)(sl + SL_RT + ((t) * 72 + lane) * 2))
            RW2_LOAD((size_t)b * SEQL + (size_t)pj * 16);
            for (int c = pj; c < SEQL / 16; c += RW2_NP) {
                const int slot = c & (RW2_NS - 1); LAS unsigned char* sl = lds_ + slot * RW2_SLOT;
                const size_t row0 = (size_t)b * SEQL + (size_t)c * 16;
                while ((int)flags[RW2_NS] < c - (RW2_NS - 1)) __builtin_amdgcn_s_sleep(2);
                LDS_FENCE();
#pragma unroll
                for (int j2 = 0; j2 < 2; ++j2) { const int so = ((ss + 8 * j2) * 72 + sp8) * 2;
                    *(LAS pg8::u32x4*)(sl + SL_RT + so) = qR[j2]; *(LAS pg8::u32x4*)(sc + SC_KT + so) = qK[j2]; *(LAS pg8::u32x4*)(sc + SC_BT + so) = qE[j2]; *(LAS pg8::u32x4*)(sl + SL_P1T + so) = qA[j2]; }
                *(LAS u32x2*)(sl + SL_VP + lane * 8) = (u32x2){qV[0], qV[1]};
                const float gCv = qG;
                LDS_FENCE();
                if (c + RW2_NP < SEQL / 16) RW2_LOAD(row0 + (size_t)RW2_NP * 16);
                {
                    pg8::u32x4 q0, q1;
#pragma unroll
                    for (int i = 0; i < 4; ++i) { q0[i] = pk2(RAWA(2 * i), RAWA(2 * i + 1)); q1[i] = pk2(RAWA(8 + 2 * i), RAWA(8 + 2 * i + 1)); }
                    *(LAS pg8::u32x4*)(sc + SC_ATT + lane * 32) = q0; *(LAS pg8::u32x4*)(sc + SC_ATT + lane * 32 + 16) = q1;
#pragma unroll
                    for (int i = 0; i < 4; ++i) { q0[i] = pk2(RAWE(2 * i) * gCv, RAWE(2 * i + 1) * gCv); q1[i] = pk2(RAWE(8 + 2 * i) * gCv, RAWE(8 + 2 * i + 1) * gCv); }
                    *(LAS pg8::u32x4*)(sl + SL_BPT + lane * 32) = q0; *(LAS pg8::u32x4*)(sl + SL_BPT + lane * 32 + 16) = q1;
#pragma unroll
                    for (int i = 0; i < 4; ++i) { q0[i] = pk2(RAWK(2 * i) * gCv, RAWK(2 * i + 1) * gCv); q1[i] = pk2(RAWK(8 + 2 * i) * gCv, RAWK(8 + 2 * i + 1) * gCv); }
                    *(LAS pg8::u32x4*)(sl + SL_KPT + lane * 32) = q0; *(LAS pg8::u32x4*)(sl + SL_KPT + lane * 32 + 16) = q1;
                    *(LAS float*)(sl + SL_GC + lane * 4) = gCv;
                }
                LDS_FENCE();
                f32x4 gba = {0.f, 0.f, 0.f, 0.f}, gka = gba, gbr = gba, gkr = gba;
#pragma unroll
                for (int k2 = 0; k2 < 2; ++k2) {
                    const int off = (fr * 72 + 32 * k2 + 8 * fq) * 2;
                    const bf16x8 fb = *(const LAS bf16x8*)(sc + SC_BT + off), fk = *(const LAS bf16x8*)(sc + SC_KT + off), fa = *(const LAS bf16x8*)(sl + SL_P1T + off), frt = *(const LAS bf16x8*)(sl + SL_RT + off);
                    gba = __builtin_amdgcn_mfma_f32_16x16x32_bf16(fb, fa, gba, 0, 0, 0); gka = __builtin_amdgcn_mfma_f32_16x16x32_bf16(fk, fa, gka, 0, 0, 0);
                    gbr = __builtin_amdgcn_mfma_f32_16x16x32_bf16(fb, frt, gbr, 0, 0, 0); gkr = __builtin_amdgcn_mfma_f32_16x16x32_bf16(fk, frt, gkr, 0, 0, 0);
                }
                {
                    Frag8 am;
#pragma unroll
                    for (int i = 0; i < 4; ++i) { const int ii = 4 * fq + i; const bool st = ii < fr, le = ii <= fr;
                        *(LAS float*)(sc + SC_L + (ii * 16 + fr) * 4) = st ? gba[i] : 0.f;
                        *(LAS unsigned short*)(sc + SC_LKA + (ii * 24 + fr) * 2) = us_bf(st ? gka[i] : 0.f);
                        gbr[i] = le ? gbr[i] : 0.f; gkr[i] = le ? gkr[i] : 0.f; }
                    am.u[0] = pk2(gbr[0], gbr[1]); am.u[1] = pk2(gbr[2], gbr[3]); am.u[2] = pk2(gkr[0], gkr[1]); am.u[3] = pk2(gkr[2], gkr[3]);
                    pg8::u32x4 t4; t4[0] = am.u[0]; t4[1] = am.u[1]; t4[2] = am.u[2]; t4[3] = am.u[3];
                    *(LAS pg8::u32x4*)(sl + SL_AM + lane * 16) = t4;
                }
                LDS_FENCE();
                float n[16];
#pragma unroll
                for (int j = 0; j < 16; ++j) n[j] = (fr == j) ? 1.0f : 0.f;
#pragma unroll
                for (int i = 14; i >= 0; --i) {
                    if ((i & 1) == 0) asm volatile("" ::: "memory");
                    float Lr[16];
#pragma unroll
                    for (int q = 0; q < 4; ++q) { const f32x4 t4 = *(const LAS f32x4*)(sc + SC_L + (i * 16 + q * 4) * 4); Lr[q * 4] = t4[0]; Lr[q * 4 + 1] = t4[1]; Lr[q * 4 + 2] = t4[2]; Lr[q * 4 + 3] = t4[3]; }
                    float a0 = n[i], a1 = 0.f, a2 = 0.f, a3 = 0.f;
#pragma unroll
                    for (int j = i + 1; j < 16; ++j) { if (((j - i) & 3) == 1) a0 = fmaf(Lr[j], n[j], a0); else if (((j - i) & 3) == 2) a1 = fmaf(Lr[j], n[j], a1); else if (((j - i) & 3) == 3) a2 = fmaf(Lr[j], n[j], a2); else a3 = fmaf(Lr[j], n[j], a3); }
                    n[i] = (a0 + a1) + (a2 + a3);
                }
                {
                    pg8::u32x4 q0, q1;
#pragma unroll
                    for (int i = 0; i < 4; ++i) { q0[i] = pk2(n[2 * i], n[2 * i + 1]); q1[i] = pk2(n[8 + 2 * i], n[8 + 2 * i + 1]); }
                    if (fq == 0) { *(LAS pg8::u32x4*)(sc + SC_NT + fr * 48) = q0; *(LAS pg8::u32x4*)(sc + SC_NT + fr * 48 + 16) = q1; }
                }
                LDS_FENCE();
                const bf16x8 z8 = {0, 0, 0, 0, 0, 0, 0, 0};
                const bf16x8 fnt = fq < 2 ? *(const LAS bf16x8*)(sc + SC_NT + fr * 48 + fq * 16) : z8;
                const bf16x8 flk = fq < 2 ? *(const LAS bf16x8*)(sc + SC_LKA + fr * 48 + fq * 16) : z8;
                f32x4 z4 = {0.f, 0.f, 0.f, 0.f};
                const f32x4 d2 = __builtin_amdgcn_mfma_f32_16x16x32_bf16(flk, fnt, z4, 0, 0, 0);
                *(LAS u32x2*)(sl + SL_A2 + lane * 8) = (u32x2){pk2(d2[0], d2[1]), pk2(d2[2], d2[3])};
#pragma unroll
                for (int tl = 0; tl < 4; ++tl) {
                    const bf16x8 fat = fq < 2 ? *(const LAS bf16x8*)(sc + SC_ATT + (16 * tl + fr) * 32 + fq * 16) : z8;
                    const f32x4 d = __builtin_amdgcn_mfma_f32_16x16x32_bf16(fnt, fat, z4, 0, 0, 0);
#pragma unroll
                    for (int i = 0; i < 4; ++i) *(LAS unsigned short*)(sl + SL_P1T + ((4 * fq + i) * 72 + 16 * tl + fr) * 2) = us_bf(d[i]);
                }
                LDS_FENCE();
                if (lane == 0) flags[slot] = (unsigned)(c + 1);
            }
        }
    }
}

#undef RW2_LOAD
#undef RAWK
#undef RAWE
#undef RAWA
#undef RAWR
__device__ __forceinline__ void phase_rw_post(const P& p, const bf16_t* OUT, const float* CB, const bf16_t* V, const bf16_t* SZ, bf16_t* OF) {
    const size_t nth = (size_t)gridDim.x * 512;
    for (size_t it = (size_t)blockIdx.x * 512 + otid(); it < (size_t)MTOK * 128; it += nth) {
        const int c0 = (int)(it & 127) * 8; const size_t row = it >> 7, o = row * DM + c0;
        float ov[8], v[8], sz[8];
        unpack8(*(const uint4*)(OUT + o), ov); unpack8(*(const uint4*)(V + o), v); unpack8(*(const uint4*)(SZ + o), sz);
        const float dot = CB[row * 16 + (c0 >> 6)];
        float sm = 0.f;
#pragma unroll
        for (int i = 0; i < 8; ++i) sm += ov[i];
        const float mean = red8(sm) * (1.0f / 64.0f);
        float q = 0.f;
#pragma unroll
        for (int i = 0; i < 8; ++i) { ov[i] -= mean; q += ov[i] * ov[i]; }
        const float rs = rsqrtf(red8(q) * (1.0f / 64.0f) + 64e-5f);
        float y[8];
#pragma unroll
        for (int i = 0; i < 8; ++i) y[i] = (ov[i] * rs * p.in[28][c0 + i] + p.in[29][c0 + i] + dot * v[i]) * sz[i];
        *(uint4*)(OF + o) = make_uint4(pk2(y[0], y[1]), pk2(y[2], y[3]), pk2(y[4], y[5]), pk2(y[6], y[7]));
    }
}

__global__ void __launch_bounds__(512, 2) fwd_mega(P p) {
    extern __shared__ __attribute__((aligned(16))) unsigned char shm[];
    LAS unsigned char* lds = (LAS unsigned char*)shm;
    LAS float* tile = (LAS float*)shm;
    volatile LAS unsigned* xst = (volatile LAS unsigned*)(lds + LDS_XST);
    if (threadIdx.x == 0) { xst[0] = 0u; xst[1] = 0u; }
    __syncthreads();
    const XcdBarrier xb = xcd_barrier_post((unsigned*)(p.ws + BAR_OFF), xst);
    unsigned char* ws = p.ws; float* X = p.out;
    bf16_t* act = (bf16_t*)(ws + ACT); bf16_t* pb = (bf16_t*)(ws + PB);
    phase_prep(p, tile);
    xcd_barrier(xb);
    for (int d = 0; d < DUP_PREP; ++d) { phase_prep(p, tile); xcd_barrier(xb); }
    for (int d = 0; d < DUP_SYNC; ++d) xcd_barrier(xb);
#define LAYER_TAIL(L, Aout, Wout, Wpe, Wpg, PEB) \
    { EpiWout E; E.X = X; E.RB = act; run_gemm(lds, Aout, Wout, 1024, 1024, E); } \
    { EpiBf16 E; E.O = PEB; E.ldo = 1024; E.split = 1 << 20; E.stride = 0; run_gemm(lds, pb, Wpe, 1024, 256, E); } \
    xcd_barrier(xb); \
    { EpiPle E; E.X = X; E.PE = PEB; run_gemm(lds, act, Wpg, 1024, 1024, E); } \
    xcd_barrier(xb); \
    phase_ln(X, act, p.in[33] + (L) * 1024, p.in[34] + (L) * 1024);
#define CONV_LAYER(L, j) { \
        bf16_t* U = (bf16_t*)(ws + T0); bf16_t* G = (bf16_t*)(ws + T0 + 32 * MiB); \
        { EpiConvIn E; E.U = U; E.G = G; run_gemm(lds, act, (const bf16_t*)(ws + W_CIN), 4096, 1024, E); } \
        xcd_barrier(xb); \
        phase_conv_ew(U, G, p.in[3] + (size_t)(j) * 3 * 1024); \
        if ((L) > 0) cvt_pb(p.in[1] + (size_t)(L) * MTOK * 256, pb); \
        xcd_barrier(xb); \
        LAYER_TAIL(L, G, (const bf16_t*)(ws + W_COUT), (const bf16_t*)(ws + W_PEC), (const bf16_t*)(ws + W_PGC), (bf16_t*)(ws + T0 + 64 * MiB)) }
    CONV_LAYER(0, 0)
    xcd_barrier(xb);
    {
        float* U = (float*)(ws + T0); bf16_t* SZ = (bf16_t*)(ws + T0 + 64 * MiB); bf16_t* YG = (bf16_t*)(ws + T0 + 96 * MiB); bf16_t* V = (bf16_t*)(ws + T0 + 128 * MiB);
        float* HL = (float*)(ws + T0 + 160 * MiB);
        { EpiSsmIn E; E.U = U; E.SZ = SZ; run_gemm(lds, act, (const bf16_t*)(ws + W_SIN), 2048, 1024, E); }
        xcd_barrier(xb);
        phase_s5<0>(p, lds, U, HL, YG);
        cvt_pb(p.in[1] + (size_t)1 * MTOK * 256, pb);
        xcd_barrier(xb);
        phase_s5<1>(p, lds, U, HL, YG);
        xcd_barrier(xb);
        for (int d = 0; d < DUP_S5; ++d) { phase_s5<0>(p, lds, U, HL, YG); xcd_barrier(xb); phase_s5<1>(p, lds, U, HL, YG); xcd_barrier(xb); }
        { EpiGlu E; E.YG = YG; E.SZ = SZ; E.bias = p.in[15]; E.V = V; run_gemm(lds, YG, (const bf16_t*)(ws + W_SGLU), 1024, 1024, E); }
        xcd_barrier(xb);
        LAYER_TAIL(1, V, (const bf16_t*)(ws + W_SOUT), (const bf16_t*)(ws + W_PE1), (const bf16_t*)(ws + W_PG1), (bf16_t*)(ws + T0))
    }
    xcd_barrier(xb);
    {
        bf16_t* XS = (bf16_t*)(ws + T0); bf16_t* RKV = (bf16_t*)(ws + T0 + 64 * MiB);
        bf16_t* Rb = RKV; bf16_t* Kb = RKV + (size_t)MTOK * DM; bf16_t* Vb = RKV + (size_t)2 * MTOK * DM;
        bf16_t* SZ = act; bf16_t* L1 = pb; bf16_t* DW = (bf16_t*)(ws + T0); bf16_t* DA = (bf16_t*)(ws + T0 + 32 * MiB);
        bf16_t* OUT = (bf16_t*)(ws + OUT_RW); bf16_t* OF = (bf16_t*)(ws + T0);
        const bf16_t* Wrk = (const bf16_t*)(ws + W_RK);
        phase_rw_prep(X, XS, p.in[17], p.in[17] + 1024);
        xcd_barrier(xb);
        { EpiBf16 E; E.O = Rb; E.ldo = 1024; E.split = 1 << 20; E.stride = 0; run_gemm(lds, XS, Wrk, 1024, 1024, E); }
        { EpiBf16 E; E.O = Kb; E.ldo = 1024; E.split = 1 << 20; E.stride = 0; run_gemm(lds, XS + (size_t)MTOK * DM, Wrk + (size_t)1024 * 1024, 1024, 1024, E); }
        phase_rw_lora1(lds, X, Wrk + (size_t)4096 * 1024, L1);
        xcd_barrier(xb);
        phase_rw_prep(X, XS, p.in[17] + 2 * 1024, p.in[17] + 3 * 1024);
        xcd_barrier(xb);
        { EpiBf16 E; E.O = Vb; E.ldo = 1024; E.split = 1 << 20; E.stride = 0; run_gemm(lds, XS, Wrk + (size_t)2 * 1024 * 1024, 1024, 1024, E); }
        { EpiBf16T<1> E; E.O = SZ; E.ldo = 1024; E.split = 1 << 20; E.stride = 0; run_gemm(lds, XS + (size_t)MTOK * DM, Wrk + (size_t)3 * 1024 * 1024, 1024, 1024, E); }
        xcd_barrier(xb);
        { EpiLora2 E; E.EW = DW; E.AA = DA; E.w0 = p.in[19]; E.a0 = p.in[22]; run_gemm(lds, L1, (const bf16_t*)(ws + W_L2), 2048, 256, E); }
        xcd_barrier(xb);
        float* GCb = (float*)(ws + T0 + 160 * MiB); float* CBb = (float*)(ws + T0 + 165 * MiB);
        phase_rw_tables(p, Rb, Kb, DW, DA, GCb, CBb);
        xcd_barrier(xb);
        phase_rw_scan2(p, lds, Rb, Kb, Vb, DW, DA, GCb, OUT);
        xcd_barrier(xb);
        for (int d = 0; d < DUP_RWSCAN; ++d) { phase_rw_scan<DUP_MODE>(p, lds, Rb, Kb, Vb, DW, DA, OUT); xcd_barrier(xb); }
        phase_rw_post(p, OUT, CBb, Vb, SZ, OF);
        cvt_pb(p.in[1] + (size_t)2 * MTOK * 256, pb);
        xcd_barrier(xb);
        LAYER_TAIL(2, OF, (const bf16_t*)(ws + W_ROUT), (const bf16_t*)(ws + W_PE2), (const bf16_t*)(ws + W_PG2), (bf16_t*)(ws + T0 + 32 * MiB))
        __syncthreads();
        conv_layer_weights(p, tile, 1, 3);
    }
    xcd_barrier(xb);
    CONV_LAYER(3, 1)
}

extern "C" void kernel_launch(void* const* d_in, const int* in_sizes, int n_in, void* d_out, int out_size, void* d_ws, size_t ws_size, hipStream_t stream) {
    static int grid_blocks = 0;
    if (!grid_blocks) {
        int dev = 0, cus = 0, per_cu = 0;
        hipGetDevice(&dev);
        hipDeviceGetAttribute(&cus, hipDeviceAttributeMultiprocessorCount, dev);
        hipFuncSetAttribute((const void*)fwd_mega, hipFuncAttributeMaxDynamicSharedMemorySize, LDS_BYTES);
        hipOccupancyMaxActiveBlocksPerMultiprocessor(&per_cu, (const void*)fwd_mega, 512, LDS_BYTES);
        if (per_cu < 1) { fprintf(stderr, "occupancy query returned %d\n", per_cu); per_cu = 1; }
        grid_blocks = cus;
        if (ws_size < 256 * MiB) fprintf(stderr, "workspace too small: %zu\n", ws_size);
    }
    P p{};
    for (int i = 0; i < 35; ++i) p.in[i] = (const float*)d_in[i];
    p.out = (float*)d_out; p.ws = (unsigned char*)d_ws;
    hipMemsetAsync((unsigned char*)d_ws + BAR_OFF, 0, XCD_BAR_WORDS * sizeof(unsigned), stream);
    void* args[] = {&p};
    hipError_t e = hipLaunchCooperativeKernel((const void*)fwd_mega, dim3(grid_blocks), dim3(512), args, LDS_BYTES, stream);
    if (e != hipSuccess) fprintf(stderr, "cooperative launch failed: %s (grid %d)\n", hipGetErrorString(e), grid_blocks);
}
```
